# Optimizing an MI355X kernel written in HIP

```python
import math
import jax, jax.numpy as jnp
from jax import lax
import numpy as np

D_MODEL = 1024
BATCH = 2
SEQ = 16384
DEPTH = 2

GRID_W = 64
CTX_LEN = 256
HEAD_DIM = 64
BLOCK = 128
WINDOW = 128
ROPE_BASE = 10000.0
EPS = 1e-6
NEG = -1e30
GROUP_W = D_MODEL // 4
A_HEADS = GROUP_W // HEAD_DIM
A_QK_DIM = HEAD_DIM // 2
A_V_DIM = HEAD_DIM
A_W = A_HEADS * A_V_DIM
B_CH = GROUP_W
CONV_W = 3
W_Q_HEADS = GROUP_W // HEAD_DIM
W_KV_HEADS = W_Q_HEADS // 2
W_GROUP = W_Q_HEADS // W_KV_HEADS
W_W = W_Q_HEADS * HEAD_DIM
G_Q_HEADS = GROUP_W // HEAD_DIM
G_KV_HEADS = G_Q_HEADS // 2
G_GROUP = G_Q_HEADS // G_KV_HEADS
G_W = G_Q_HEADS * HEAD_DIM
MIX_W = A_W + B_CH + W_W + G_W
SPLIT_SIZES = (A_HEADS * 2 * A_QK_DIM, A_HEADS * 2 * A_QK_DIM, A_HEADS * A_V_DIM,
               B_CH, B_CH, B_CH,
               W_Q_HEADS * HEAD_DIM, W_KV_HEADS * HEAD_DIM, W_KV_HEADS * HEAD_DIM,
               G_Q_HEADS * HEAD_DIM, G_KV_HEADS * HEAD_DIM, G_KV_HEADS * HEAD_DIM)
IN_W = sum(SPLIT_SIZES)
D_FF = 256 * ((8 * D_MODEL // 3 + 255) // 256)
N_MOD = 9

kernel_name = "hybrid_parallel_group_dit_block"


def _layer_norm(x, g, b):
    xf = x.astype(jnp.float32)
    mu = jnp.mean(xf, axis=-1, keepdims=True)
    var = jnp.mean(jnp.square(xf - mu), axis=-1, keepdims=True)
    return ((xf - mu) * lax.rsqrt(var + EPS) * g + b).astype(x.dtype)


def _rms_norm(x, g):
    xf = x.astype(jnp.float32)
    return (xf * lax.rsqrt(jnp.mean(xf * xf, axis=-1, keepdims=True) + EPS) * g).astype(x.dtype)


def _modulate(s, shift, scale):
    return s * (1.0 + scale) + shift


def _swiglu(h, w_gu, w_dn):
    g, u = jnp.split(h @ w_gu, 2, axis=-1)
    return (jax.nn.silu(g) * u) @ w_dn


def _ffn_step(s, shift, scale, gate, w_gu, w_dn, g, b, alpha):
    h = _modulate(s, shift, scale)
    return _layer_norm(alpha * s + 0.5 * gate * _swiglu(h, w_gu, w_dn), g, b)


def _rope_tables(rows, dim):
    n_freq = dim // 4
    inv_freq = ROPE_BASE ** (-jnp.arange(n_freq, dtype=jnp.float32) / n_freq)
    ang_r = jnp.arange(rows, dtype=jnp.float32)[:, None] * inv_freq
    ang_c = jnp.arange(GRID_W, dtype=jnp.float32)[:, None] * inv_freq
    ang_r = jnp.broadcast_to(ang_r[:, None, :], (rows, GRID_W, n_freq))
    ang_c = jnp.broadcast_to(ang_c[None, :, :], (rows, GRID_W, n_freq))
    ang = jnp.concatenate([ang_r, ang_r, ang_c, ang_c], axis=-1).reshape(rows * GRID_W, dim)
    return jnp.cos(ang), jnp.sin(ang)


def _apply_rope(x, cos, sin):
    shape = (cos.shape[0],) + (1,) * (x.ndim - 3) + (cos.shape[1],)
    a, b, c, d = jnp.split(x, 4, axis=-1)
    rot = jnp.concatenate([-b, a, -d, c], axis=-1)
    return (x * cos.reshape(shape) + rot * sin.reshape(shape)).astype(x.dtype)


def _split_cols(z):
    idx = np.cumsum(SPLIT_SIZES)[:-1].tolist()
    return jnp.split(z, idx, axis=-1)


def _gqa_softmax(q, k, v, sink=None):
    logits = jnp.einsum('bqhgd,bkhd->bhgqk', q, k).astype(jnp.float32) * (HEAD_DIM ** -0.5)
    if sink is None:
        p = jax.nn.softmax(logits, axis=-1)
    else:
        s = jnp.broadcast_to(sink.astype(jnp.float32).reshape((1,) + q.shape[2:4] + (1, 1)),
                             logits.shape[:-1] + (1,))
        p = jax.nn.softmax(jnp.concatenate([logits, s], axis=-1), axis=-1)[..., :-1]
    return jnp.einsum('bhgqk,bkhd->bqhgd', p.astype(v.dtype), v)


def _diff_softmax(q, k, v, lam):
    logits = jnp.einsum('bqhmd,bkhmd->bhmqk', q, k).astype(jnp.float32) * (A_QK_DIM ** -0.5)
    p = jax.nn.softmax(logits, axis=-1)
    w = p[:, :, 0] - lam * p[:, :, 1]
    return jnp.einsum('bhqk,bkhd->bqhd', w.astype(v.dtype), v)


def _diff_attention(zx, zc, lam, lambda_init, subln_w, rope, need_ctx):
    aq, ak, av = zx
    cq, ck, cv = zc
    B, S = aq.shape[:2]
    L = cq.shape[1]
    nb = S // BLOCK
    q = _apply_rope(aq.reshape(B, S, A_HEADS, 2, A_QK_DIM), *rope)
    k = _apply_rope(ak.reshape(B, S, A_HEADS, 2, A_QK_DIM), *rope)
    v = av.reshape(B, S, A_HEADS, A_V_DIM)
    qc = cq.reshape(B, L, A_HEADS, 2, A_QK_DIM)
    kc = ck.reshape(B, L, A_HEADS, 2, A_QK_DIM)
    vc = cv.reshape(B, L, A_HEADS, A_V_DIM)
    k_all = jnp.concatenate([kc, k], axis=1)
    v_all = jnp.concatenate([vc, v], axis=1)
    qb = jnp.moveaxis(q.reshape(B, nb, BLOCK, A_HEADS, 2, A_QK_DIM), 1, 0)
    o = lax.map(lambda qi: _diff_softmax(qi, k_all, v_all, lam), qb)
    o = jnp.moveaxis(o, 0, 1).reshape(B, S, A_HEADS, A_V_DIM)
    y_lat = (_rms_norm(o, subln_w) * (1.0 - lambda_init)).reshape(B, S, A_W)
    y_ctx = None
    if need_ctx:
        oc = _diff_softmax(qc, kc, vc, lam)
        y_ctx = (_rms_norm(oc, subln_w) * (1.0 - lambda_init)).reshape(B, L, A_W)
    return y_lat, y_ctx


def _short_conv(gb, gc, u, conv_w):
    h = gc * u
    y = lax.conv_general_dilated(h, conv_w[:, None, :].astype(h.dtype), window_strides=(1,),
                                 padding=[(CONV_W // 2, CONV_W // 2)],
                                 dimension_numbers=('NWC', 'WIO', 'NWC'),
                                 feature_group_count=B_CH)
    return gb * y


def _banded_sink_attention(q, k, v, kc, vc, sink):
    B, S = q.shape[:2]
    L = kc.shape[1]
    nb = S // BLOCK
    qb = q.reshape(B, nb, BLOCK, W_KV_HEADS, W_GROUP, HEAD_DIM)
    pad = ((0, 0), (BLOCK, BLOCK), (0, 0), (0, 0))
    kp = jnp.pad(k, pad).reshape(B, nb + 2, BLOCK, W_KV_HEADS, HEAD_DIM)
    vp = jnp.pad(v, pad).reshape(B, nb + 2, BLOCK, W_KV_HEADS, HEAD_DIM)
    kw = jnp.concatenate([kp[:, :-2], kp[:, 1:-1], kp[:, 2:]], axis=2)
    vw = jnp.concatenate([vp[:, :-2], vp[:, 1:-1], vp[:, 2:]], axis=2)
    kpos = jnp.arange(3 * BLOCK) - BLOCK
    qpos = jnp.arange(BLOCK)
    rel = kpos[None, :] - qpos[:, None]
    absk = jnp.arange(nb)[:, None, None] * BLOCK + kpos[None, None, :]
    valid = (jnp.abs(rel) <= WINDOW)[None] & (absk >= 0) & (absk < S)
    scale = HEAD_DIM ** -0.5
    lw = jnp.einsum('bnqhgd,bnkhd->bhgnqk', qb, kw).astype(jnp.float32) * scale
    lw = jnp.where(valid, lw, NEG)
    lc = jnp.einsum('bnqhgd,bchd->bhgnqc', qb, kc).astype(jnp.float32) * scale
    ls = jnp.broadcast_to(sink.astype(jnp.float32).reshape(1, W_KV_HEADS, W_GROUP, 1, 1, 1),
                          lw.shape[:-1] + (1,))
    p = jax.nn.softmax(jnp.concatenate([lw, lc, ls], axis=-1), axis=-1)
    pw = p[..., :3 * BLOCK].astype(v.dtype)
    pc = p[..., 3 * BLOCK:3 * BLOCK + L].astype(v.dtype)
    o = (jnp.einsum('bhgnqk,bnkhd->bnqhgd', pw, vw)
         + jnp.einsum('bhgnqc,bchd->bnqhgd', pc, vc))
    return o.reshape(B, S, W_W)


def _window_attention(zx, zc, sink, rope, need_ctx):
    q, k, v = zx
    qc, kc, vc = zc
    B, S = q.shape[:2]
    L = qc.shape[1]
    q = _apply_rope(q.reshape(B, S, W_KV_HEADS, W_GROUP, HEAD_DIM), *rope)
    k = _apply_rope(k.reshape(B, S, W_KV_HEADS, HEAD_DIM), *rope)
    v = v.reshape(B, S, W_KV_HEADS, HEAD_DIM)
    qc = qc.reshape(B, L, W_KV_HEADS, W_GROUP, HEAD_DIM)
    kc = kc.reshape(B, L, W_KV_HEADS, HEAD_DIM)
    vc = vc.reshape(B, L, W_KV_HEADS, HEAD_DIM)
    y_lat = _banded_sink_attention(q, k, v, kc, vc, sink)
    y_ctx = _gqa_softmax(qc, kc, vc, sink).reshape(B, L, W_W) if need_ctx else None
    return y_lat, y_ctx


def _global_attention(zx, zc, qn_w, kn_w, rope, need_ctx):
    q, k, v = zx
    qc, kc, vc = zc
    B, S = q.shape[:2]
    L = qc.shape[1]
    nb = S // BLOCK
    q = _apply_rope(_rms_norm(q.reshape(B, S, G_KV_HEADS, G_GROUP, HEAD_DIM), qn_w), *rope)
    k = _apply_rope(_rms_norm(k.reshape(B, S, G_KV_HEADS, HEAD_DIM), kn_w), *rope)
    v = v.reshape(B, S, G_KV_HEADS, HEAD_DIM)
    qc = _rms_norm(qc.reshape(B, L, G_KV_HEADS, G_GROUP, HEAD_DIM), qn_w)
    kc = _rms_norm(kc.reshape(B, L, G_KV_HEADS, HEAD_DIM), kn_w)
    vc = vc.reshape(B, L, G_KV_HEADS, HEAD_DIM)
    k_all = jnp.concatenate([kc, k], axis=1)
    v_all = jnp.concatenate([vc, v], axis=1)
    qb = jnp.moveaxis(q.reshape(B, nb, BLOCK, G_KV_HEADS, G_GROUP, HEAD_DIM), 1, 0)
    o = lax.map(lambda qi: _gqa_softmax(qi, k_all, v_all), qb)
    y_lat = jnp.moveaxis(o, 0, 1).reshape(B, S, G_W)
    y_ctx = _gqa_softmax(qc, kc, vc).reshape(B, L, G_W) if need_ctx else None
    return y_lat, y_ctx


def setup_inputs(seed: int = 0) -> dict:
    key = jax.random.key(seed)
    ks = jax.random.split(key, 24)
    beta = (8.0 * DEPTH) ** -0.25

    def nrm(k, shape, s):
        return jax.random.normal(k, shape, jnp.float32) * s

    return {
        "x": nrm(ks[0], (BATCH, SEQ, D_MODEL), 1.0),
        "c": nrm(ks[1], (BATCH, D_MODEL), 1.0),
        "ctx": nrm(ks[2], (BATCH, CTX_LEN, D_MODEL), 1.0),
        "c_ctx": nrm(ks[3], (D_MODEL,), 1.0),
        "w_mod": nrm(ks[4], (DEPTH, D_MODEL, N_MOD * D_MODEL), 0.5 * D_MODEL ** -0.5),
        "b_mod": nrm(ks[5], (DEPTH, N_MOD * D_MODEL), 0.02),
        "ln_g": 1.0 + nrm(ks[6], (DEPTH, 3, D_MODEL), 0.02),
        "ln_b": nrm(ks[7], (DEPTH, 3, D_MODEL), 0.02),
        "w_gu1": nrm(ks[8], (DEPTH, D_MODEL, 2 * D_FF), D_MODEL ** -0.5),
        "w_dn1": nrm(ks[9], (DEPTH, D_FF, D_MODEL), beta * D_FF ** -0.5),
        "w_in": nrm(ks[10], (DEPTH, D_MODEL, IN_W), D_MODEL ** -0.5),
        "w_out": nrm(ks[11], (DEPTH, MIX_W, D_MODEL), beta * MIX_W ** -0.5),
        "conv_w": nrm(ks[12], (DEPTH, CONV_W, B_CH), CONV_W ** -0.5),
        "lam_q1": nrm(ks[13], (DEPTH, A_QK_DIM), 0.1),
        "lam_k1": nrm(ks[14], (DEPTH, A_QK_DIM), 0.1),
        "lam_q2": nrm(ks[15], (DEPTH, A_QK_DIM), 0.1),
        "lam_k2": nrm(ks[16], (DEPTH, A_QK_DIM), 0.1),
        "subln_w": 1.0 + nrm(ks[17], (DEPTH, A_V_DIM), 0.02),
        "sink": nrm(ks[18], (DEPTH, W_Q_HEADS), 0.5),
        "qn_w": 1.0 + nrm(ks[19], (DEPTH, HEAD_DIM), 0.02),
        "kn_w": 1.0 + nrm(ks[20], (DEPTH, HEAD_DIM), 0.02),
        "w_gu2": nrm(ks[21], (DEPTH, D_MODEL, 2 * D_FF), D_MODEL ** -0.5),
        "w_dn2": nrm(ks[22], (DEPTH, D_FF, D_MODEL), beta * D_FF ** -0.5),
    }


def reference(x, c, ctx, c_ctx, w_mod, b_mod, ln_g, ln_b, w_gu1, w_dn1, w_in, w_out, conv_w,
              lam_q1, lam_k1, lam_q2, lam_k2, subln_w, sink, qn_w, kn_w, w_gu2, w_dn2):
    B, S, _ = x.shape
    rows = S // GRID_W
    rope_a = _rope_tables(rows, A_QK_DIM)
    rope_h = _rope_tables(rows, HEAD_DIM)
    alpha = (2.0 * DEPTH) ** 0.25
    xc = ctx
    for l in range(DEPTH):
        need_ctx = l < DEPTH - 1
        lambda_init = 0.8 - 0.6 * math.exp(-0.3 * l)
        mx = jnp.split((jax.nn.silu(c) @ w_mod[l] + b_mod[l])[:, None, :], N_MOD, axis=-1)
        mc = jnp.split((jax.nn.silu(c_ctx) @ w_mod[l] + b_mod[l])[None, None, :], N_MOD, axis=-1)

        x = _ffn_step(x, mx[0], mx[1], mx[2], w_gu1[l], w_dn1[l], ln_g[l, 0], ln_b[l, 0], alpha)
        xc = _ffn_step(xc, mc[0], mc[1], mc[2], w_gu1[l], w_dn1[l], ln_g[l, 0], ln_b[l, 0], alpha)

        zx = _split_cols(_modulate(x, mx[3], mx[4]) @ w_in[l])
        zc = _split_cols(_modulate(xc, mc[3], mc[4]) @ w_in[l])
        lam = (jnp.exp(jnp.sum(lam_q1[l] * lam_k1[l])) - jnp.exp(jnp.sum(lam_q2[l] * lam_k2[l]))
               + lambda_init).astype(jnp.float32)
        ya_x, ya_c = _diff_attention(zx[0:3], zc[0:3], lam, lambda_init, subln_w[l], rope_a, need_ctx)
        yb_x = _short_conv(zx[3], zx[4], zx[5], conv_w[l])
        yw_x, yw_c = _window_attention(zx[6:9], zc[6:9], sink[l], rope_h, need_ctx)
        yg_x, yg_c = _global_attention(zx[9:12], zc[9:12], qn_w[l], kn_w[l], rope_h, need_ctx)
        y_lat = jnp.concatenate([ya_x, yb_x, yw_x, yg_x], axis=-1) @ w_out[l]
        x = _layer_norm(alpha * x + mx[5] * y_lat, ln_g[l, 1], ln_b[l, 1])

        x = _ffn_step(x, mx[6], mx[7], mx[8], w_gu2[l], w_dn2[l], ln_g[l, 2], ln_b[l, 2], alpha)

        if need_ctx:
            yb_c = _short_conv(zc[3], zc[4], zc[5], conv_w[l])
            y_ctx = jnp.concatenate([ya_c, yb_c, yw_c, yg_c], axis=-1) @ w_out[l]
            xc = _layer_norm(alpha * xc + mc[5] * y_ctx, ln_g[l, 1], ln_b[l, 1])
            xc = _ffn_step(xc, mc[6], mc[7], mc[8], w_gu2[l], w_dn2[l], ln_g[l, 2], ln_b[l, 2], alpha)
    return x
```

```cpp
#include <hip/hip_runtime.h>
#include <hip/hip_cooperative_groups.h>
#include <cstdio>
#include <cstdint>
namespace cg = cooperative_groups;
namespace pg8 {
#define PG8_LAS __attribute__((address_space(3)))
typedef unsigned short bf16_t;
typedef short bf16x8 __attribute__((ext_vector_type(8)));
typedef float f32x4 __attribute__((ext_vector_type(4)));
typedef unsigned u32x4 __attribute__((ext_vector_type(4)));
constexpr int BM = 256, BK = 64, HALF = 128, HTB = HALF * BK * 2  , STAGE_BYTES = 8 * HTB, NXCD = 8, WGM = 8;

__host__ __device__ __forceinline__ int lds_byte(int r, int c) { const int st = (r >> 4) * 2 + (c >> 5), rr = r & 15, cc = c & 31, ob = rr * 64 + cc * 2; return st * 1024 + (ob ^ (((ob >> 9) & 1) << 5)); }
__host__ __device__ __forceinline__ void stage_rc(int b, int& R, int& C) { const int st = b / 1024, sb = b % 1024, swz = sb ^ (((sb >> 9) & 1) << 5); R = (st >> 1) * 16 + swz / 64; C = (st & 1) * 32 + (swz % 64) / 2; }
__host__ __device__ __forceinline__ int perm32(int rho) { const int n = rho >> 4, i = rho & 15; return 8 * (i >> 2) + 4 * n + (i & 3); }

struct Unit { int pm, pn; };
struct Gemm { const bf16_t* A; const bf16_t* Bt; int M, N, K; };

struct StaticOrder {
    int nM, nN, nwg, G, c;
    __host__ __device__ void init(int M, int N, int G_, int c_) { nM = M / BM; nN = N / BM; nwg = nM * nN; G = G_; c = c_; }
    __host__ __device__ bool next(int i, Unit& u) const {
        const long L = (long)i * G + c; if (L >= nwg) return false;
        int wgid = (int)L; { const int q = nwg / NXCD, r = nwg % NXCD, xcd = wgid % NXCD, off = wgid / NXCD; wgid = (xcd < r ? xcd * (q + 1) : r * (q + 1) + (xcd - r) * q) + off; }
        const int nig = WGM * nN, gid = wgid / nig, fm = gid * WGM, gsz = (nM - fm) < WGM ? (nM - fm) : WGM;
        u.pm = fm + ((wgid % nig) % gsz); u.pn = (wgid % nig) / gsz; return true;
    }
    __device__ __forceinline__ void a_ready(const Unit&) const {}
    __device__ __forceinline__ void done(const Unit&) const {}
};

__device__ __forceinline__ unsigned cvt_pk_bf16(float lo, float hi) { unsigned r; asm volatile("v_cvt_pk_bf16_f32 %0, %1, %2" : "=v"(r) : "v"(lo), "v"(hi)); return r; }
typedef float f32x2 __attribute__((ext_vector_type(2)));
__device__ __forceinline__ f32x2 gelu_pk(f32x2 v) {
    const f32x2 av = __builtin_elementwise_abs(v), d = av * 0.2316418882f + 1.0f;
    f32x2 t; t.x = __builtin_amdgcn_rcpf(d.x); t.y = __builtin_amdgcn_rcpf(d.y);
    f32x2 q = t * 0.5307027145f + (-0.7265760135f); q = q * t + 0.7107068705f; q = q * t + (-0.142248368f); q = q * t + 0.127414796f; q = q * t;
    const f32x2 s = (v * v) * (-0.72134752044f);
    f32x2 e; e.x = __builtin_amdgcn_exp2f(s.x); e.y = __builtin_amdgcn_exp2f(s.y);
    const f32x2 m = v * (q * e), r = v - m;
    f32x2 o; o.x = v.x < 0.f ? m.x : r.x; o.y = v.y < 0.f ? m.y : r.y; return o;
}

template <int ACT  > struct EpiBf16 {
    static constexpr bool PERM = true, AFTER_DRAIN = false; static_assert(ACT == 0 || ACT == 1, "EpiBf16: ACT is 0 (none) or 1 (gelu_pk)");
    bf16_t* O; int ldc; const float* bias; int split_cols; size_t split_stride; float scale0;
    __device__ __forceinline__ void operator()(const f32x4 (&acc)[2][2][4][2], const Unit& u, int wr, int wc, int fr, int fq) const {
        const int row0 = u.pm * BM + wr * 64 + fr; int colt = u.pn * BM; bf16_t* base = O;
        float sc = 1.f; if (split_cols) { const int t = colt / split_cols; base += (size_t)t * split_stride; colt -= t * split_cols; if (t == 0) sc = scale0; }
        const int col0 = colt + wc * 32 + 8 * fq, bcol0 = u.pn * BM + wc * 32 + 8 * fq;
        f32x4 bv[2][2];
#pragma unroll
        for (int bj = 0; bj < 2; ++bj)
#pragma unroll
            for (int n = 0; n < 2; ++n) bv[bj][n] = bias ? *(const f32x4*)(bias + bcol0 + bj * HALF + 4 * n) : (f32x4){0.f, 0.f, 0.f, 0.f};
#pragma unroll
        for (int ai = 0; ai < 2; ++ai)
#pragma unroll
            for (int m = 0; m < 4; ++m) { bf16_t* rowp = base + (size_t)(row0 + ai * HALF + m * 16) * ldc + col0;
#pragma unroll
                for (int bj = 0; bj < 2; ++bj) { f32x4 v0 = acc[ai][bj][m][0] + bv[bj][0], v1 = acc[ai][bj][m][1] + bv[bj][1];
                    if (ACT == 1) { f32x2 a = gelu_pk((f32x2){v0[0], v0[1]}), b = gelu_pk((f32x2){v0[2], v0[3]}), c = gelu_pk((f32x2){v1[0], v1[1]}), d = gelu_pk((f32x2){v1[2], v1[3]});
                        v0 = (f32x4){a.x, a.y, b.x, b.y}; v1 = (f32x4){c.x, c.y, d.x, d.y}; }
                    v0 = v0 * sc; v1 = v1 * sc; u32x4 w; w.x = cvt_pk_bf16(v0[0], v0[1]); w.y = cvt_pk_bf16(v0[2], v0[3]); w.z = cvt_pk_bf16(v1[0], v1[1]); w.w = cvt_pk_bf16(v1[2], v1[3]);
                    *(u32x4*)(rowp + bj * HALF) = w; } }
    }
};
struct EpiSwiglu {
    static constexpr bool PERM = true, AFTER_DRAIN = false;
    bf16_t* O; int ldc;
    __device__ __forceinline__ void operator()(const f32x4 (&acc)[2][2][4][2], const Unit& u, int wr, int wc, int fr, int fq) const {
        const int row0 = u.pm * BM + wr * 64 + fr; const int col0 = u.pn * HALF + wc * 32 + 8 * fq;
#pragma unroll
        for (int ai = 0; ai < 2; ++ai)
#pragma unroll
            for (int m = 0; m < 4; ++m) { bf16_t* rowp = O + (size_t)(row0 + ai * HALF + m * 16) * ldc + col0;
                float r[8];
#pragma unroll
                for (int n = 0; n < 2; ++n)
#pragma unroll
                    for (int e = 0; e < 4; ++e) { const float g = acc[ai][0][m][n][e], uu = acc[ai][1][m][n][e];
                        const float sg = __builtin_amdgcn_rcpf(1.0f + __builtin_amdgcn_exp2f(-1.4426950408889634f * g)); r[n * 4 + e] = g * sg * uu; }
                u32x4 w; w.x = cvt_pk_bf16(r[0], r[1]); w.y = cvt_pk_bf16(r[2], r[3]); w.z = cvt_pk_bf16(r[4], r[5]); w.w = cvt_pk_bf16(r[6], r[7]);
                *(u32x4*)rowp = w; }
    }
};
struct EpiResid {
    static constexpr bool PERM = true, AFTER_DRAIN = false;
    float* Xlat; float* Xctx; const float* gate; float coef;
    const float* Slat; const float* Sctx;
    const float* stats; const float* lg; const float* lb; int ident;
    __device__ __forceinline__ void operator()(const f32x4 (&acc)[2][2][4][2], const Unit& u, int wr, int wc, int fr, int fq) const {
        const int rowt = u.pm * BM; float* base; int set;
        const float* sbase;
        if (rowt < 32768) { base = Xlat + (size_t)rowt * 1024; sbase = Slat + (size_t)rowt * 1024; set = rowt >> 14; } else { base = Xctx + (size_t)(rowt - 32768) * 1024; sbase = Sctx + (size_t)(rowt - 32768) * 1024; set = 2; }
        const int col0 = u.pn * BM + wc * 32 + 8 * fq; const float* gp = gate + set * 9216 + col0;
        float mean[2][4], rstd[2][4];
#pragma unroll
        for (int ai = 0; ai < 2; ++ai)
#pragma unroll
            for (int m = 0; m < 4; ++m) { mean[ai][m] = 0.f; rstd[ai][m] = 1.f;
                if (!ident) { const f32x2 st = *(const f32x2*)(stats + 2 * (size_t)(rowt + wr * 64 + fr + ai * HALF + m * 16)); mean[ai][m] = st[0]; rstd[ai][m] = st[1]; } }
#pragma unroll
        for (int bj = 0; bj < 2; ++bj)
#pragma unroll
            for (int n = 0; n < 2; ++n) { const f32x4 gvv = *(const f32x4*)(gp + bj * HALF + 4 * n) * coef; f32x4 g4v, b4v;
                if (ident) { g4v = (f32x4){1.41421356237f, 1.41421356237f, 1.41421356237f, 1.41421356237f}; b4v = (f32x4){0.f, 0.f, 0.f, 0.f}; }
                else { g4v = *(const f32x4*)(lg + col0 + bj * HALF + 4 * n) * 1.41421356237f; b4v = *(const f32x4*)(lb + col0 + bj * HALF + 4 * n) * 1.41421356237f; }
#pragma unroll
                for (int ai = 0; ai < 2; ++ai)
#pragma unroll
                    for (int m = 0; m < 4; ++m) { const size_t eo_ = (size_t)(wr * 64 + fr + ai * HALF + m * 16) * 1024 + col0 + bj * HALF + 4 * n; f32x4* p = (f32x4*)(base + eo_); const f32x4 x = *(const f32x4*)(sbase + eo_);
                        *p = ((x - mean[ai][m]) * rstd[ai][m]) * g4v + b4v + gvv * acc[ai][bj][m][n]; } }
    }
};
template <class Epi, class Sched, bool ALIGN_EPI = false, bool SP2 = false>
__device__ __forceinline__ void gemm_phase(PG8_LAS unsigned char* lds, const Gemm g, const Sched& S, const Epi& E) {
    int tid_ = threadIdx.x; asm volatile("" : "+v"(tid_)); const int tid = tid_, wid = __builtin_amdgcn_readfirstlane(tid >> 6), lane = tid & 63, wr = wid >> 2, wc = wid & 3, fr = lane & 15, fq = lane >> 4;
    const int K = g.K, nt = K / BK;
    unsigned voffA[2], voffB[2];
#pragma unroll
    for (int i = 0; i < 2; ++i) { int R, C; stage_rc(tid * 16 + i * 8192, R, C); const int Rb = Epi::PERM ? ((R & ~31) + perm32(R & 31)) : R;
        voffA[i] = (unsigned)(R * K + C) * 2u; voffB[i] = (unsigned)(Rb * K + C) * 2u; }
    const size_t kstep = (size_t)(BK * 2);
    const size_t hstep = (size_t)HALF * K * 2;
    const size_t tstep = 2 * hstep;
    const unsigned ldsw = (unsigned)wid * 1024u;
    const int aoff = lds_byte(wr * 64 + fr, fq * 8), boff = lds_byte(wc * 32 + fr, fq * 8);
#define PG8_SA(b, h) (((b) * 2 + (h)) * HTB)
#define PG8_SB(b, h) ((4 + (b) * 2 + (h)) * HTB)
#define PG8_STAGE(bufoff, gbase, voff) do { _Pragma("unroll") for (int _i = 0; _i < 2; ++_i) \
        __builtin_amdgcn_global_load_lds((const unsigned*)((const char*)(gbase) + (voff)[_i]), (PG8_LAS unsigned*)(lds + (bufoff) + ldsw + _i * 8192), 16, 0, 0); } while (0)
#define PG8_LDA(dst, b, h) do { _Pragma("unroll") for (int m = 0; m < 4; ++m) _Pragma("unroll") for (int k = 0; k < 2; ++k) dst[m][k] = *(const PG8_LAS bf16x8*)(lds + PG8_SA(b, h) + aoff + m * 2048 + k * 1024); } while (0)
#define PG8_LDB(dst, b, h) do { _Pragma("unroll") for (int n = 0; n < 2; ++n) _Pragma("unroll") for (int k = 0; k < 2; ++k) dst[n][k] = *(const PG8_LAS bf16x8*)(lds + PG8_SB(b, h) + boff + n * 2048 + k * 1024); } while (0)
#define PG8_MMA(ai, bj, At, Bt) do { __builtin_amdgcn_s_setprio(1); _Pragma("unroll") for (int m = 0; m < 4; ++m) _Pragma("unroll") for (int n = 0; n < 2; ++n) _Pragma("unroll") for (int k = 0; k < 2; ++k) \
        acc[ai][bj][m][n] = __builtin_amdgcn_mfma_f32_16x16x32_bf16(Bt[n][k], At[m][k], acc[ai][bj][m][n], 0, 0, 0); __builtin_amdgcn_s_setprio(0); } while (0)
#define PG8_WAIT_V(n) asm volatile("s_waitcnt vmcnt(" #n ")" ::: "memory")
#define PG8_WAIT_L(n) asm volatile("s_waitcnt lgkmcnt(" #n ")" ::: "memory")
#define PG8_BAR __builtin_amdgcn_s_barrier()
#define PG8_SCHED __builtin_amdgcn_sched_barrier(0)
    Unit cur, nxt; int ui = 0;
    if (!S.next(0, cur)) return;
    f32x4 acc[2][2][4][2];
#pragma unroll
    for (int a = 0; a < 2; ++a)
#pragma unroll
        for (int b = 0; b < 2; ++b)
#pragma unroll
            for (int m = 0; m < 4; ++m)
#pragma unroll
                for (int n = 0; n < 2; ++n) acc[a][b][m][n] = (f32x4){0.f, 0.f, 0.f, 0.f};
    bf16x8 At[4][2], B0[2][2], B1[2][2];
    const char* cA = (const char*)g.A + (size_t)cur.pm * tstep; const char* cB = (const char*)g.Bt + (size_t)cur.pn * tstep;
    S.a_ready(cur);
    if constexpr (SP2) {
        PG8_STAGE(PG8_SB(0, 0), cB, voffB); PG8_STAGE(PG8_SB(0, 1), cB + hstep, voffB); PG8_STAGE(PG8_SA(0, 0), cA, voffA); PG8_STAGE(PG8_SA(0, 1), cA + hstep, voffA);
        if (wr == 1) PG8_BAR;
        PG8_WAIT_V(2); PG8_BAR;
        PG8_STAGE(PG8_SB(1, 0), cB + kstep, voffB); PG8_STAGE(PG8_SA(1, 0), cA + kstep, voffA); PG8_STAGE(PG8_SB(1, 1), cB + hstep + kstep, voffB);
        PG8_WAIT_V(6); PG8_BAR;
    } else {
        PG8_STAGE(PG8_SB(0, 0), cB, voffB); PG8_STAGE(PG8_SA(0, 0), cA, voffA); PG8_STAGE(PG8_SB(0, 1), cB + hstep, voffB); PG8_STAGE(PG8_SA(0, 1), cA + hstep, voffA);
        if (wr == 1) PG8_BAR;
        PG8_WAIT_V(4); PG8_BAR;
        PG8_STAGE(PG8_SB(1, 0), cB + kstep, voffB); PG8_STAGE(PG8_SA(1, 0), cA + kstep, voffA); PG8_STAGE(PG8_SB(1, 1), cB + hstep + kstep, voffB);
        PG8_WAIT_V(6); PG8_BAR;
    }
    for (;;) {
        const bool has_next = S.next(ui + 1, nxt);
        const char* nA = has_next ? (const char*)g.A + (size_t)nxt.pm * tstep : cA; const char* nB = has_next ? (const char*)g.Bt + (size_t)nxt.pn * tstep : cB;
        for (int t = 0; t < nt; t += 2) {
            const bool last = (t == nt - 2);
            const char* a1 = cA + (size_t)(t + 1) * kstep;
            const char* a2 = last ? nA : cA + (size_t)(t + 2) * kstep; const char* b2 = last ? nB : cB + (size_t)(t + 2) * kstep;
            const char* a3 = a2 + kstep; const char* b3 = b2 + kstep;
            if (last && has_next) S.a_ready(nxt);
            if constexpr (SP2) {
            PG8_LDB(B0, 0, 0); PG8_LDB(B1, 0, 1); PG8_SCHED; PG8_LDA(At, 0, 0); PG8_STAGE(PG8_SA(1, 1), a1 + hstep, voffA);
            PG8_WAIT_V(8); PG8_WAIT_L(0); PG8_BAR; PG8_MMA(0, 0, At, B0); PG8_MMA(0, 1, At, B1); PG8_BAR; PG8_SCHED;
            PG8_LDA(At, 0, 1); PG8_STAGE(PG8_SB(0, 0), b2, voffB); PG8_STAGE(PG8_SB(0, 1), b2 + hstep, voffB); PG8_STAGE(PG8_SA(0, 0), a2, voffA);
            PG8_WAIT_V(8); PG8_WAIT_L(0); PG8_BAR; PG8_MMA(1, 0, At, B0); PG8_MMA(1, 1, At, B1); PG8_BAR; PG8_SCHED;
            PG8_LDB(B0, 1, 0); PG8_LDB(B1, 1, 1); PG8_SCHED; PG8_LDA(At, 1, 0); PG8_STAGE(PG8_SA(0, 1), a2 + hstep, voffA);
            PG8_WAIT_V(8); PG8_WAIT_L(0); PG8_BAR; PG8_MMA(0, 0, At, B0); PG8_MMA(0, 1, At, B1); PG8_BAR; PG8_SCHED;
            PG8_LDA(At, 1, 1); PG8_STAGE(PG8_SB(1, 0), b3, voffB); PG8_STAGE(PG8_SB(1, 1), b3 + hstep, voffB); PG8_STAGE(PG8_SA(1, 0), a3, voffA);
            PG8_WAIT_V(8); PG8_WAIT_L(0); PG8_BAR; PG8_MMA(1, 0, At, B0); PG8_MMA(1, 1, At, B1); PG8_BAR; PG8_SCHED;
            } else {
            PG8_LDB(B0, 0, 0); PG8_SCHED; PG8_LDA(At, 0, 0); PG8_STAGE(PG8_SA(1, 1), a1 + hstep, voffA);
            PG8_WAIT_L(8); PG8_BAR; PG8_WAIT_L(0); PG8_MMA(0, 0, At, B0); PG8_BAR; PG8_SCHED;
            PG8_LDB(B1, 0, 1); PG8_STAGE(PG8_SB(0, 0), b2, voffB);
            PG8_BAR; PG8_WAIT_L(0); PG8_MMA(0, 1, At, B1); PG8_BAR;
            PG8_LDA(At, 0, 1); PG8_STAGE(PG8_SA(0, 0), a2, voffA);
            PG8_BAR; PG8_WAIT_L(0); PG8_MMA(1, 0, At, B0); PG8_BAR; PG8_SCHED;
            PG8_STAGE(PG8_SB(0, 1), b2 + hstep, voffB);
            PG8_WAIT_V(6); PG8_BAR; PG8_MMA(1, 1, At, B1); PG8_BAR;
            PG8_LDB(B0, 1, 0); PG8_SCHED; PG8_LDA(At, 1, 0); PG8_STAGE(PG8_SA(0, 1), a2 + hstep, voffA);
            PG8_WAIT_L(8); PG8_BAR; PG8_WAIT_L(0); PG8_MMA(0, 0, At, B0); PG8_BAR; PG8_SCHED;
            PG8_LDB(B1, 1, 1); PG8_STAGE(PG8_SB(1, 0), b3, voffB);
            PG8_BAR; PG8_WAIT_L(0); PG8_MMA(0, 1, At, B1); PG8_BAR;
            PG8_LDA(At, 1, 1); PG8_STAGE(PG8_SA(1, 0), a3, voffA);
            PG8_BAR; PG8_WAIT_L(0); PG8_MMA(1, 0, At, B0); PG8_BAR; PG8_SCHED;
            PG8_STAGE(PG8_SB(1, 1), b3 + hstep, voffB);
            PG8_WAIT_V(6); PG8_BAR; PG8_MMA(1, 1, At, B1); PG8_BAR;
            }
        }
        if constexpr (ALIGN_EPI) { if (wr == 0) PG8_BAR; }
        if constexpr (!Epi::AFTER_DRAIN) { E(acc, cur, wr, wc, fr, fq); S.done(cur); }
        if (!has_next) break;
#pragma unroll
        for (int a = 0; a < 2; ++a)
#pragma unroll
            for (int b = 0; b < 2; ++b)
#pragma unroll
                for (int m = 0; m < 4; ++m)
#pragma unroll
                    for (int n = 0; n < 2; ++n) acc[a][b][m][n] = (f32x4){0.f, 0.f, 0.f, 0.f};
        cur = nxt; cA = nA; cB = nB; ++ui;
        if constexpr (ALIGN_EPI) { if (wr == 1) PG8_BAR; }
    }
    PG8_WAIT_V(0);
    if constexpr (!ALIGN_EPI) { if (wr == 0) PG8_BAR; }
    PG8_BAR;
    if constexpr (Epi::AFTER_DRAIN) { E.fused(acc, cur, wr, wc, fr, fq, lds, wid, lane); S.done(cur); }
#undef PG8_SA
#undef PG8_SB
#undef PG8_STAGE
#undef PG8_LDA
#undef PG8_LDB
#undef PG8_MMA
#undef PG8_WAIT_V
#undef PG8_WAIT_L
#undef PG8_BAR
#undef PG8_SCHED
}
}

#define LAS __attribute__((address_space(3)))
#define GAS __attribute__((address_space(1)))
typedef unsigned short bf16_t;
typedef short bf16x8 __attribute__((ext_vector_type(8)));
typedef float f32x4 __attribute__((ext_vector_type(4)));
typedef float f32x16 __attribute__((ext_vector_type(16)));
typedef float f32x2 __attribute__((ext_vector_type(2)));
typedef unsigned u32x4 __attribute__((ext_vector_type(4)));
typedef unsigned u32x2 __attribute__((ext_vector_type(2)));
constexpr int DM = 1024, SEQ = 16384, CTXL = 256, NLAT = 32768, TROWS = 33280, NK = SEQ + CTXL, DFF = 2816, INW = 2560, NMODW = 9216;
constexpr size_t MiB = (size_t)1 << 20;
constexpr size_t WS_MOD = 0, WS_LAM = 512 * 1024, WS_STATS = 3 * 512 * 1024 + 1024 * 1024 * 0, WS_XCNT = 768 * 1024, WS_XBAR = 800 * 1024, WS_ROPE = 1 * MiB, WS_XCTX = 2 * MiB, WS_W = 4 * MiB, WS_H = 84 * MiB, WS_BIG = 149 * MiB;
constexpr size_t W_GU1 = 0, W_DN1 = 11534336, W_IN = 17301504, W_OUT = 22544384, W_GU2 = 24641536, W_DN2 = 36175872, W_LAYER = 41943040;
constexpr size_t QU = 8519680;
constexpr size_t WS_ACT = WS_BIG, WS_Z = WS_BIG, WS_Y = WS_BIG + 163 * MiB, WS_QKV = WS_BIG + 228 * MiB;
constexpr size_t O_QA = 0, O_KA = 2 * QU, O_VAT = 4 * QU, O_QC = 6 * QU, O_KC = 8 * QU, O_VCT = 9 * QU, O_QD = 10 * QU, O_KD = 12 * QU, O_VDT = 13 * QU;
constexpr size_t WS_END = WS_QKV + 14 * QU;
constexpr int LDS_BYTES = 147456, LDS_RANK_OFF = 147440, LDS_XB_OFF = 147444;
constexpr float LOG2E = 1.4426950408889634f;
constexpr float QSCALE_A = 0.17677669529663687f * LOG2E;
constexpr float QSCALE_H = 0.125f * LOG2E;

struct Params { const float* in[23]; float* out; unsigned char* ws; };

__device__ __forceinline__ float bf2f(unsigned v) { return __uint_as_float(v << 16); }
typedef float f32x2_t __attribute__((ext_vector_type(2))); typedef __bf16 bf16x2_t __attribute__((ext_vector_type(2)));
__device__ __forceinline__ unsigned cvtpk(float lo, float hi) { f32x2_t v = {lo, hi}; bf16x2_t b = __builtin_convertvector(v, bf16x2_t); return __builtin_bit_cast(unsigned, b); }
__device__ __forceinline__ float wave_sum(float v) {
#pragma unroll
    for (int o = 1; o < 64; o <<= 1) v += __shfl_xor(v, o);
    return v;
}
__device__ __forceinline__ float xhalf_max(float v) { auto rr = __builtin_amdgcn_permlane32_swap(__float_as_uint(v), __float_as_uint(v), false, false); return fmaxf(__uint_as_float(rr[0]), __uint_as_float(rr[1])); }
__device__ __forceinline__ float xhalf_sum(float v) { auto rr = __builtin_amdgcn_permlane32_swap(__float_as_uint(v), __float_as_uint(v), false, false); return __uint_as_float(rr[0]) + __uint_as_float(rr[1]); }
__device__ __forceinline__ int crow(int r, int hi) { return (r & 3) + 8 * (r >> 2) + 4 * hi; }

__device__ __forceinline__ void transpose_item(const float* W, int K, int N, bf16_t* WT, bool gu, LAS float* scr, int item, int lane) {
    const int nblk = N / 32, kb = item / nblk, nb = item % nblk, k0 = 64 * kb, n0 = 32 * nb;
    int rbase = n0;
    if (gu) { const int half = n0 >= DFF ? 1 : 0, j0 = n0 - half * DFF; rbase = (j0 >> 7) * 256 + half * 128 + (j0 & 127); }
#pragma unroll 8
    for (int i = 0; i < 32; ++i) { const int kk = 2 * i + (lane >> 5); scr[kk * 33 + (lane & 31)] = W[(size_t)(k0 + kk) * N + n0 + (lane & 31)]; }
    asm volatile("s_waitcnt lgkmcnt(0)" ::: "memory");
    const int c = lane & 7;
#pragma unroll
    for (int j = 0; j < 4; ++j) { const int n = (lane >> 3) + 8 * j; const LAS float* s = scr + (8 * c) * 33 + n;
        u32x4 o; o.x = cvtpk(s[0 * 33], s[1 * 33]); o.y = cvtpk(s[2 * 33], s[3 * 33]); o.z = cvtpk(s[4 * 33], s[5 * 33]); o.w = cvtpk(s[6 * 33], s[7 * 33]);
        *(u32x4*)(WT + (size_t)(rbase + n) * K + k0 + 8 * c) = o; }
    asm volatile("s_waitcnt lgkmcnt(0)" ::: "memory");
}
__device__ __forceinline__ void dsincos(double a, float& c, float& s) {
    const double TWO_PI = 6.283185307179586476925286766559;
    const double k = __builtin_rint(a / TWO_PI); double r = a - k * TWO_PI;
    const double r2 = r * r; double tc = 1.0, ts = r, sc = 1.0, ss = r;
#pragma unroll 1
    for (int i = 1; i <= 16; ++i) { tc = -tc * r2 / (double)((2 * i - 1) * (2 * i)); ts = -ts * r2 / (double)((2 * i) * (2 * i + 1)); sc += tc; ss += ts; }
    c = (float)sc; s = (float)ss;
}
__device__ __forceinline__ void prologue(const Params& P, LAS unsigned char* lds) {
    int tid_ = threadIdx.x; asm volatile("" : "+v"(tid_)); const int tid = tid_, lane = tid & 63, wave = __builtin_amdgcn_readfirstlane(tid >> 6);
    GAS unsigned char* wsg_ = (GAS unsigned char*)P.ws; asm volatile("" : "+s"(wsg_)); unsigned char* ws = (unsigned char*)wsg_;
    LAS float* sv = (LAS float*)(lds + 69632); LAS float* red = sv + 3072;
    for (int k = tid; k < 3072; k += 512) { const int s = k >> 10, kk = k & 1023; const float c = s < 2 ? P.in[1][s * 1024 + kk] : P.in[3][kk]; sv[k] = c / (1.0f + __expf(-c)); }
    __syncthreads();
    float* mod = (float*)(ws + WS_MOD);
    for (int it = blockIdx.x; it < 288; it += gridDim.x) {
        const int l = it / 144, n0 = (it % 144) * 64;
        const float* w = P.in[4] + (size_t)l * 1024 * NMODW + (size_t)(wave * 128) * NMODW + n0 + lane;
        float a0 = 0.f, a1 = 0.f, a2 = 0.f;
#pragma unroll 8
        for (int k = 0; k < 128; ++k) { const float wv = w[(size_t)k * NMODW]; const int kk = wave * 128 + k; a0 += sv[kk] * wv; a1 += sv[1024 + kk] * wv; a2 += sv[2048 + kk] * wv; }
        red[(wave * 3 + 0) * 64 + lane] = a0; red[(wave * 3 + 1) * 64 + lane] = a1; red[(wave * 3 + 2) * 64 + lane] = a2;
        __syncthreads();
        if (tid < 192) { const int s = tid >> 6, ln = tid & 63; float t = 0.f;
#pragma unroll
            for (int w8 = 0; w8 < 8; ++w8) t += red[(w8 * 3 + s) * 64 + ln];
            mod[(size_t)(l * 3 + s) * NMODW + n0 + ln] = t + P.in[5][l * NMODW + n0 + ln]; }
        __syncthreads();
    }
    { const int gt = blockIdx.x * 512 + tid; float* rope = (float*)(ws + WS_ROPE);
      if (gt < 6144) { const int pos = gt / 24, f = gt % 24; double inv;
          if (f < 8) { inv = 1.0; for (int i = 0; i < (f >> 1); ++i) inv *= 0.1; if (f & 1) inv *= 0.31622776601683794; }
          else { const int i4 = f - 8; inv = 1.0; for (int i = 0; i < (i4 >> 2); ++i) inv *= 0.1; const int rm = i4 & 3; inv *= (rm == 0 ? 1.0 : rm == 1 ? 0.5623413251903491 : rm == 2 ? 0.31622776601683794 : 0.1778279410038923); }
          const float invf = (float)inv; const float ang = (float)pos * invf; float c, s; dsincos((double)ang, c, s);
          if (f < 8) { rope[pos * 8 + f] = c; rope[2048 + pos * 8 + f] = s; } else { rope[4096 + pos * 16 + (f - 8)] = c; rope[8192 + pos * 16 + (f - 8)] = s; } }
      if (gt == 6144 || gt == 6145) { const int l = gt - 6144; float s1 = 0.f, s2 = 0.f;
          for (int i = 0; i < 32; ++i) { s1 += P.in[13][l * 32 + i] * P.in[14][l * 32 + i]; s2 += P.in[15][l * 32 + i] * P.in[16][l * 32 + i]; }
          const float li = l == 0 ? 0.2f : 0.35550906759097f; ((float*)(ws + WS_LAM))[l] = expf(s1) - expf(s2) + li; } }
    { LAS float* scr = (LAS float*)(lds + wave * 8448);
      const int gw = blockIdx.x * 8 + wave, NGW = gridDim.x * 8;
      constexpr int I_GU = 16 * 176, I_DN = 44 * 32, I_IN = 16 * 80, I_OUT = 16 * 32, I_LAYER = 2 * I_GU + 2 * I_DN + I_IN + I_OUT;
      for (int it = gw; it < 2 * I_LAYER; it += NGW) {
          const int l = it / I_LAYER; int r = it % I_LAYER; unsigned char* wl = ws + WS_W + (size_t)l * W_LAYER;
          if (r < I_GU) { transpose_item(P.in[8] + (size_t)l * DM * 2 * DFF, DM, 2 * DFF, (bf16_t*)(wl + W_GU1), true, scr, r, lane); continue; } r -= I_GU;
          if (r < I_GU) { transpose_item(P.in[21] + (size_t)l * DM * 2 * DFF, DM, 2 * DFF, (bf16_t*)(wl + W_GU2), true, scr, r, lane); continue; } r -= I_GU;
          if (r < I_DN) { transpose_item(P.in[9] + (size_t)l * DFF * DM, DFF, DM, (bf16_t*)(wl + W_DN1), false, scr, r, lane); continue; } r -= I_DN;
          if (r < I_DN) { transpose_item(P.in[22] + (size_t)l * DFF * DM, DFF, DM, (bf16_t*)(wl + W_DN2), false, scr, r, lane); continue; } r -= I_DN;
          if (r < I_IN) { transpose_item(P.in[10] + (size_t)l * DM * INW, DM, INW, (bf16_t*)(wl + W_IN), false, scr, r, lane); continue; } r -= I_IN;
          transpose_item(P.in[11] + (size_t)l * DM * DM, DM, DM, (bf16_t*)(wl + W_OUT), false, scr, r, lane);
      } }
}

template <bool LN>
__device__ __forceinline__ void row_pass(const Params& P, int nrows, const float* gam, const float* bet, const float* shift0, const float* scale0, bool write_h, bool write_x) {
    int tid_ = threadIdx.x; asm volatile("" : "+v"(tid_)); const int tid = tid_, lane = tid & 63, wave = __builtin_amdgcn_readfirstlane(tid >> 6);
    const int gw = blockIdx.x * 8 + wave, NGW = gridDim.x * 8;
    GAS unsigned char* wsg_ = (GAS unsigned char*)P.ws; asm volatile("" : "+s"(wsg_)); unsigned char* ws = (unsigned char*)wsg_;
    float* xctx = (float*)(ws + WS_XCTX); bf16_t* H = (bf16_t*)(ws + WS_H); float* stats = (float*)(ws + WS_STATS);
    f32x4 sh[4], sc[4], g4[4], b4[4]; int curset = -1;
#pragma unroll
    for (int j = 0; j < 4; ++j) { sh[j] = (f32x4){0.f, 0.f, 0.f, 0.f}; sc[j] = sh[j]; g4[j] = sh[j]; b4[j] = sh[j]; }
    if (LN) {
#pragma unroll
        for (int j = 0; j < 4; ++j) { g4[j] = *(const f32x4*)(gam + 4 * lane + 256 * j); b4[j] = *(const f32x4*)(bet + 4 * lane + 256 * j); } }
    for (int r = gw; r < nrows; r += NGW) {
        const int set = r < SEQ ? 0 : (r < NLAT ? 1 : 2);
        if (write_h && set != curset) { curset = set;
#pragma unroll
            for (int j = 0; j < 4; ++j) { sh[j] = *(const f32x4*)(shift0 + set * NMODW + 4 * lane + 256 * j); sc[j] = *(const f32x4*)(scale0 + set * NMODW + 4 * lane + 256 * j); } }
        float* dst = r < NLAT ? P.out + (size_t)r * DM : xctx + (size_t)(r - NLAT) * DM;
        const float* src = LN ? dst : (r < NLAT ? P.in[0] + (size_t)r * DM : P.in[2] + (size_t)(r - NLAT) * DM);
        f32x4 v[4];
#pragma unroll
        for (int j = 0; j < 4; ++j) v[j] = *(const f32x4*)(src + 4 * lane + 256 * j);
        if (LN) {
            float s = 0.f;
#pragma unroll
            for (int j = 0; j < 4; ++j) s += (v[j][0] + v[j][1]) + (v[j][2] + v[j][3]);
            const float mean = wave_sum(s) * (1.0f / DM); float s2 = 0.f;
#pragma unroll
            for (int j = 0; j < 4; ++j) { v[j] = v[j] - mean; s2 += (v[j][0] * v[j][0] + v[j][1] * v[j][1]) + (v[j][2] * v[j][2] + v[j][3] * v[j][3]); }
            const float rstd = 1.0f / sqrtf(wave_sum(s2) * (1.0f / DM) + 1e-6f);
            if (!write_x && lane == 0) *(f32x2*)(stats + 2 * (size_t)r) = (f32x2){mean, rstd};
#pragma unroll
            for (int j = 0; j < 4; ++j) v[j] = v[j] * rstd * g4[j] + b4[j];
        }
        if (write_x) {
#pragma unroll
            for (int j = 0; j < 4; ++j) *(f32x4*)(dst + 4 * lane + 256 * j) = v[j]; }
        if (write_h) {
#pragma unroll
            for (int j = 0; j < 4; ++j) { const f32x4 h = v[j] * (sc[j] + 1.0f) + sh[j]; u32x2 o; o.x = cvtpk(h[0], h[1]); o.y = cvtpk(h[2], h[3]);
                *(u32x2*)(H + (size_t)r * DM + 4 * lane + 256 * j) = o; } }
    }
}

__device__ __forceinline__ void rope4(float (&v)[4], const float* ctab, const float* stab, bool odd, int xmask) {
    const f32x4 c = *(const f32x4*)ctab, s = *(const f32x4*)stab;
#pragma unroll
    for (int e = 0; e < 4; ++e) { const float p = __shfl_xor(v[e], xmask); v[e] = v[e] * c[e] + (odd ? p : -p) * s[e]; }
}
__device__ __forceinline__ void up4(const u32x2 raw, float (&v)[4]) { v[0] = bf2f(raw.x & 0xffffu); v[1] = bf2f(raw.x >> 16); v[2] = bf2f(raw.y & 0xffffu); v[3] = bf2f(raw.y >> 16); }
__device__ __forceinline__ void ld4(const bf16_t* p, float (&v)[4]) { const u32x2 raw = *(const u32x2*)p; v[0] = bf2f(raw.x & 0xffffu); v[1] = bf2f(raw.x >> 16); v[2] = bf2f(raw.y & 0xffffu); v[3] = bf2f(raw.y >> 16); }
__device__ __forceinline__ void st4(bf16_t* p, const float (&v)[4], float sc) { u32x2 o; o.x = cvtpk(v[0] * sc, v[1] * sc); o.y = cvtpk(v[2] * sc, v[3] * sc); *(u32x2*)p = o; }
__device__ __forceinline__ void st4lds(LAS bf16_t* p, const float (&v)[4]) { u32x2 o; o.x = cvtpk(v[0], v[1]); o.y = cvtpk(v[2], v[3]); *(LAS u32x2*)p = o; }

__device__ __forceinline__ void zpost_phase(const Params& P, LAS unsigned char* lds, int l) {
    int tid_ = threadIdx.x; asm volatile("" : "+v"(tid_)); const int tid = tid_, lane = tid & 63, wave = __builtin_amdgcn_readfirstlane(tid >> 6);
    GAS unsigned char* wsg_ = (GAS unsigned char*)P.ws; asm volatile("" : "+s"(wsg_)); unsigned char* ws = (unsigned char*)wsg_;
    const bf16_t* Z = (const bf16_t*)(ws + WS_Z); bf16_t* Y = (bf16_t*)(ws + WS_Y); unsigned char* qkv = ws + WS_QKV;
    bf16_t *QA = (bf16_t*)(qkv + O_QA), *KA = (bf16_t*)(qkv + O_KA), *VAT = (bf16_t*)(qkv + O_VAT), *QC = (bf16_t*)(qkv + O_QC), *KC = (bf16_t*)(qkv + O_KC), *VCT = (bf16_t*)(qkv + O_VCT),
           *QD = (bf16_t*)(qkv + O_QD), *KD = (bf16_t*)(qkv + O_KD), *VDT = (bf16_t*)(qkv + O_VDT);
    const float* rope = (const float*)(ws + WS_ROPE);
    const float* convw = P.in[12] + l * 768; const float* qnw = P.in[19] + l * 64; const float* knw = P.in[20] + l * 64;
    LAS bf16_t* vt = (LAS bf16_t*)lds;
    for (int u = blockIdx.x; u < 1040; u += gridDim.x) {
        const int b = u / 520, kt = u % 520, kk0 = kt * 32; const bool isctx = kt < 8;
        __syncthreads();
        for (int ii = 0; ii < 4; ++ii) {
            const int i = wave * 4 + ii, kk = kk0 + i;
            const int r = isctx ? NLAT + b * CTXL + kk : b * SEQ + kk - CTXL;
            const int t = kk - CTXL, prow = (t >> 6) & 255, pcol = t & 63;
            const bf16_t* z = Z + (size_t)r * INW;
            float v[4];
            const int lkk = lane & 31;
            const bool hasp_ = isctx ? (kk > 0) : (t > 0), hasn_ = isctx ? (kk < CTXL - 1) : (t < SEQ - 1);
            u32x2 zr[16];
            zr[0] = *(const u32x2*)(z + 4 * lane); zr[1] = *(const u32x2*)(z + 256 + 4 * lane); zr[2] = *(const u32x2*)(z + 512 + 4 * lane);
            zr[3] = *(const u32x2*)(z + 768 + 4 * lane); zr[4] = *(const u32x2*)(z + 1024 + 4 * lane); zr[5] = *(const u32x2*)(z + 1280 + 4 * lane);
            zr[6] = (u32x2){0u, 0u}; zr[7] = zr[6]; zr[8] = zr[6]; zr[9] = zr[6];
            if (hasp_) { zr[6] = *(const u32x2*)(z - INW + 1024 + 4 * lane); zr[7] = *(const u32x2*)(z - INW + 1280 + 4 * lane); }
            if (hasn_) { zr[8] = *(const u32x2*)(z + INW + 1024 + 4 * lane); zr[9] = *(const u32x2*)(z + INW + 1280 + 4 * lane); }
            zr[10] = *(const u32x2*)(z + 1536 + 4 * lane); zr[11] = *(const u32x2*)(z + 1792 + 4 * lkk); zr[12] = *(const u32x2*)(z + 1920 + 4 * lkk);
            zr[13] = *(const u32x2*)(z + 2048 + 4 * lane); zr[14] = *(const u32x2*)(z + 2304 + 4 * lkk); zr[15] = *(const u32x2*)(z + 2432 + 4 * lkk);
            { const int h = lane >> 4, c = (4 * lane) & 63, quarter = (lane & 7) >> 1, e0 = (lane & 1) * 4; const int pos = quarter < 2 ? prow : pcol;
              const float* ct = rope + pos * 8 + e0; const float* st = rope + 2048 + pos * 8 + e0;
              up4(zr[0], v); if (!isctx) rope4(v, ct, st, quarter & 1, 2);
              st4(QA + ((size_t)(b * 4 + h) * NK + kk) * 64 + c, v, QSCALE_A);
              up4(zr[1], v); if (!isctx) rope4(v, ct, st, quarter & 1, 2);
              st4(KA + ((size_t)(b * 4 + h) * NK + kk) * 64 + c, v, 1.0f);
              up4(zr[2], v); st4lds(vt + i * 520 + 4 * lane, v); }
            { const bool hasp = isctx ? (kk > 0) : (t > 0), hasn = isctx ? (kk < CTXL - 1) : (t < SEQ - 1);
              float gb[4], gc[4], uu[4], hm[4], hp[4]; up4(zr[3], gb); up4(zr[4], gc); up4(zr[5], uu);
#pragma unroll
              for (int e = 0; e < 4; ++e) { hm[e] = 0.f; hp[e] = 0.f; }
              if (hasp) { float a[4], c2[4]; up4(zr[6], a); up4(zr[7], c2);
#pragma unroll
                  for (int e = 0; e < 4; ++e) hm[e] = a[e] * c2[e]; }
              if (hasn) { float a[4], c2[4]; up4(zr[8], a); up4(zr[9], c2);
#pragma unroll
                  for (int e = 0; e < 4; ++e) hp[e] = a[e] * c2[e]; }
              const f32x4 w0 = *(const f32x4*)(convw + 4 * lane), w1 = *(const f32x4*)(convw + 256 + 4 * lane), w2 = *(const f32x4*)(convw + 512 + 4 * lane);
#pragma unroll
              for (int e = 0; e < 4; ++e) v[e] = gb[e] * (w0[e] * hm[e] + w1[e] * (gc[e] * uu[e]) + w2[e] * hp[e]);
              st4(Y + (size_t)r * DM + 256 + 4 * lane, v, 1.0f); }
            { const int hq = lane >> 4, c = (4 * lane) & 63, quarter = (lane & 15) >> 2, e0 = (lane & 3) * 4; const int pos = quarter < 2 ? prow : pcol;
              const float* ct = rope + 4096 + pos * 16 + e0; const float* st = rope + 8192 + pos * 16 + e0;
              const int lk = lane & 31, hk = lk >> 4;
              up4(zr[10], v); if (!isctx) rope4(v, ct, st, quarter & 1, 4);
              st4(QC + ((size_t)(b * 4 + hq) * NK + kk) * 64 + c, v, QSCALE_H);
              up4(zr[11], v); if (!isctx) rope4(v, ct, st, quarter & 1, 4);
              if (lane < 32) st4(KC + ((size_t)(b * 2 + hk) * NK + kk) * 64 + c, v, 1.0f);
              up4(zr[12], v); if (lane < 32) st4lds(vt + i * 520 + 256 + 4 * lk, v);
              up4(zr[13], v);
              { float ss = v[0] * v[0] + v[1] * v[1] + v[2] * v[2] + v[3] * v[3]; ss += __shfl_xor(ss, 1); ss += __shfl_xor(ss, 2); ss += __shfl_xor(ss, 4); ss += __shfl_xor(ss, 8);
                const float rs = 1.0f / sqrtf(ss * (1.0f / 64.0f) + 1e-6f); const f32x4 w = *(const f32x4*)(qnw + c);
#pragma unroll
                for (int e = 0; e < 4; ++e) v[e] = v[e] * rs * w[e]; }
              if (!isctx) rope4(v, ct, st, quarter & 1, 4);
              st4(QD + ((size_t)(b * 4 + hq) * NK + kk) * 64 + c, v, QSCALE_H);
              up4(zr[14], v);
              { float ss = v[0] * v[0] + v[1] * v[1] + v[2] * v[2] + v[3] * v[3]; ss += __shfl_xor(ss, 1); ss += __shfl_xor(ss, 2); ss += __shfl_xor(ss, 4); ss += __shfl_xor(ss, 8);
                const float rs = 1.0f / sqrtf(ss * (1.0f / 64.0f) + 1e-6f); const f32x4 w = *(const f32x4*)(knw + c);
#pragma unroll
                for (int e = 0; e < 4; ++e) v[e] = v[e] * rs * w[e]; }
              if (!isctx) rope4(v, ct, st, quarter & 1, 4);
              if (lane < 32) st4(KD + ((size_t)(b * 2 + hk) * NK + kk) * 64 + c, v, 1.0f);
              up4(zr[15], v); if (lane < 32) st4lds(vt + i * 520 + 384 + 4 * lk, v); }
        }
        __syncthreads();
#pragma unroll 2
        for (int it = 0; it < 4; ++it) { const int vc = it * 128 + (tid >> 2), g = tid & 3; bf16_t* dst;
          if (vc < 256) dst = VAT + ((size_t)(b * 4 + (vc >> 6)) * 64 + (vc & 63)) * NK;
          else if (vc < 384) dst = VCT + ((size_t)(b * 2 + ((vc - 256) >> 6)) * 64 + (vc & 63)) * NK;
          else dst = VDT + ((size_t)(b * 2 + ((vc - 384) >> 6)) * 64 + (vc & 63)) * NK;
          unsigned w[4];
#pragma unroll
          for (int i2 = 0; i2 < 4; ++i2) { const int ia = 2 * i2, ib = 2 * i2 + 1;
              const int ta = 16 * (g >> 1) + 8 * (ia >> 2) + 4 * (g & 1) + (ia & 3), tb = 16 * (g >> 1) + 8 * (ib >> 2) + 4 * (g & 1) + (ib & 3);
              w[i2] = (unsigned)vt[ta * 520 + vc] | ((unsigned)vt[tb * 520 + vc] << 16); }
          *(u32x4*)(dst + kk0 + 8 * g) = (u32x4){w[0], w[1], w[2], w[3]}; }
    }
}

__device__ __forceinline__ float fmax3(float a, float b, float c) { float r; asm("v_max3_f32 %0, %1, %2, %3" : "=v"(r) : "v"(a), "v"(b), "v"(c)); return r; }
__device__ __forceinline__ void g2_first(f32x16& acc, bf16x8 a, bf16x8 b, const f32x16& c, float& e0, float& e1, float& e2, float& e3, float p0, float p1, float p2, float p3) {
    asm volatile("s_nop 4\n\tv_mfma_f32_32x32x16_bf16 %0, %5, %6, %7\n\tv_exp_f32_e32 %1, %8\n\tv_exp_f32_e32 %2, %9\n\tv_exp_f32_e32 %3, %10\n\tv_exp_f32_e32 %4, %11\n\ts_nop 0"
                 : "=&v"(acc), "=&v"(e0), "=&v"(e1), "=&v"(e2), "=&v"(e3) : "v"(a), "v"(b), "v"(c), "v"(p0), "v"(p1), "v"(p2), "v"(p3)); }
__device__ __forceinline__ void g2_acc(f32x16& acc, bf16x8 a, bf16x8 b, float& e0, float& e1, float& e2, float& e3, float p0, float p1, float p2, float p3) {
    asm volatile("v_mfma_f32_32x32x16_bf16 %0, %5, %6, %0\n\tv_exp_f32_e32 %1, %7\n\tv_exp_f32_e32 %2, %8\n\tv_exp_f32_e32 %3, %9\n\tv_exp_f32_e32 %4, %10\n\ts_nop 0"
                 : "+v"(acc), "=&v"(e0), "=&v"(e1), "=&v"(e2), "=&v"(e3) : "v"(a), "v"(b), "v"(p0), "v"(p1), "v"(p2), "v"(p3)); }
__device__ __forceinline__ void g2_none(float& e0, float& e1, float& e2, float& e3, float p0, float p1, float p2, float p3) {
    asm volatile("v_exp_f32_e32 %0, %4\n\tv_exp_f32_e32 %1, %5\n\tv_exp_f32_e32 %2, %6\n\tv_exp_f32_e32 %3, %7\n\ts_nop 0"
                 : "=&v"(e0), "=&v"(e1), "=&v"(e2), "=&v"(e3) : "v"(p0), "v"(p1), "v"(p2), "v"(p3)); }
__device__ __forceinline__ bf16x8 pack8(const f32x16& e, int b) { const u32x4 t = (u32x4){cvtpk(e[b], e[b + 1]), cvtpk(e[b + 2], e[b + 3]), cvtpk(e[b + 4], e[b + 5]), cvtpk(e[b + 6], e[b + 7])}; return __builtin_bit_cast(bf16x8, t); }
__device__ __forceinline__ float sum4(const f32x16& e, int b) { return (e[b] + e[b + 1]) + (e[b + 2] + e[b + 3]); }
__device__ __forceinline__ void g1_a0(f32x16& o, bf16x8 vf, bf16x8 pw, float& ps, float a0, float a1, float a2, float a3) {
    asm volatile("s_nop 1\n\tv_mfma_f32_32x32x16_bf16 %0, %2, %3, %0\n\tv_add_f32_e32 %1, %1, %4\n\tv_add_f32_e32 %1, %1, %5\n\tv_add_f32_e32 %1, %1, %6\n\tv_add_f32_e32 %1, %1, %7"
                 : "+v"(o), "+v"(ps) : "v"(vf), "v"(pw), "v"(a0), "v"(a1), "v"(a2), "v"(a3)); }
__device__ __forceinline__ void g1_b0(f32x16& o, bf16x8 vf, bf16x8 pw, float& ps, float a0, float a1, float a2, float a3,
                                      unsigned& w0, unsigned& w1, unsigned& w2, unsigned& w3, float c0, float c1, float c2, float c3, float c4, float c5, float c6, float c7) {
    asm volatile("s_nop 1\n\tv_mfma_f32_32x32x16_bf16 %0, %6, %7, %0\n\tv_add_f32_e32 %1, %1, %8\n\tv_add_f32_e32 %1, %1, %9\n\tv_add_f32_e32 %1, %1, %10\n\tv_add_f32_e32 %1, %1, %11\n\t"
                 "v_cvt_pk_bf16_f32 %2, %12, %13\n\tv_cvt_pk_bf16_f32 %3, %14, %15\n\tv_cvt_pk_bf16_f32 %4, %16, %17\n\tv_cvt_pk_bf16_f32 %5, %18, %19"
                 : "+v"(o), "+v"(ps), "=&v"(w0), "=&v"(w1), "=&v"(w2), "=&v"(w3)
                 : "v"(vf), "v"(pw), "v"(a0), "v"(a1), "v"(a2), "v"(a3), "v"(c0), "v"(c1), "v"(c2), "v"(c3), "v"(c4), "v"(c5), "v"(c6), "v"(c7)); }
__device__ __forceinline__ void g1_a(f32x16& o, bf16x8 vf, bf16x8 pw, float& mx, float m0, float m1, float m2, float m3, float& ps, float a0, float a1, float a2, float a3) {
    asm volatile("s_nop 1\n\tv_mfma_f32_32x32x16_bf16 %0, %3, %4, %0\n\tv_max3_f32 %1, %1, %5, %6\n\tv_max3_f32 %1, %1, %7, %8\n\t"
                 "v_add_f32_e32 %2, %2, %9\n\tv_add_f32_e32 %2, %2, %10\n\tv_add_f32_e32 %2, %2, %11\n\tv_add_f32_e32 %2, %2, %12"
                 : "+v"(o), "+v"(mx), "+v"(ps) : "v"(vf), "v"(pw), "v"(m0), "v"(m1), "v"(m2), "v"(m3), "v"(a0), "v"(a1), "v"(a2), "v"(a3)); }
__device__ __forceinline__ void g1_b(f32x16& o, bf16x8 vf, bf16x8 pw, float& mx, float m0, float m1, float m2, float m3, float& ps, float a0, float a1, float a2, float a3,
                                     unsigned& w0, unsigned& w1, unsigned& w2, unsigned& w3, float c0, float c1, float c2, float c3, float c4, float c5, float c6, float c7) {
    asm volatile("s_nop 1\n\tv_mfma_f32_32x32x16_bf16 %0, %7, %8, %0\n\tv_max3_f32 %1, %1, %9, %10\n\tv_max3_f32 %1, %1, %11, %12\n\t"
                 "v_add_f32_e32 %2, %2, %13\n\tv_add_f32_e32 %2, %2, %14\n\tv_add_f32_e32 %2, %2, %15\n\tv_add_f32_e32 %2, %2, %16\n\t"
                 "v_cvt_pk_bf16_f32 %3, %17, %18\n\tv_cvt_pk_bf16_f32 %4, %19, %20\n\tv_cvt_pk_bf16_f32 %5, %21, %22\n\tv_cvt_pk_bf16_f32 %6, %23, %24"
                 : "+v"(o), "+v"(mx), "+v"(ps), "=&v"(w0), "=&v"(w1), "=&v"(w2), "=&v"(w3)
                 : "v"(vf), "v"(pw), "v"(m0), "v"(m1), "v"(m2), "v"(m3), "v"(a0), "v"(a1), "v"(a2), "v"(a3), "v"(c0), "v"(c1), "v"(c2), "v"(c3), "v"(c4), "v"(c5), "v"(c6), "v"(c7)); }
struct AttnPtrs { const bf16_t* Q; const bf16_t* K; const bf16_t* Vt; bf16_t* Y; const float* subw; const float* sink; float lam; float oml; };
template <int MODE>
__device__ __forceinline__ void attn_unit(LAS unsigned char* lds, const AttnPtrs& A, int b, int head, int qt) {
    int tid_ = threadIdx.x; asm volatile("" : "+v"(tid_)); const int tid = tid_, lane = tid & 63, r32 = lane & 31, hi = lane >> 5;
    const int wid = __builtin_amdgcn_readfirstlane(tid >> 6), sub = wid >> 2, rq = (wid & 3) * 32;
    constexpr int DQ = (MODE == 0) ? 32 : 64, NCH = DQ / 16, NKVH = (MODE == 0) ? 4 : 2;
    constexpr int KBUF = 9216, VBUF = 9216, VS0 = 4 * KBUF, XB0 = VS0 + 5 * VBUF;
    constexpr float THR = 8.0f;
    const int q0 = qt * 128;
    const int qhead = (MODE == 0) ? head : head * 2 + sub;
    const int doff = (MODE == 0) ? sub * 32 : 0;
    const bf16_t* Qrow = A.Q + ((size_t)(b * 4 + qhead) * NK + q0 + rq + r32) * 64 + doff;
    const bf16_t* Kb = A.K + (size_t)(b * NKVH + head) * NK * 64;
    const bf16_t* Vb = A.Vt + (size_t)(b * NKVH + head) * 64 * NK;
    bf16x8 qf[NCH];
#pragma unroll
    for (int j = 0; j < NCH; ++j) qf[j] = *(const bf16x8*)(Qrow + 16 * j + 8 * hi);
    int lo = 4, hit = 4;
    if (qt >= 2) { if (MODE == 1) { lo = (q0 - 128) >> 6; if (lo < 4) lo = 4; hit = (q0 + 256) >> 6; if (hit > 260) hit = 260; } else { hit = 260; } }
    const int nsteps = 4 + hit - lo;
#define ATT_TILE(s) ((s) < 4 ? (s) : lo + (s) - 4)
    const int srow = tid >> 3, sch = tid & 7;
    const bf16_t* kg = Kb + (size_t)srow * 64 + sch * 8;
    const bf16_t* vg = Vb + (size_t)srow * NK + sch * 8;
    const unsigned sofs = srow * 144 + sch * 16;
    LAS unsigned char* Ks = lds; LAS unsigned char* Vs = lds + VS0;
    const LAS unsigned char* kp0 = Ks + r32 * 144 + (doff + 8 * hi) * 2;
    const LAS unsigned char* vp0 = Vs + r32 * 144 + hi * 16;
    const int qrel = q0 + rq + r32;
    f32x16 negm, p0, p1, o0, o1;
#pragma unroll
    for (int r = 0; r < 16; ++r) { negm[r] = 0.f; o0[r] = 0.f; o1[r] = 0.f; }
    asm volatile("" : "+v"(negm));
#define ATT_QK(D0, D1, kbuf) do { const LAS unsigned char* kp_ = kp0 + (kbuf) * KBUF; \
        _Pragma("unroll") for (int j = 0; j < NCH; ++j) { const bf16x8 k0_ = *(const LAS bf16x8*)(kp_ + j * 32); const bf16x8 k1_ = *(const LAS bf16x8*)(kp_ + 32 * 144 + j * 32); \
            if (j == 0) { D0 = __builtin_amdgcn_mfma_f32_32x32x16_bf16(k0_, qf[0], negm, 0, 0, 0); D1 = __builtin_amdgcn_mfma_f32_32x32x16_bf16(k1_, qf[0], negm, 0, 0, 0); } \
            else { D0 = __builtin_amdgcn_mfma_f32_32x32x16_bf16(k0_, qf[j], D0, 0, 0, 0); D1 = __builtin_amdgcn_mfma_f32_32x32x16_bf16(k1_, qf[j], D1, 0, 0, 0); } } } while (0)
#define ATT_MASK(D0, D1, s) do { if (MODE == 1 && (s) >= 4) { asm volatile("s_nop 7\n\ts_nop 3" ::: "memory");     \
        const int db_ = (lo + (s) - 4) * 64 - qrel; \
        _Pragma("unroll") for (int r = 0; r < 16; ++r) { const int d0_ = db_ + crow(r, hi), d1_ = d0_ + 32; \
            if (d0_ > 128 || d0_ < -128) D0[r] = -1e30f; if (d1_ > 128 || d1_ < -128) D1[r] = -1e30f; } } } while (0)
#define ATT_LDK(s) (*(const u32x4*)(kg + (size_t)ATT_TILE(s) * 4096))
#define ATT_LDV(s) (*(const u32x4*)(vg + ATT_TILE(s) * 64))

    __syncthreads();
    u32x4 kqa = (u32x4){0u, 0u, 0u, 0u}, vqa = kqa, kqb = kqa, vqb = kqa;
    { const u32x4 k0r = ATT_LDK(0); const u32x4 v0r = ATT_LDV(0); const u32x4 k1r = ATT_LDK(1); const u32x4 k2r = ATT_LDK(2); const u32x4 v1r = ATT_LDV(1);
      kqb = ATT_LDK(3); vqb = ATT_LDV(2);
      *(LAS u32x4*)(Ks + sofs) = k0r; *(LAS u32x4*)(Vs + sofs) = v0r; *(LAS u32x4*)(Ks + KBUF + sofs) = k1r; *(LAS u32x4*)(Ks + 2 * KBUF + sofs) = k2r; *(LAS u32x4*)(Vs + VBUF + sofs) = v1r; }
    __syncthreads();
    f32x16 pb0, pb1;
    ATT_QK(p0, p1, 0);
    float m = 0.f, lsum = 0.f;
    int kb_cur = 0;
#define ATT_MAXUPD(S, P0, P1) do { \
        float mx = fmax3(fmax3(P0[0], P1[0], P0[1]), P1[1], P0[2]); \
        _Pragma("unroll") for (int r = 2; r < 14; r += 2) mx = fmax3(fmax3(mx, P1[r], P0[r + 1]), P1[r + 1], P0[r + 2]); \
        mx = fmax3(fmax3(mx, P1[14], P0[15]), P1[15], P1[15]); \
        mx = xhalf_max(mx); \
        if ((S) == 0 || __any(mx > THR)) { \
            const float dl = ((S) == 0) ? mx : fmaxf(mx, 0.f); \
            m += dl; \
            _Pragma("unroll") for (int r = 0; r < 16; ++r) { P0[r] -= dl; P1[r] -= dl; negm[r] = -m; } \
            asm volatile("" : "+v"(negm)); \
            if ((S) > 0) { const float f = __builtin_amdgcn_exp2f(-dl); lsum *= f; \
                _Pragma("unroll") for (int r = 0; r < 16; ++r) { o0[r] *= f; o1[r] *= f; } } \
        } } while (0)
#define ATT_EXPPACK(P0, P1, PW) do { \
        float ps = 0.f; \
        _Pragma("unroll") for (int r = 0; r < 16; ++r) { P0[r] = __builtin_amdgcn_exp2f(P0[r]); P1[r] = __builtin_amdgcn_exp2f(P1[r]); ps += P0[r] + P1[r]; } \
        lsum += ps; \
        { u32x4 t; \
          t.x = cvtpk(P0[0], P0[1]); t.y = cvtpk(P0[2], P0[3]); t.z = cvtpk(P0[4], P0[5]); t.w = cvtpk(P0[6], P0[7]); PW[0] = __builtin_bit_cast(bf16x8, t); \
          t.x = cvtpk(P0[8], P0[9]); t.y = cvtpk(P0[10], P0[11]); t.z = cvtpk(P0[12], P0[13]); t.w = cvtpk(P0[14], P0[15]); PW[1] = __builtin_bit_cast(bf16x8, t); \
          t.x = cvtpk(P1[0], P1[1]); t.y = cvtpk(P1[2], P1[3]); t.z = cvtpk(P1[4], P1[5]); t.w = cvtpk(P1[6], P1[7]); PW[2] = __builtin_bit_cast(bf16x8, t); \
          t.x = cvtpk(P1[8], P1[9]); t.y = cvtpk(P1[10], P1[11]); t.z = cvtpk(P1[12], P1[13]); t.w = cvtpk(P1[14], P1[15]); PW[3] = __builtin_bit_cast(bf16x8, t); } } while (0)
#define ATT_PV(PW, vslot) do { const LAS unsigned char* vp_ = vp0 + (vslot) * VBUF; \
        _Pragma("unroll") for (int c = 0; c < 4; ++c) { const bf16x8 v0_ = *(const LAS bf16x8*)(vp_ + c * 32); const bf16x8 v1_ = *(const LAS bf16x8*)(vp_ + 32 * 144 + c * 32); \
            o0 = __builtin_amdgcn_mfma_f32_32x32x16_bf16(v0_, PW[c], o0, 0, 0, 0); o1 = __builtin_amdgcn_mfma_f32_32x32x16_bf16(v1_, PW[c], o1, 0, 0, 0); } } while (0)
    bf16x8 pwk[4];
#pragma unroll
    for (int c = 0; c < 4; ++c) pwk[c] = (bf16x8){0, 0, 0, 0, 0, 0, 0, 0};
#define ATT_LDVF(VF, vslot) do { const LAS unsigned char* vp_ = vp0 + (vslot) * VBUF; \
        _Pragma("unroll") for (int c = 0; c < 4; ++c) { VF[2 * c] = *(const LAS bf16x8*)(vp_ + c * 32); VF[2 * c + 1] = *(const LAS bf16x8*)(vp_ + 32 * 144 + c * 32); } } while (0)
#define ATT_LDKF(KF, kslot) do { const LAS unsigned char* kp_ = kp0 + (kslot) * KBUF; \
        _Pragma("unroll") for (int j = 0; j < NCH; ++j) { KF[2 * j] = *(const LAS bf16x8*)(kp_ + j * 32); KF[2 * j + 1] = *(const LAS bf16x8*)(kp_ + 32 * 144 + j * 32); } } while (0)
#define ATT_PVF(VF, PW) do { \
        _Pragma("unroll") for (int c = 0; c < 4; ++c) { o0 = __builtin_amdgcn_mfma_f32_32x32x16_bf16(VF[2 * c], PW[c], o0, 0, 0, 0); o1 = __builtin_amdgcn_mfma_f32_32x32x16_bf16(VF[2 * c + 1], PW[c], o1, 0, 0, 0); } } while (0)
#define ATT_QKF(KF, D0, D1) do { \
        D0 = __builtin_amdgcn_mfma_f32_32x32x16_bf16(KF[0], qf[0], negm, 0, 0, 0); D1 = __builtin_amdgcn_mfma_f32_32x32x16_bf16(KF[1], qf[0], negm, 0, 0, 0); \
        _Pragma("unroll") for (int j = 1; j < NCH; ++j) { D0 = __builtin_amdgcn_mfma_f32_32x32x16_bf16(KF[2 * j], qf[j], D0, 0, 0, 0); D1 = __builtin_amdgcn_mfma_f32_32x32x16_bf16(KF[2 * j + 1], qf[j], D1, 0, 0, 0); } } while (0)
#define ATT_VV(P0, P1, i) ((i) < 16 ? P0[(i) & 15] : P1[(i) & 15])
#define ATT_MXOP(P0, P1, k) do { if ((k) == 0) mx_ = fmax3(P0[0], P0[1], P0[2]); else if ((k) == 15) mx_ = fmax3(mx_, P1[15], P1[15]); \
        else mx_ = fmax3(mx_, ATT_VV(P0, P1, 1 + 2 * (k)), ATT_VV(P0, P1, 2 + 2 * (k))); } while (0)
#define ATT_SB() __builtin_amdgcn_sched_barrier(0)
#define ATT_STEP(BAR, S, FIRST, CHK, P0, P1, N0, N1, KN, VN, KO, VO) do { \
        if (BAR) __syncthreads(); \
        const int kb_n1 = (kb_cur + 1) & 3; const int vb_prev = vb_cur == 0 ? 4 : vb_cur - 1; \
        { const int sk_ = (S) + 4 < nsteps ? (S) + 4 : nsteps - 1, sv_ = (S) + 3 < nsteps ? (S) + 3 : nsteps - 1;     \
          KN = ATT_LDK(sk_); VN = ATT_LDV(sv_); } \
        bf16x8 kf_[2 * NCH]; \
        float mx_; \
        if (!(FIRST)) { \
            if (BAR) { ATT_LDVF(vf_, vb_prev); }     \
            ATT_SB(); \
            __builtin_amdgcn_s_setprio(1); \
              \
            float ps_ = 0.f; mx_ = P0[0]; bf16x8 pwa_ = pack8(N0, 0), pwb_; unsigned w0_, w1_, w2_, w3_; \
            if (CHK) { \
            g1_a(o0, vf_[0], pwa_, mx_, P0[1], P0[2], P0[3], P0[4], ps_, N0[0], N0[1], N0[2], N0[3]); \
            g1_b(o1, vf_[1], pwa_, mx_, P0[5], P0[6], P0[7], P0[8], ps_, N0[4], N0[5], N0[6], N0[7], w0_, w1_, w2_, w3_, N0[8], N0[9], N0[10], N0[11], N0[12], N0[13], N0[14], N0[15]); \
            { const u32x4 t_ = (u32x4){w0_, w1_, w2_, w3_}; pwb_ = __builtin_bit_cast(bf16x8, t_); } \
            g1_a(o0, vf_[2], pwb_, mx_, P0[9], P0[10], P0[11], P0[12], ps_, N0[8], N0[9], N0[10], N0[11]); \
            g1_b(o1, vf_[3], pwb_, mx_, P0[13], P0[14], P0[15], P1[0], ps_, N0[12], N0[13], N0[14], N0[15], w0_, w1_, w2_, w3_, N1[0], N1[1], N1[2], N1[3], N1[4], N1[5], N1[6], N1[7]); \
            { const u32x4 t_ = (u32x4){w0_, w1_, w2_, w3_}; pwa_ = __builtin_bit_cast(bf16x8, t_); } \
            g1_a(o0, vf_[4], pwa_, mx_, P1[1], P1[2], P1[3], P1[4], ps_, N1[0], N1[1], N1[2], N1[3]); \
            g1_b(o1, vf_[5], pwa_, mx_, P1[5], P1[6], P1[7], P1[8], ps_, N1[4], N1[5], N1[6], N1[7], w0_, w1_, w2_, w3_, N1[8], N1[9], N1[10], N1[11], N1[12], N1[13], N1[14], N1[15]); \
            { const u32x4 t_ = (u32x4){w0_, w1_, w2_, w3_}; pwb_ = __builtin_bit_cast(bf16x8, t_); } \
            g1_a(o0, vf_[6], pwb_, mx_, P1[9], P1[10], P1[11], P1[12], ps_, N1[8], N1[9], N1[10], N1[11]); \
            g1_a(o1, vf_[7], pwb_, mx_, P1[13], P1[14], P1[15], P1[15], ps_, N1[12], N1[13], N1[14], N1[15]); \
            } else { \
            g1_a0(o0, vf_[0], pwa_, ps_, N0[0], N0[1], N0[2], N0[3]); \
            g1_b0(o1, vf_[1], pwa_, ps_, N0[4], N0[5], N0[6], N0[7], w0_, w1_, w2_, w3_, N0[8], N0[9], N0[10], N0[11], N0[12], N0[13], N0[14], N0[15]); \
            { const u32x4 t_ = (u32x4){w0_, w1_, w2_, w3_}; pwb_ = __builtin_bit_cast(bf16x8, t_); } \
            g1_a0(o0, vf_[2], pwb_, ps_, N0[8], N0[9], N0[10], N0[11]); \
            g1_b0(o1, vf_[3], pwb_, ps_, N0[12], N0[13], N0[14], N0[15], w0_, w1_, w2_, w3_, N1[0], N1[1], N1[2], N1[3], N1[4], N1[5], N1[6], N1[7]); \
            { const u32x4 t_ = (u32x4){w0_, w1_, w2_, w3_}; pwa_ = __builtin_bit_cast(bf16x8, t_); } \
            g1_a0(o0, vf_[4], pwa_, ps_, N1[0], N1[1], N1[2], N1[3]); \
            g1_b0(o1, vf_[5], pwa_, ps_, N1[4], N1[5], N1[6], N1[7], w0_, w1_, w2_, w3_, N1[8], N1[9], N1[10], N1[11], N1[12], N1[13], N1[14], N1[15]); \
            { const u32x4 t_ = (u32x4){w0_, w1_, w2_, w3_}; pwb_ = __builtin_bit_cast(bf16x8, t_); } \
            g1_a0(o0, vf_[6], pwb_, ps_, N1[8], N1[9], N1[10], N1[11]); \
            g1_a0(o1, vf_[7], pwb_, ps_, N1[12], N1[13], N1[14], N1[15]); \
            } \
            lsum += ps_; \
        } else { \
            _Pragma("unroll") for (int k = 0; k < 16; ++k) ATT_MXOP(P0, P1, k); \
        } \
        ATT_LDKF(kf_, kb_n1); \
        ATT_SB(); \
        if (CHK) { const float mx = xhalf_max(mx_); \
          if ((FIRST) || __any(mx > THR)) { \
            const float dl = (FIRST) ? mx : fmaxf(mx, 0.f); \
            m += dl; \
            _Pragma("unroll") for (int r = 0; r < 16; ++r) { P0[r] -= dl; P1[r] -= dl; negm[r] = -m; } \
            asm volatile("" : "+v"(negm)); \
            if (!(FIRST)) { asm volatile("s_nop 11" ::: "memory"); const float f = __builtin_amdgcn_exp2f(-dl); lsum *= f; \
                _Pragma("unroll") for (int r = 0; r < 16; ++r) { o0[r] *= f; o1[r] *= f; } } \
          } } \
        ATT_SB(); \
        { \
          _Pragma("unroll") for (int g = 0; g < 8; ++g) { \
            constexpr int GSTEP = 8 / (2 * NCH); \
            const float q0_ = g < 4 ? P0[(4 * g) & 15] : P1[(4 * g) & 15], q1_ = g < 4 ? P0[(4 * g + 1) & 15] : P1[(4 * g + 1) & 15], q2_ = g < 4 ? P0[(4 * g + 2) & 15] : P1[(4 * g + 2) & 15], q3_ = g < 4 ? P0[(4 * g + 3) & 15] : P1[(4 * g + 3) & 15]; \
            float e0, e1, e2, e3; \
            if ((g % GSTEP) == 0) { const int mi = g / GSTEP, j = mi >> 1; \
                if ((mi & 1) == 0) { if (j == 0) g2_first(N0, kf_[0], qf[0], negm, e0, e1, e2, e3, q0_, q1_, q2_, q3_); else g2_acc(N0, kf_[2 * j], qf[j], e0, e1, e2, e3, q0_, q1_, q2_, q3_); } \
                else { if (j == 0) g2_first(N1, kf_[1], qf[0], negm, e0, e1, e2, e3, q0_, q1_, q2_, q3_); else g2_acc(N1, kf_[2 * j + 1], qf[j], e0, e1, e2, e3, q0_, q1_, q2_, q3_); } } \
            else g2_none(e0, e1, e2, e3, q0_, q1_, q2_, q3_); \
            if (g < 4) { P0[(4 * g) & 15] = e0; P0[(4 * g + 1) & 15] = e1; P0[(4 * g + 2) & 15] = e2; P0[(4 * g + 3) & 15] = e3; } \
            else { P1[(4 * g) & 15] = e0; P1[(4 * g + 1) & 15] = e1; P1[(4 * g + 2) & 15] = e2; P1[(4 * g + 3) & 15] = e3; } \
            ATT_SB(); } } \
        __builtin_amdgcn_s_setprio(0); \
        ATT_MASK(N0, N1, (S) + 1); \
        *(LAS u32x4*)(Ks + ((kb_cur + 3) & 3) * KBUF + sofs) = KO; \
        *(LAS u32x4*)(Vs + (vb_cur >= 3 ? vb_cur - 3 : vb_cur + 2) * VBUF + sofs) = VO; \
        if (BAR) { ATT_LDVF(vf_, vb_cur); }     \
        kb_cur = kb_n1; vb_cur = vb_cur == 4 ? 0 : vb_cur + 1; } while (0)
    int vb_cur = 0;
    bf16x8 vf_[8];
    ATT_STEP(false, 0, true, true, p0, p1, pb0, pb1, kqa, vqa, kqb, vqb);
    int s = 1;
    for (; s + 7 < nsteps; s += 8) {
        ATT_STEP(true, s, false, false, pb0, pb1, p0, p1, kqb, vqb, kqa, vqa);
        ATT_STEP(false, s + 1, false, false, p0, p1, pb0, pb1, kqa, vqa, kqb, vqb);
        ATT_STEP(true, s + 2, false, false, pb0, pb1, p0, p1, kqb, vqb, kqa, vqa);
        ATT_STEP(false, s + 3, false, false, p0, p1, pb0, pb1, kqa, vqa, kqb, vqb);
        ATT_STEP(true, s + 4, false, false, pb0, pb1, p0, p1, kqb, vqb, kqa, vqa);
        ATT_STEP(false, s + 5, false, false, p0, p1, pb0, pb1, kqa, vqa, kqb, vqb);
        ATT_STEP(true, s + 6, false, false, pb0, pb1, p0, p1, kqb, vqb, kqa, vqa);
        ATT_STEP(false, s + 7, false, true, p0, p1, pb0, pb1, kqa, vqa, kqb, vqb);
    }
    for (; s + 1 < nsteps; s += 2) {
        ATT_STEP(true, s, false, false, pb0, pb1, p0, p1, kqb, vqb, kqa, vqa);
        ATT_STEP(false, s + 1, false, true, p0, p1, pb0, pb1, kqa, vqa, kqb, vqb);
    }
    ATT_STEP(true, nsteps - 1, false, false, pb0, pb1, p0, p1, kqb, vqb, kqa, vqa);
    { bf16x8 vfl[8]; ATT_LDVF(vfl, (vb_cur == 0 ? 4 : vb_cur - 1));
      const bf16x8 w0 = pack8(pb0, 0), w1 = pack8(pb0, 8), w2 = pack8(pb1, 0), w3 = pack8(pb1, 8);
      o0 = __builtin_amdgcn_mfma_f32_32x32x16_bf16(vfl[0], w0, o0, 0, 0, 0); o1 = __builtin_amdgcn_mfma_f32_32x32x16_bf16(vfl[1], w0, o1, 0, 0, 0);
      o0 = __builtin_amdgcn_mfma_f32_32x32x16_bf16(vfl[2], w1, o0, 0, 0, 0); o1 = __builtin_amdgcn_mfma_f32_32x32x16_bf16(vfl[3], w1, o1, 0, 0, 0);
      o0 = __builtin_amdgcn_mfma_f32_32x32x16_bf16(vfl[4], w2, o0, 0, 0, 0); o1 = __builtin_amdgcn_mfma_f32_32x32x16_bf16(vfl[5], w2, o1, 0, 0, 0);
      o0 = __builtin_amdgcn_mfma_f32_32x32x16_bf16(vfl[6], w3, o0, 0, 0, 0); o1 = __builtin_amdgcn_mfma_f32_32x32x16_bf16(vfl[7], w3, o1, 0, 0, 0);
      lsum += ((sum4(pb0, 0) + sum4(pb0, 4)) + (sum4(pb0, 8) + sum4(pb0, 12))) + ((sum4(pb1, 0) + sum4(pb1, 4)) + (sum4(pb1, 8) + sum4(pb1, 12))); }
#undef ATT_MAXUPD
#undef ATT_VV
#undef ATT_MXOP
#undef ATT_SB
#undef ATT_LDVF
#undef ATT_LDKF
#undef ATT_PVF
#undef ATT_QKF
#undef ATT_EXPPACK
#undef ATT_PV
#undef ATT_STEP
#undef ATT_LDK
#undef ATT_LDV
#undef ATT_TILE
#undef ATT_QK
#undef ATT_MASK
    float lt = xhalf_sum(lsum);
    if (MODE == 1) lt += __builtin_amdgcn_exp2f(A.sink[qhead] * LOG2E - m);
    const float inv = 1.0f / lt;
#pragma unroll
    for (int r = 0; r < 16; ++r) { o0[r] *= inv; o1[r] *= inv; }
    const int qq = q0 + rq + r32;
    const size_t yrow = qq < CTXL ? (size_t)(NLAT + b * CTXL + qq) : (size_t)b * SEQ + (qq - CTXL);
    if (MODE == 0) {
        LAS float* xb = (LAS float*)(lds + XB0) + (wid & 3) * 2048;
        if (sub == 1) {
#pragma unroll
            for (int r = 0; r < 16; ++r) { xb[r * 64 + lane] = o0[r]; xb[(16 + r) * 64 + lane] = o1[r]; } }
        __syncthreads();
        if (sub == 0) { float ss = 0.f;
#pragma unroll
            for (int r = 0; r < 16; ++r) { o0[r] -= A.lam * xb[r * 64 + lane]; o1[r] -= A.lam * xb[(16 + r) * 64 + lane]; ss += o0[r] * o0[r] + o1[r] * o1[r]; }
            ss = xhalf_sum(ss); const float rs = A.oml / sqrtf(ss * (1.0f / 64.0f) + 1e-6f);
            bf16_t* yp = A.Y + yrow * DM + head * 64;
#pragma unroll
            for (int rg = 0; rg < 4; ++rg) { const int dv = 8 * rg + 4 * hi; const f32x4 w0 = *(const f32x4*)(A.subw + dv), w1 = *(const f32x4*)(A.subw + 32 + dv);
                u32x2 a, c2; a.x = cvtpk(o0[4 * rg] * rs * w0[0], o0[4 * rg + 1] * rs * w0[1]); a.y = cvtpk(o0[4 * rg + 2] * rs * w0[2], o0[4 * rg + 3] * rs * w0[3]);
                c2.x = cvtpk(o1[4 * rg] * rs * w1[0], o1[4 * rg + 1] * rs * w1[1]); c2.y = cvtpk(o1[4 * rg + 2] * rs * w1[2], o1[4 * rg + 3] * rs * w1[3]);
                *(u32x2*)(yp + dv) = a; *(u32x2*)(yp + 32 + dv) = c2; } }
    } else {
        bf16_t* yp = A.Y + yrow * DM + (MODE == 1 ? 512 : 768) + qhead * 64;
#pragma unroll
        for (int rg = 0; rg < 4; ++rg) { const int dv = 8 * rg + 4 * hi;
            u32x2 a, c2; a.x = cvtpk(o0[4 * rg], o0[4 * rg + 1]); a.y = cvtpk(o0[4 * rg + 2], o0[4 * rg + 3]);
            c2.x = cvtpk(o1[4 * rg], o1[4 * rg + 1]); c2.y = cvtpk(o1[4 * rg + 2], o1[4 * rg + 3]);
            *(u32x2*)(yp + dv) = a; *(u32x2*)(yp + 32 + dv) = c2; }
    }
}
__device__ __forceinline__ unsigned xcc_id() { return (unsigned)__builtin_amdgcn_s_getreg((3 << 11) | 20) & 0xFu; }
__device__ __forceinline__ void attn_phase(const Params& P, LAS unsigned char* lds, int l) {
    GAS unsigned char* wsg_ = (GAS unsigned char*)P.ws; asm volatile("" : "+s"(wsg_)); unsigned char* ws = (unsigned char*)wsg_;
    unsigned char* qkv = ws + WS_QKV; bf16_t* Y = (bf16_t*)(ws + WS_Y);
    const float lam = ((const float*)(ws + WS_LAM))[l]; const float oml = 1.0f - (l == 0 ? 0.2f : 0.35550906759097f);
    const float* subw = P.in[17] + l * 64; const float* sink = P.in[18] + l * 4;
    const unsigned* xcnt = (const unsigned*)(ws + WS_XCNT);
    const int myx = (int)xcc_id(); const int rank = __builtin_amdgcn_readfirstlane(*(const LAS int*)(lds + LDS_RANK_OFF));
    int nx = 0, vx = 0, nloc = 1;
    for (int j = 0; j < 16; ++j) { const int cj = (int)xcnt[j]; if (cj > 0) { if (j < myx) ++vx; ++nx; } if (j == myx) nloc = cj; }
    if (nx < 1) nx = 1; if (nloc < 1) nloc = 1;
    const int nlist = (l == 0) ? 260 : 256;
    for (int g = vx; g < 8; g += nx) {
        for (int i = rank; i < nlist; i += nloc) {
            int mode, b, head, qt;
            if (i < 128) { mode = 0; b = g >> 2; head = g & 3; qt = 2 + i; }
            else if (i < 192) { mode = 2; b = (g & 3) >> 1; head = g & 1; qt = 2 + 64 * (g >> 2) + (i - 128); }
            else if (i < 256) { mode = 1; b = (g & 3) >> 1; head = g & 1; qt = 2 + 64 * (g >> 2) + (i - 192); }
            else if (i < 258) { mode = 0; b = g >> 2; head = g & 3; qt = i - 256; }
            else if (i == 258) { mode = 2; b = (g & 3) >> 1; head = g & 1; qt = g >> 2; }
            else { mode = 1; b = (g & 3) >> 1; head = g & 1; qt = g >> 2; }
            if (mode == 0) { const AttnPtrs A{(const bf16_t*)(qkv + O_QA), (const bf16_t*)(qkv + O_KA), (const bf16_t*)(qkv + O_VAT), Y, subw, sink, lam, oml}; attn_unit<0>(lds, A, b, head, qt); }
            else if (mode == 1) { const AttnPtrs A{(const bf16_t*)(qkv + O_QC), (const bf16_t*)(qkv + O_KC), (const bf16_t*)(qkv + O_VCT), Y, subw, sink, lam, oml}; attn_unit<1>(lds, A, b, head, qt); }
            else { const AttnPtrs A{(const bf16_t*)(qkv + O_QD), (const bf16_t*)(qkv + O_KD), (const bf16_t*)(qkv + O_VDT), Y, subw, sink, lam, oml}; attn_unit<2>(lds, A, b, head, qt); }
        }
    }
}

#define XB_TMO      128
#define XB_XCNT(j)  (256  + 64 * (j))
#define XB_XSUB(j)  (1280 + 64 * (j))
#define XB_XGEN(j)  (2304 + 64 * (j))
#define XB_TOP      3328
#define XB_TOPGEN   3392
#define XCD_BAR_WORDS 3456
#define XB_SPIN_CAP (1u << 23)

__device__ __forceinline__ unsigned xb_ld(unsigned* p)              { return __hip_atomic_load(p, __ATOMIC_RELAXED, __HIP_MEMORY_SCOPE_AGENT); }
__device__ __forceinline__ unsigned xb_add(unsigned* p, unsigned v) { return __hip_atomic_fetch_add(p, v, __ATOMIC_RELAXED, __HIP_MEMORY_SCOPE_AGENT); }
__device__ __forceinline__ unsigned xb_xcc_id() { return (unsigned)__builtin_amdgcn_s_getreg((3 << 11) | 20) & 0xFu; }
#define XB_SPIN(cond, bar) do { unsigned _sp = 0; while (cond) { __builtin_amdgcn_s_sleep(1); \
    if ((++_sp & 255u) == 0u) { if (xb_ld(&(bar)[XB_TMO])) break; if (_sp > XB_SPIN_CAP) { atomicAdd(&(bar)[XB_TMO], 1u); break; } } } } while (0)

struct XcdBarrier {
    unsigned* bar; unsigned x;
    volatile LAS unsigned* st;
};

__device__ __forceinline__ XcdBarrier xcd_barrier_post(unsigned* bar, volatile LAS unsigned* st) {
    XcdBarrier b; b.bar = bar; b.x = xb_xcc_id(); b.st = st;
    if (threadIdx.x == 0) (void)xb_add(&bar[XB_XCNT(b.x)], 1u);
    return b;
}
__device__ __forceinline__ void xcd_barrier_complete(unsigned* bar, unsigned x, unsigned& nloc, unsigned& nx) {
    const unsigned G = gridDim.x * gridDim.y * gridDim.z;
    unsigned sum, cnt, mine, sp = 0u;
    for (;;) {
        sum = 0u; cnt = 0u; mine = 0u;
#pragma unroll
        for (unsigned j = 0; j < 16; ++j) { const unsigned c = xb_ld(&bar[XB_XCNT(j)]); sum += c; cnt += (c > 0u) ? 1u : 0u; mine = (j == x) ? c : mine; }
        if (sum == G) break;
        __builtin_amdgcn_s_sleep(1);
        if ((++sp & 255u) == 0u) { if (xb_ld(&bar[XB_TMO])) break; if (sp > XB_SPIN_CAP) { atomicAdd(&bar[XB_TMO], 1u); break; } }
    }
    nloc = mine > 0u ? mine : 1u; nx = cnt > 0u ? cnt : 1u;
}

__device__ __forceinline__ void xcd_barrier(const XcdBarrier& b) {
    asm volatile("s_waitcnt vmcnt(0)" ::: "memory");
    __syncthreads();
    if (threadIdx.x == 0) {
        unsigned* bar = b.bar;
        __builtin_amdgcn_s_waitcnt(0);
        unsigned nloc = b.st[0], nx = b.st[1];
        if (nloc == 0u) { xcd_barrier_complete(bar, b.x, nloc, nx); b.st[0] = nloc; b.st[1] = nx; }
        const unsigned old = xb_add(&bar[XB_XSUB(b.x)], 1u);
        const unsigned gen = old / nloc;
        if (old + 1u == (gen + 1u) * nloc) {
            __builtin_amdgcn_fence(__ATOMIC_RELEASE, "agent");
            asm volatile("s_waitcnt vmcnt(0)" ::: "memory");
            const unsigned og = xb_add(&bar[XB_TOP], 1u);
            const unsigned tg = og / nx;
            if (og + 1u == (tg + 1u) * nx) xb_add(&bar[XB_TOPGEN], 1u);
            else XB_SPIN(xb_ld(&bar[XB_TOPGEN]) == tg, bar);
            __builtin_amdgcn_fence(__ATOMIC_ACQUIRE, "agent");
            xb_add(&bar[XB_XGEN(b.x)], 1u);
            asm volatile("s_waitcnt vmcnt(0)" ::: "memory");
        } else {
            XB_SPIN(xb_ld(&bar[XB_XGEN(b.x)]) == gen, bar);
            __builtin_amdgcn_fence(__ATOMIC_ACQUIRE, "agent");
            asm volatile("s_waitcnt vmcnt(0)" ::: "memory");
        }
    }
    __syncthreads();
}

__global__ void __launch_bounds__(512, 2) mega_fwd(Params P) {
    extern __shared__ __attribute__((aligned(16))) unsigned char lds_raw[];
    LAS unsigned char* lds = (LAS unsigned char*)lds_raw;
    cg::grid_group grid = cg::this_grid();
    unsigned char* ws = P.ws;
    const float* mod = (const float*)(ws + WS_MOD);
    const int G = gridDim.x, bx = blockIdx.x;

    if (threadIdx.x == 0) { const unsigned r_ = atomicAdd((unsigned*)(ws + WS_XCNT) + xcc_id(), 1u); *(LAS unsigned*)(lds + LDS_RANK_OFF) = r_; }
    if (threadIdx.x == 0) { *(volatile LAS unsigned*)(lds + LDS_XB_OFF) = 0u; *(volatile LAS unsigned*)(lds + LDS_XB_OFF + 4) = 0u; }
    __syncthreads();
    (void)xcd_barrier_post((unsigned*)(ws + WS_XBAR), (volatile LAS unsigned*)(lds + LDS_XB_OFF));
#define GBAR() do { XcdBarrier xb_; xb_.bar = (unsigned*)(P.ws + WS_XBAR); xb_.x = xb_xcc_id(); xb_.st = (volatile LAS unsigned*)(lds + LDS_XB_OFF); xcd_barrier(xb_); } while (0)
    prologue(P, lds);
    grid.sync();
    row_pass<false>(P, TROWS, nullptr, nullptr, mod + 0 * 1024, mod + 1 * 1024, true, false);
    GBAR();
#pragma unroll 1
    for (int l = 0; l < 2; ++l) {
        GAS unsigned char* wsg_ = (GAS unsigned char*)ws; asm volatile("" : "+s"(wsg_)); unsigned char* wsl = (unsigned char*)wsg_;
        const float* modl = (const float*)(wsl + WS_MOD) + (size_t)l * 3 * NMODW;
        const unsigned char* wl = wsl + WS_W + (size_t)l * W_LAYER;
        float* xctx = (float*)(wsl + WS_XCTX); bf16_t* H = (bf16_t*)(wsl + WS_H); bf16_t* ACT = (bf16_t*)(wsl + WS_ACT); bf16_t* Z = (bf16_t*)(wsl + WS_Z); bf16_t* Y = (bf16_t*)(wsl + WS_Y);
        const int Mtail = (l == 1) ? NLAT : TROWS;
        const float* lng = P.in[6] + l * 3 * DM; const float* lnb = P.in[7] + l * 3 * DM;
#pragma unroll 1
        for (int f = 0; f < 2; ++f) {
            const int Mf = f == 0 ? TROWS : Mtail;
            { pg8::Gemm g{H, (const bf16_t*)(wl + (f == 0 ? W_GU1 : W_GU2)), Mf, 2 * DFF, DM}; pg8::StaticOrder S; S.init(Mf, 2 * DFF, G, bx);
              pg8::EpiSwiglu E{ACT, DFF};
              pg8::gemm_phase<pg8::EpiSwiglu, pg8::StaticOrder, true, true>(lds, g, S, E); }
            GBAR();
            { pg8::Gemm g{ACT, (const bf16_t*)(wl + (f == 0 ? W_DN1 : W_DN2)), Mf, DM, DFF}; pg8::StaticOrder S; S.init(Mf, DM, G, bx);
              const int pli = (f == 0) ? (l == 0 ? 0 : 2) : 1;
              const float* plg = (f == 0) ? P.in[6] + (l == 0 ? 0 : (l - 1) * 3 * DM) + pli * DM : lng + DM; const float* plb = (f == 0) ? P.in[7] + (l == 0 ? 0 : (l - 1) * 3 * DM) + pli * DM : lnb + DM;
              const bool first_ = (f == 0 && l == 0);
              pg8::EpiResid E{P.out, xctx, modl + (f == 0 ? 2 : 8) * 1024, 0.5f, first_ ? P.in[0] : (const float*)P.out, first_ ? P.in[2] : (const float*)xctx, (const float*)(wsl + WS_STATS), plg, plb, first_ ? 1 : 0};
              pg8::gemm_phase<pg8::EpiResid, pg8::StaticOrder, true, true>(lds, g, S, E); }
            GBAR();
            if (f == 0) {
                row_pass<true>(P, TROWS, lng, lnb, modl + 3 * 1024, modl + 4 * 1024, true, false);
                GBAR();
                { pg8::Gemm g{H, (const bf16_t*)(wl + W_IN), TROWS, INW, DM}; pg8::StaticOrder S; S.init(TROWS, INW, G, bx);
                  pg8::EpiBf16<0> E{Z, INW, nullptr, 0, 0, 1.f};
                  pg8::gemm_phase<pg8::EpiBf16<0>, pg8::StaticOrder, true, true>(lds, g, S, E); }
                GBAR();
                zpost_phase(P, lds, l);
                GBAR();
                attn_phase(P, lds, l);
                GBAR();
                { pg8::Gemm g{Y, (const bf16_t*)(wl + W_OUT), Mtail, DM, DM}; pg8::StaticOrder S; S.init(Mtail, DM, G, bx);
                  pg8::EpiResid E{P.out, xctx, modl + 5 * 1024, 1.0f, (const float*)P.out, (const float*)xctx, (const float*)(wsl + WS_STATS), lng, lnb, 0};
                  pg8::gemm_phase<pg8::EpiResid, pg8::StaticOrder, true, true>(lds, g, S, E); }
                GBAR();
                row_pass<true>(P, Mtail, lng + DM, lnb + DM, modl + 6 * 1024, modl + 7 * 1024, true, false);
                GBAR();
            } else {
                const bool last = (l == 1);
                row_pass<true>(P, Mtail, lng + 2 * DM, lnb + 2 * DM, modl + 3 * NMODW + 0 * 1024, modl + 3 * NMODW + 1 * 1024, !last, last);
                if (!last) GBAR();
            }
        }
    }
}

extern "C" void kernel_launch(void* const* d_in, const int* in_sizes, int n_in, void* d_out, int out_size, void* d_ws, size_t ws_size, hipStream_t stream) {
    static int grid = 0;
    if (grid == 0) {
        if (n_in != 23 || out_size != NLAT * DM || ws_size < WS_END) { fprintf(stderr, "kernel_launch: unexpected shapes (n_in %d out %d ws %zu, need %zu)\n", n_in, out_size, ws_size, (size_t)WS_END); grid = -1; return; }
        int dev = 0, cus = 0, per_cu = 0;
        if (hipGetDevice(&dev) != hipSuccess || hipDeviceGetAttribute(&cus, hipDeviceAttributeMultiprocessorCount, dev) != hipSuccess) { grid = -1; return; }
        if (hipFuncSetAttribute((const void*)mega_fwd, hipFuncAttributeMaxDynamicSharedMemorySize, LDS_BYTES) != hipSuccess) { fprintf(stderr, "kernel_launch: hipFuncSetAttribute failed\n"); grid = -1; return; }
        if (hipOccupancyMaxActiveBlocksPerMultiprocessor(&per_cu, (const void*)mega_fwd, 512, LDS_BYTES) != hipSuccess || per_cu < 1) { fprintf(stderr, "kernel_launch: occupancy query says %d\n", per_cu); per_cu = 1; }
        (void)hipGetLastError();
        grid = cus * per_cu;
    }
    if (grid < 0) return;
    Params p{};
    for (int i = 0; i < 23; ++i) p.in[i] = (const float*)d_in[i];
    p.out = (float*)d_out; p.ws = (unsigned char*)d_ws;
    (void)hipMemsetAsync((unsigned char*)d_ws + WS_XCNT, 0, 64 * 1024, stream);
    void* args[] = {&p};
    hipError_t e = hipLaunchCooperativeKernel((const void*)mega_fwd, dim3(grid), dim3(512), args, LDS_BYTES, stream);
    if (e != hipSuccess) fprintf(stderr, "kernel_launch: cooperative launch failed: %s (grid %d)\n", hipGetErrorString(e), grid);
}
```

```cpp
#include <hip/hip_runtime.h>
#include <hip/hip_cooperative_groups.h>
#include <cstdio>
#include <cstdint>
namespace cg = cooperative_groups;
namespace pg8 {
#define PG8_LAS __attribute__((address_space(3)))
typedef unsigned short bf16_t;
typedef short bf16x8 __attribute__((ext_vector_type(8)));
typedef float f32x4 __attribute__((ext_vector_type(4)));
typedef unsigned u32x4 __attribute__((ext_vector_type(4)));
constexpr int BM = 256, BK = 64, HALF = 128, HTB = HALF * BK * 2  , STAGE_BYTES = 8 * HTB, NXCD = 8, WGM = 8;

__host__ __device__ __forceinline__ int lds_byte(int r, int c) { const int st = (r >> 4) * 2 + (c >> 5), rr = r & 15, cc = c & 31, ob = rr * 64 + cc * 2; return st * 1024 + (ob ^ (((ob >> 9) & 1) << 5)); }
__host__ __device__ __forceinline__ void stage_rc(int b, int& R, int& C) { const int st = b / 1024, sb = b % 1024, swz = sb ^ (((sb >> 9) & 1) << 5); R = (st >> 1) * 16 + swz / 64; C = (st & 1) * 32 + (swz % 64) / 2; }
__host__ __device__ __forceinline__ int perm32(int rho) { const int n = rho >> 4, i = rho & 15; return 8 * (i >> 2) + 4 * n + (i & 3); }

struct Unit { int pm, pn; };
struct Gemm { const bf16_t* A; const bf16_t* Bt; int M, N, K; };

struct StaticOrder {
    int nM, nN, nwg, G, c;
    __host__ __device__ void init(int M, int N, int G_, int c_) { nM = M / BM; nN = N / BM; nwg = nM * nN; G = G_; c = c_; }
    __host__ __device__ bool next(int i, Unit& u) const {
        const long L = (long)i * G + c; if (L >= nwg) return false;
        int wgid = (int)L; { const int q = nwg / NXCD, r = nwg % NXCD, xcd = wgid % NXCD, off = wgid / NXCD; wgid = (xcd < r ? xcd * (q + 1) : r * (q + 1) + (xcd - r) * q) + off; }
        const int nig = WGM * nN, gid = wgid / nig, fm = gid * WGM, gsz = (nM - fm) < WGM ? (nM - fm) : WGM;
        u.pm = fm + ((wgid % nig) % gsz); u.pn = (wgid % nig) / gsz; return true;
    }
    __device__ __forceinline__ void a_ready(const Unit&) const {}
    __device__ __forceinline__ void done(const Unit&) const {}
};

__device__ __forceinline__ unsigned cvt_pk_bf16(float lo, float hi) { unsigned r; asm volatile("v_cvt_pk_bf16_f32 %0, %1, %2" : "=v"(r) : "v"(lo), "v"(hi)); return r; }
typedef float f32x2 __attribute__((ext_vector_type(2)));
__device__ __forceinline__ f32x2 gelu_pk(f32x2 v) {
    const f32x2 av = __builtin_elementwise_abs(v), d = av * 0.2316418882f + 1.0f;
    f32x2 t; t.x = __builtin_amdgcn_rcpf(d.x); t.y = __builtin_amdgcn_rcpf(d.y);
    f32x2 q = t * 0.5307027145f + (-0.7265760135f); q = q * t + 0.7107068705f; q = q * t + (-0.142248368f); q = q * t + 0.127414796f; q = q * t;
    const f32x2 s = (v * v) * (-0.72134752044f);
    f32x2 e; e.x = __builtin_amdgcn_exp2f(s.x); e.y = __builtin_amdgcn_exp2f(s.y);
    const f32x2 m = v * (q * e), r = v - m;
    f32x2 o; o.x = v.x < 0.f ? m.x : r.x; o.y = v.y < 0.f ? m.y : r.y; return o;
}

template <int ACT  > struct EpiBf16 {
    static constexpr bool PERM = true, AFTER_DRAIN = false; static_assert(ACT == 0 || ACT == 1, "EpiBf16: ACT is 0 (none) or 1 (gelu_pk)");
    bf16_t* O; int ldc; const float* bias; int split_cols; size_t split_stride; float scale0;
    __device__ __forceinline__ void operator()(const f32x4 (&acc)[2][2][4][2], const Unit& u, int wr, int wc, int fr, int fq) const {
        const int row0 = u.pm * BM + wr * 64 + fr; int colt = u.pn * BM; bf16_t* base = O;
        float sc = 1.f; if (split_cols) { const int t = colt / split_cols; base += (size_t)t * split_stride; colt -= t * split_cols; if (t == 0) sc = scale0; }
        const int col0 = colt + wc * 32 + 8 * fq, bcol0 = u.pn * BM + wc * 32 + 8 * fq;
        f32x4 bv[2][2];
#pragma unroll
        for (int bj = 0; bj < 2; ++bj)
#pragma unroll
            for (int n = 0; n < 2; ++n) bv[bj][n] = bias ? *(const f32x4*)(bias + bcol0 + bj * HALF + 4 * n) : (f32x4){0.f, 0.f, 0.f, 0.f};
#pragma unroll
        for (int ai = 0; ai < 2; ++ai)
#pragma unroll
            for (int m = 0; m < 4; ++m) { bf16_t* rowp = base + (size_t)(row0 + ai * HALF + m * 16) * ldc + col0;
#pragma unroll
                for (int bj = 0; bj < 2; ++bj) { f32x4 v0 = acc[ai][bj][m][0] + bv[bj][0], v1 = acc[ai][bj][m][1] + bv[bj][1];
                    if (ACT == 1) { f32x2 a = gelu_pk((f32x2){v0[0], v0[1]}), b = gelu_pk((f32x2){v0[2], v0[3]}), c = gelu_pk((f32x2){v1[0], v1[1]}), d = gelu_pk((f32x2){v1[2], v1[3]});
                        v0 = (f32x4){a.x, a.y, b.x, b.y}; v1 = (f32x4){c.x, c.y, d.x, d.y}; }
                    v0 = v0 * sc; v1 = v1 * sc; u32x4 w; w.x = cvt_pk_bf16(v0[0], v0[1]); w.y = cvt_pk_bf16(v0[2], v0[3]); w.z = cvt_pk_bf16(v1[0], v1[1]); w.w = cvt_pk_bf16(v1[2], v1[3]);
                    *(u32x4*)(rowp + bj * HALF) = w; } }
    }
};
struct EpiSwiglu {
    static constexpr bool PERM = true, AFTER_DRAIN = false;
    bf16_t* O; int ldc;
    __device__ __forceinline__ void operator()(const f32x4 (&acc)[2][2][4][2], const Unit& u, int wr, int wc, int fr, int fq) const {
        const int row0 = u.pm * BM + wr * 64 + fr; const int col0 = u.pn * HALF + wc * 32 + 8 * fq;
#pragma unroll
        for (int ai = 0; ai < 2; ++ai)
#pragma unroll
            for (int m = 0; m < 4; ++m) { bf16_t* rowp = O + (size_t)(row0 + ai * HALF + m * 16) * ldc + col0;
                float r[8];
#pragma unroll
                for (int n = 0; n < 2; ++n)
#pragma unroll
                    for (int e = 0; e < 4; ++e) { const float g = acc[ai][0][m][n][e], uu = acc[ai][1][m][n][e];
                        const float sg = __builtin_amdgcn_rcpf(1.0f + __builtin_amdgcn_exp2f(-1.4426950408889634f * g)); r[n * 4 + e] = g * sg * uu; }
                u32x4 w; w.x = cvt_pk_bf16(r[0], r[1]); w.y = cvt_pk_bf16(r[2], r[3]); w.z = cvt_pk_bf16(r[4], r[5]); w.w = cvt_pk_bf16(r[6], r[7]);
                *(u32x4*)rowp = w; }
    }
};
struct EpiResid {
    static constexpr bool PERM = true, AFTER_DRAIN = false;
    float* Xlat; float* Xctx; const float* gate; float coef;
    const float* Slat; const float* Sctx;
    const float* stats; const float* lg; const float* lb; int ident;
    __device__ __forceinline__ void operator()(const f32x4 (&acc)[2][2][4][2], const Unit& u, int wr, int wc, int fr, int fq) const {
        const int rowt = u.pm * BM; float* base; int set;
        const float* sbase;
        if (rowt < 32768) { base = Xlat + (size_t)rowt * 1024; sbase = Slat + (size_t)rowt * 1024; set = rowt >> 14; } else { base = Xctx + (size_t)(rowt - 32768) * 1024; sbase = Sctx + (size_t)(rowt - 32768) * 1024; set = 2; }
        const int col0 = u.pn * BM + wc * 32 + 8 * fq; const float* gp = gate + set * 9216 + col0;
        float mean[2][4], rstd[2][4];
#pragma unroll
        for (int ai = 0; ai < 2; ++ai)
#pragma unroll
            for (int m = 0; m < 4; ++m) { mean[ai][m] = 0.f; rstd[ai][m] = 1.f;
                if (!ident) { const f32x2 st = *(const f32x2*)(stats + 2 * (size_t)(rowt + wr * 64 + fr + ai * HALF + m * 16)); mean[ai][m] = st[0]; rstd[ai][m] = st[1]; } }
#pragma unroll
        for (int bj = 0; bj < 2; ++bj)
#pragma unroll
            for (int n = 0; n < 2; ++n) { const f32x4 gvv = *(const f32x4*)(gp + bj * HALF + 4 * n) * coef; f32x4 g4v, b4v;
                if (ident) { g4v = (f32x4){1.41421356237f, 1.41421356237f, 1.41421356237f, 1.41421356237f}; b4v = (f32x4){0.f, 0.f, 0.f, 0.f}; }
                else { g4v = *(const f32x4*)(lg + col0 + bj * HALF + 4 * n) * 1.41421356237f; b4v = *(const f32x4*)(lb + col0 + bj * HALF + 4 * n) * 1.41421356237f; }
#pragma unroll
                for (int ai = 0; ai < 2; ++ai)
#pragma unroll
                    for (int m = 0; m < 4; ++m) { const size_t eo_ = (size_t)(wr * 64 + fr + ai * HALF + m * 16) * 1024 + col0 + bj * HALF + 4 * n; f32x4* p = (f32x4*)(base + eo_); const f32x4 x = *(const f32x4*)(sbase + eo_);
                        *p = ((x - mean[ai][m]) * rstd[ai][m]) * g4v + b4v + gvv * acc[ai][bj][m][n]; } }
    }
};
template <class Epi, class Sched, bool ALIGN_EPI = false, bool SP2 = false>
__device__ __forceinline__ void gemm_phase(PG8_LAS unsigned char* lds, const Gemm g, const Sched& S, const Epi& E) {
    int tid_ = threadIdx.x; asm volatile("" : "+v"(tid_)); const int tid = tid_, wid = __builtin_amdgcn_readfirstlane(tid >> 6), lane = tid & 63, wr = wid >> 2, wc = wid & 3, fr = lane & 15, fq = lane >> 4;
    const int K = g.K, nt = K / BK;
    unsigned voffA[2], voffB[2];
#pragma unroll
    for (int i = 0; i < 2; ++i) { int R, C; stage_rc(tid * 16 + i * 8192, R, C); const int Rb = Epi::PERM ? ((R & ~31) + perm32(R & 31)) : R;
        voffA[i] = (unsigned)(R * K + C) * 2u; voffB[i] = (unsigned)(Rb * K + C) * 2u; }
    const size_t kstep = (size_t)(BK * 2);
    const size_t hstep = (size_t)HALF * K * 2;
    const size_t tstep = 2 * hstep;
    const unsigned ldsw = (unsigned)wid * 1024u;
    const int aoff = lds_byte(wr * 64 + fr, fq * 8), boff = lds_byte(wc * 32 + fr, fq * 8);
#define PG8_SA(b, h) (((b) * 2 + (h)) * HTB)
#define PG8_SB(b, h) ((4 + (b) * 2 + (h)) * HTB)
#define PG8_STAGE(bufoff, gbase, voff) do { _Pragma("unroll") for (int _i = 0; _i < 2; ++_i) \
        __builtin_amdgcn_global_load_lds((const unsigned*)((const char*)(gbase) + (voff)[_i]), (PG8_LAS unsigned*)(lds + (bufoff) + ldsw + _i * 8192), 16, 0, 0); } while (0)
#define PG8_LDA(dst, b, h) do { _Pragma("unroll") for (int m = 0; m < 4; ++m) _Pragma("unroll") for (int k = 0; k < 2; ++k) dst[m][k] = *(const PG8_LAS bf16x8*)(lds + PG8_SA(b, h) + aoff + m * 2048 + k * 1024); } while (0)
#define PG8_LDB(dst, b, h) do { _Pragma("unroll") for (int n = 0; n < 2; ++n) _Pragma("unroll") for (int k = 0; k < 2; ++k) dst[n][k] = *(const PG8_LAS bf16x8*)(lds + PG8_SB(b, h) + boff + n * 2048 + k * 1024); } while (0)
#define PG8_MMA(ai, bj, At, Bt) do { __builtin_amdgcn_s_setprio(1); _Pragma("unroll") for (int m = 0; m < 4; ++m) _Pragma("unroll") for (int n = 0; n < 2; ++n) _Pragma("unroll") for (int k = 0; k < 2; ++k) \
        acc[ai][bj][m][n] = __builtin_amdgcn_mfma_f32_16x16x32_bf16(Bt[n][k], At[m][k], acc[ai][bj][m][n], 0, 0, 0); __builtin_amdgcn_s_setprio(0); } while (0)
#define PG8_WAIT_V(n) asm volatile("s_waitcnt vmcnt(" #n ")" ::: "memory")
#define PG8_WAIT_L(n) asm volatile("s_waitcnt lgkmcnt(" #n ")" ::: "memory")
#define PG8_BAR __builtin_amdgcn_s_barrier()
#define PG8_SCHED __builtin_amdgcn_sched_barrier(0)
    Unit cur, nxt; int ui = 0;
    if (!S.next(0, cur)) return;
    f32x4 acc[2][2][4][2];
#pragma unroll
    for (int a = 0; a < 2; ++a)
#pragma unroll
        for (int b = 0; b < 2; ++b)
#pragma unroll
            for (int m = 0; m < 4; ++m)
#pragma unroll
                for (int n = 0; n < 2; ++n) acc[a][b][m][n] = (f32x4){0.f, 0.f, 0.f, 0.f};
    bf16x8 At[4][2], B0[2][2], B1[2][2];
    const char* cA = (const char*)g.A + (size_t)cur.pm * tstep; const char* cB = (const char*)g.Bt + (size_t)cur.pn * tstep;
    S.a_ready(cur);
    if constexpr (SP2) {
        PG8_STAGE(PG8_SB(0, 0), cB, voffB); PG8_STAGE(PG8_SB(0, 1), cB + hstep, voffB); PG8_STAGE(PG8_SA(0, 0), cA, voffA); PG8_STAGE(PG8_SA(0, 1), cA + hstep, voffA);
        if (wr == 1) PG8_BAR;
        PG8_WAIT_V(2); PG8_BAR;
        PG8_STAGE(PG8_SB(1, 0), cB + kstep, voffB); PG8_STAGE(PG8_SA(1, 0), cA + kstep, voffA); PG8_STAGE(PG8_SB(1, 1), cB + hstep + kstep, voffB);
        PG8_WAIT_V(6); PG8_BAR;
    } else {
        PG8_STAGE(PG8_SB(0, 0), cB, voffB); PG8_STAGE(PG8_SA(0, 0), cA, voffA); PG8_STAGE(PG8_SB(0, 1), cB + hstep, voffB); PG8_STAGE(PG8_SA(0, 1), cA + hstep, voffA);
        if (wr == 1) PG8_BAR;
        PG8_WAIT_V(4); PG8_BAR;
        PG8_STAGE(PG8_SB(1, 0), cB + kstep, voffB); PG8_STAGE(PG8_SA(1, 0), cA + kstep, voffA); PG8_STAGE(PG8_SB(1, 1), cB + hstep + kstep, voffB);
        PG8_WAIT_V(6); PG8_BAR;
    }
    for (;;) {
        const bool has_next = S.next(ui + 1, nxt);
        const char* nA = has_next ? (const char*)g.A + (size_t)nxt.pm * tstep : cA; const char* nB = has_next ? (const char*)g.Bt + (size_t)nxt.pn * tstep : cB;
        for (int t = 0; t < nt; t += 2) {
            const bool last = (t == nt - 2);
            const char* a1 = cA + (size_t)(t + 1) * kstep;
            const char* a2 = last ? nA : cA + (size_t)(t + 2) * kstep; const char* b2 = last ? nB : cB + (size_t)(t + 2) * kstep;
            const char* a3 = a2 + kstep; const char* b3 = b2 + kstep;
            if (last && has_next) S.a_ready(nxt);
            if constexpr (SP2) {
            PG8_LDB(B0, 0, 0); PG8_LDB(B1, 0, 1); PG8_SCHED; PG8_LDA(At, 0, 0); PG8_STAGE(PG8_SA(1, 1), a1 + hstep, voffA);
            PG8_WAIT_V(8); PG8_WAIT_L(0); PG8_BAR; PG8_MMA(0, 0, At, B0); PG8_MMA(0, 1, At, B1); PG8_BAR; PG8_SCHED;
            PG8_LDA(At, 0, 1); PG8_STAGE(PG8_SB(0, 0), b2, voffB); PG8_STAGE(PG8_SB(0, 1), b2 + hstep, voffB); PG8_STAGE(PG8_SA(0, 0), a2, voffA);
            PG8_WAIT_V(8); PG8_WAIT_L(0); PG8_BAR; PG8_MMA(1, 0, At, B0); PG8_MMA(1, 1, At, B1); PG8_BAR; PG8_SCHED;
            PG8_LDB(B0, 1, 0); PG8_LDB(B1, 1, 1); PG8_SCHED; PG8_LDA(At, 1, 0); PG8_STAGE(PG8_SA(0, 1), a2 + hstep, voffA);
            PG8_WAIT_V(8); PG8_WAIT_L(0); PG8_BAR; PG8_MMA(0, 0, At, B0); PG8_MMA(0, 1, At, B1); PG8_BAR; PG8_SCHED;
            PG8_LDA(At, 1, 1); PG8_STAGE(PG8_SB(1, 0), b3, voffB); PG8_STAGE(PG8_SB(1, 1), b3 + hstep, voffB); PG8_STAGE(PG8_SA(1, 0), a3, voffA);
            PG8_WAIT_V(8); PG8_WAIT_L(0); PG8_BAR; PG8_MMA(1, 0, At, B0); PG8_MMA(1, 1, At, B1); PG8_BAR; PG8_SCHED;
            } else {
            PG8_LDB(B0, 0, 0); PG8_SCHED; PG8_LDA(At, 0, 0); PG8_STAGE(PG8_SA(1, 1), a1 + hstep, voffA);
            PG8_WAIT_L(8); PG8_BAR; PG8_WAIT_L(0); PG8_MMA(0, 0, At, B0); PG8_BAR; PG8_SCHED;
            PG8_LDB(B1, 0, 1); PG8_STAGE(PG8_SB(0, 0), b2, voffB);
            PG8_BAR; PG8_WAIT_L(0); PG8_MMA(0, 1, At, B1); PG8_BAR;
            PG8_LDA(At, 0, 1); PG8_STAGE(PG8_SA(0, 0), a2, voffA);
            PG8_BAR; PG8_WAIT_L(0); PG8_MMA(1, 0, At, B0); PG8_BAR; PG8_SCHED;
            PG8_STAGE(PG8_SB(0, 1), b2 + hstep, voffB);
            PG8_WAIT_V(6); PG8_BAR; PG8_MMA(1, 1, At, B1); PG8_BAR;
            PG8_LDB(B0, 1, 0); PG8_SCHED; PG8_LDA(At, 1, 0); PG8_STAGE(PG8_SA(0, 1), a2 + hstep, voffA);
            PG8_WAIT_L(8); PG8_BAR; PG8_WAIT_L(0); PG8_MMA(0, 0, At, B0); PG8_BAR; PG8_SCHED;
            PG8_LDB(B1, 1, 1); PG8_STAGE(PG8_SB(1, 0), b3, voffB);
            PG8_BAR; PG8_WAIT_L(0); PG8_MMA(0, 1, At, B1); PG8_BAR;
            PG8_LDA(At, 1, 1); PG8_STAGE(PG8_SA(1, 0), a3, voffA);
            PG8_BAR; PG8_WAIT_L(0); PG8_MMA(1, 0, At, B0); PG8_BAR; PG8_SCHED;
            PG8_STAGE(PG8_SB(1, 1), b3 + hstep, voffB);
            PG8_WAIT_V(6); PG8_BAR; PG8_MMA(1, 1, At, B1); PG8_BAR;
            }
        }
        if constexpr (ALIGN_EPI) { if (wr == 0) PG8_BAR; }
        if constexpr (!Epi::AFTER_DRAIN) { E(acc, cur, wr, wc, fr, fq); S.done(cur); }
        if (!has_next) break;
#pragma unroll
        for (int a = 0; a < 2; ++a)
#pragma unroll
            for (int b = 0; b < 2; ++b)
#pragma unroll
                for (int m = 0; m < 4; ++m)
#pragma unroll
                    for (int n = 0; n < 2; ++n) acc[a][b][m][n] = (f32x4){0.f, 0.f, 0.f, 0.f};
        cur = nxt; cA = nA; cB = nB; ++ui;
        if constexpr (ALIGN_EPI) { if (wr == 1) PG8_BAR; }
    }
    PG8_WAIT_V(0);
    if constexpr (!ALIGN_EPI) { if (wr == 0) PG8_BAR; }
    PG8_BAR;
    if constexpr (Epi::AFTER_DRAIN) { E.fused(acc, cur, wr, wc, fr, fq, lds, wid, lane); S.done(cur); }
#undef PG8_SA
#undef PG8_SB
#undef PG8_STAGE
#undef PG8_LDA
#undef PG8_LDB
#undef PG8_MMA
#undef PG8_WAIT_V
#undef PG8_WAIT_L
#undef PG8_BAR
#undef PG8_SCHED
}
}

#define LAS __attribute__((address_space(3)))
#define GAS __attribute__((address_space(1)))
typedef unsigned short bf16_t;
typedef short bf16x8 __attribute__((ext_vector_type(8)));
typedef float f32x4 __attribute__((ext_vector_type(4)));
typedef float f32x16 __attribute__((ext_vector_type(16)));
typedef float f32x2 __attribute__((ext_vector_type(2)));
typedef unsigned u32x4 __attribute__((ext_vector_type(4)));
typedef unsigned u32x2 __attribute__((ext_vector_type(2)));
constexpr int DM = 1024, SEQ = 16384, CTXL = 256, NLAT = 32768, TROWS = 33280, NK = SEQ + CTXL, DFF = 2816, INW = 2560, NMODW = 9216;
constexpr size_t MiB = (size_t)1 << 20;
constexpr size_t WS_MOD = 0, WS_LAM = 512 * 1024, WS_STATS = 3 * 512 * 1024 + 1024 * 1024 * 0, WS_XCNT = 768 * 1024, WS_XBAR = 800 * 1024, WS_ROPE = 1 * MiB, WS_XCTX = 2 * MiB, WS_W = 4 * MiB, WS_H = 84 * MiB, WS_BIG = 149 * MiB;
constexpr size_t W_GU1 = 0, W_DN1 = 11534336, W_IN = 17301504, W_OUT = 22544384, W_GU2 = 24641536, W_DN2 = 36175872, W_LAYER = 41943040;
constexpr size_t QU = 8519680;
constexpr size_t WS_ACT = WS_BIG, WS_Z = WS_BIG, WS_Y = WS_BIG + 163 * MiB, WS_QKV = WS_BIG + 228 * MiB;
constexpr size_t O_QA = 0, O_KA = 2 * QU, O_VAT = 4 * QU, O_QC = 6 * QU, O_KC = 8 * QU, O_VCT = 9 * QU, O_QD = 10 * QU, O_KD = 12 * QU, O_VDT = 13 * QU;
constexpr size_t WS_END = WS_QKV + 14 * QU;
constexpr int LDS_BYTES = 147456, LDS_RANK_OFF = 147440, LDS_XB_OFF = 147444;
constexpr float LOG2E = 1.4426950408889634f;
constexpr float QSCALE_A = 0.17677669529663687f * LOG2E;
constexpr float QSCALE_H = 0.125f * LOG2E;

struct Params { const float* in[23]; float* out; unsigned char* ws; };

__device__ __forceinline__ float bf2f(unsigned v) { return __uint_as_float(v << 16); }
typedef float f32x2_t __attribute__((ext_vector_type(2))); typedef __bf16 bf16x2_t __attribute__((ext_vector_type(2)));
__device__ __forceinline__ unsigned cvtpk(float lo, float hi) { f32x2_t v = {lo, hi}; bf16x2_t b = __builtin_convertvector(v, bf16x2_t); return __builtin_bit_cast(unsigned, b); }
__device__ __forceinline__ float wave_sum(float v) {
#pragma unroll
    for (int o = 1; o < 64; o <<= 1) v += __shfl_xor(v, o);
    return v;
}
__device__ __forceinline__ float xhalf_max(float v) { auto rr = __builtin_amdgcn_permlane32_swap(__float_as_uint(v), __float_as_uint(v), false, false); return fmaxf(__uint_as_float(rr[0]), __uint_as_float(rr[1])); }
__device__ __forceinline__ float xhalf_sum(float v) { auto rr = __builtin_amdgcn_permlane32_swap(__float_as_uint(v), __float_as_uint(v), false, false); return __uint_as_float(rr[0]) + __uint_as_float(rr[1]); }
__device__ __forceinline__ int crow(int r, int hi) { return (r & 3) + 8 * (r >> 2) + 4 * hi; }

__device__ __forceinline__ void transpose_item(const float* W, int K, int N, bf16_t* WT, bool gu, LAS float* scr, int item, int lane) {
    const int nblk = N / 32, kb = item / nblk, nb = item % nblk, k0 = 64 * kb, n0 = 32 * nb;
    int rbase = n0;
    if (gu) { const int half = n0 >= DFF ? 1 : 0, j0 = n0 - half * DFF; rbase = (j0 >> 7) * 256 + half * 128 + (j0 & 127); }
#pragma unroll 8
    for (int i = 0; i < 32; ++i) { const int kk = 2 * i + (lane >> 5); scr[kk * 33 + (lane & 31)] = W[(size_t)(k0 + kk) * N + n0 + (lane & 31)]; }
    asm volatile("s_waitcnt lgkmcnt(0)" ::: "memory");
    const int c = lane & 7;
#pragma unroll
    for (int j = 0; j < 4; ++j) { const int n = (lane >> 3) + 8 * j; const LAS float* s = scr + (8 * c) * 33 + n;
        u32x4 o; o.x = cvtpk(s[0 * 33], s[1 * 33]); o.y = cvtpk(s[2 * 33], s[3 * 33]); o.z = cvtpk(s[4 * 33], s[5 * 33]); o.w = cvtpk(s[6 * 33], s[7 * 33]);
        *(u32x4*)(WT + (size_t)(rbase + n) * K + k0 + 8 * c) = o; }
    asm volatile("s_waitcnt lgkmcnt(0)" ::: "memory");
}
__device__ __forceinline__ void dsincos(double a, float& c, float& s) {
    const double TWO_PI = 6.283185307179586476925286766559;
    const double k = __builtin_rint(a / TWO_PI); double r = a - k * TWO_PI;
    const double r2 = r * r; double tc = 1.0, ts = r, sc = 1.0, ss = r;
#pragma unroll 1
    for (int i = 1; i <= 16; ++i) { tc = -tc * r2 / (double)((2 * i - 1) * (2 * i)); ts = -ts * r2 / (double)((2 * i) * (2 * i + 1)); sc += tc; ss += ts; }
    c = (float)sc; s = (float)ss;
}
__device__ __forceinline__ void prologue(const Params& P, LAS unsigned char* lds) {
    int tid_ = threadIdx.x; asm volatile("" : "+v"(tid_)); const int tid = tid_, lane = tid & 63, wave = __builtin_amdgcn_readfirstlane(tid >> 6);
    GAS unsigned char* wsg_ = (GAS unsigned char*)P.ws; asm volatile("" : "+s"(wsg_)); unsigned char* ws = (unsigned char*)wsg_;
    LAS float* sv = (LAS float*)(lds + 69632); LAS float* red = sv + 3072;
    for (int k = tid; k < 3072; k += 512) { const int s = k >> 10, kk = k & 1023; const float c = s < 2 ? P.in[1][s * 1024 + kk] : P.in[3][kk]; sv[k] = c / (1.0f + __expf(-c)); }
    __syncthreads();
    float* mod = (float*)(ws + WS_MOD);
    for (int it = blockIdx.x; it < 288; it += gridDim.x) {
        const int l = it / 144, n0 = (it % 144) * 64;
        const float* w = P.in[4] + (size_t)l * 1024 * NMODW + (size_t)(wave * 128) * NMODW + n0 + lane;
        float a0 = 0.f, a1 = 0.f, a2 = 0.f;
#pragma unroll 8
        for (int k = 0; k < 128; ++k) { const float wv = w[(size_t)k * NMODW]; const int kk = wave * 128 + k; a0 += sv[kk] * wv; a1 += sv[1024 + kk] * wv; a2 += sv[2048 + kk] * wv; }
        red[(wave * 3 + 0) * 64 + lane] = a0; red[(wave * 3 + 1) * 64 + lane] = a1; red[(wave * 3 + 2) * 64 + lane] = a2;
        __syncthreads();
        if (tid < 192) { const int s = tid >> 6, ln = tid & 63; float t = 0.f;
#pragma unroll
            for (int w8 = 0; w8 < 8; ++w8) t += red[(w8 * 3 + s) * 64 + ln];
            mod[(size_t)(l * 3 + s) * NMODW + n0 + ln] = t + P.in[5][l * NMODW + n0 + ln]; }
        __syncthreads();
    }
    { const int gt = blockIdx.x * 512 + tid; float* rope = (float*)(ws + WS_ROPE);
      if (gt < 6144) { const int pos = gt / 24, f = gt % 24; double inv;
          if (f < 8) { inv = 1.0; for (int i = 0; i < (f >> 1); ++i) inv *= 0.1; if (f & 1) inv *= 0.31622776601683794; }
          else { const int i4 = f - 8; inv = 1.0; for (int i = 0; i < (i4 >> 2); ++i) inv *= 0.1; const int rm = i4 & 3; inv *= (rm == 0 ? 1.0 : rm == 1 ? 0.5623413251903491 : rm == 2 ? 0.31622776601683794 : 0.1778279410038923); }
          const float invf = (float)inv; const float ang = (float)pos * invf; float c, s; dsincos((double)ang, c, s);
          if (f < 8) { rope[pos * 8 + f] = c; rope[2048 + pos * 8 + f] = s; } else { rope[4096 + pos * 16 + (f - 8)] = c; rope[8192 + pos * 16 + (f - 8)] = s; } }
      if (gt == 6144 || gt == 6145) { const int l = gt - 6144; float s1 = 0.f, s2 = 0.f;
          for (int i = 0; i < 32; ++i) { s1 += P.in[13][l * 32 + i] * P.in[14][l * 32 + i]; s2 += P.in[15][l * 32 + i] * P.in[16][l * 32 + i]; }
          const float li = l == 0 ? 0.2f : 0.35550906759097f; ((float*)(ws + WS_LAM))[l] = expf(s1) - expf(s2) + li; } }
    { LAS float* scr = (LAS float*)(lds + wave * 8448);
      const int gw = blockIdx.x * 8 + wave, NGW = gridDim.x * 8;
      constexpr int I_GU = 16 * 176, I_DN = 44 * 32, I_IN = 16 * 80, I_OUT = 16 * 32, I_LAYER = 2 * I_GU + 2 * I_DN + I_IN + I_OUT;
      for (int it = gw; it < 2 * I_LAYER; it += NGW) {
          const int l = it / I_LAYER; int r = it % I_LAYER; unsigned char* wl = ws + WS_W + (size_t)l * W_LAYER;
          if (r < I_GU) { transpose_item(P.in[8] + (size_t)l * DM * 2 * DFF, DM, 2 * DFF, (bf16_t*)(wl + W_GU1), true, scr, r, lane); continue; } r -= I_GU;
          if (r < I_GU) { transpose_item(P.in[21] + (size_t)l * DM * 2 * DFF, DM, 2 * DFF, (bf16_t*)(wl + W_GU2), true, scr, r, lane); continue; } r -= I_GU;
          if (r < I_DN) { transpose_item(P.in[9] + (size_t)l * DFF * DM, DFF, DM, (bf16_t*)(wl + W_DN1), false, scr, r, lane); continue; } r -= I_DN;
          if (r < I_DN) { transpose_item(P.in[22] + (size_t)l * DFF * DM, DFF, DM, (bf16_t*)(wl + W_DN2), false, scr, r, lane); continue; } r -= I_DN;
          if (r < I_IN) { transpose_item(P.in[10] + (size_t)l * DM * INW, DM, INW, (bf16_t*)(wl + W_IN), false, scr, r, lane); continue; } r -= I_IN;
          transpose_item(P.in[11] + (size_t)l * DM * DM, DM, DM, (bf16_t*)(wl + W_OUT), false, scr, r, lane);
      } }
}

template <bool LN>
__device__ __forceinline__ void row_pass(const Params& P, int nrows, const float* gam, const float* bet, const float* shift0, const float* scale0, bool write_h, bool write_x) {
    int tid_ = threadIdx.x; asm volatile("" : "+v"(tid_)); const int tid = tid_, lane = tid & 63, wave = __builtin_amdgcn_readfirstlane(tid >> 6);
    const int gw = blockIdx.x * 8 + wave, NGW = gridDim.x * 8;
    GAS unsigned char* wsg_ = (GAS unsigned char*)P.ws; asm volatile("" : "+s"(wsg_)); unsigned char* ws = (unsigned char*)wsg_;
    float* xctx = (float*)(ws + WS_XCTX); bf16_t* H = (bf16_t*)(ws + WS_H); float* stats = (float*)(ws + WS_STATS);
    f32x4 sh[4], sc[4], g4[4], b4[4]; int curset = -1;
#pragma unroll
    for (int j = 0; j < 4; ++j) { sh[j] = (f32x4){0.f, 0.f, 0.f, 0.f}; sc[j] = sh[j]; g4[j] = sh[j]; b4[j] = sh[j]; }
    if (LN) {
#pragma unroll
        for (int j = 0; j < 4; ++j) { g4[j] = *(const f32x4*)(gam + 4 * lane + 256 * j); b4[j] = *(const f32x4*)(bet + 4 * lane + 256 * j); } }
    for (int r = gw; r < nrows; r += NGW) {
        const int set = r < SEQ ? 0 : (r < NLAT ? 1 : 2);
        if (write_h && set != curset) { curset = set;
#pragma unroll
            for (int j = 0; j < 4; ++j) { sh[j] = *(const f32x4*)(shift0 + set * NMODW + 4 * lane + 256 * j); sc[j] = *(const f32x4*)(scale0 + set * NMODW + 4 * lane + 256 * j); } }
        float* dst = r < NLAT ? P.out + (size_t)r * DM : xctx + (size_t)(r - NLAT) * DM;
        const float* src = LN ? dst : (r < NLAT ? P.in[0] + (size_t)r * DM : P.in[2] + (size_t)(r - NLAT) * DM);
        f32x4 v[4];
#pragma unroll
        for (int j = 0; j < 4; ++j) v[j] = *(const f32x4*)(src + 4 * lane + 256 * j);
        if (LN) {
            float s = 0.f;
#pragma unroll
            for (int j = 0; j < 4; ++j) s += (v[j][0] + v[j][1]) + (v[j][2] + v[j][3]);
            const float mean = wave_sum(s) * (1.0f / DM); float s2 = 0.f;
#pragma unroll
            for (int j = 0; j < 4; ++j) { v[j] = v[j] - mean; s2 += (v[j][0] * v[j][0] + v[j][1] * v[j][1]) + (v[j][2] * v[j][2] + v[j][3] * v[j][3]); }
            const float rstd = 1.0f / sqrtf(wave_sum(s2) * (1.0f / DM) + 1e-6f);
            if (!write_x && lane == 0) *(f32x2*)(stats + 2 * (size_t)r) = (f32x2){mean, rstd};
#pragma unroll
            for (int j = 0; j < 4; ++j) v[j] = v[j] * rstd * g4[j] + b4[j];
        }
        if (write_x) {
#pragma unroll
            for (int j = 0; j < 4; ++j) *(f32x4*)(dst + 4 * lane + 256 * j) = v[j]; }
        if (write_h) {
#pragma unroll
            for (int j = 0; j < 4; ++j) { const f32x4 h = v[j] * (sc[j] + 1.0f) + sh[j]; u32x2 o; o.x = cvtpk(h[0], h[1]); o.y = cvtpk(h[2], h[3]);
                *(u32x2*)(H + (size_t)r * DM + 4 * lane + 256 * j) = o; } }
    }
}

__device__ __forceinline__ void rope4(float (&v)[4], const float* ctab, const float* stab, bool odd, int xmask) {
    const f32x4 c = *(const f32x4*)ctab, s = *(const f32x4*)stab;
#pragma unroll
    for (int e = 0; e < 4; ++e) { const float p = __shfl_xor(v[e], xmask); v[e] = v[e] * c[e] + (odd ? p : -p) * s[e]; }
}
__device__ __forceinline__ void up4(const u32x2 raw, float (&v)[4]) { v[0] = bf2f(raw.x & 0xffffu); v[1] = bf2f(raw.x >> 16); v[2] = bf2f(raw.y & 0xffffu); v[3] = bf2f(raw.y >> 16); }
__device__ __forceinline__ void ld4(const bf16_t* p, float (&v)[4]) { const u32x2 raw = *(const u32x2*)p; v[0] = bf2f(raw.x & 0xffffu); v[1] = bf2f(raw.x >> 16); v[2] = bf2f(raw.y & 0xffffu); v[3] = bf2f(raw.y >> 16); }
__device__ __forceinline__ void st4(bf16_t* p, const float (&v)[4], float sc) { u32x2 o; o.x = cvtpk(v[0] * sc, v[1] * sc); o.y = cvtpk(v[2] * sc, v[3] * sc); *(u32x2*)p = o; }
__device__ __forceinline__ void st4lds(LAS bf16_t* p, const float (&v)[4]) { u32x2 o; o.x = cvtpk(v[0], v[1]); o.y = cvtpk(v[2], v[3]); *(LAS u32x2*)p = o; }

__device__ __forceinline__ void zpost_phase(const Params& P, LAS unsigned char* lds, int l) {
    int tid_ = threadIdx.x; asm volatile("" : "+v"(tid_)); const int tid = tid_, lane = tid & 63, wave = __builtin_amdgcn_readfirstlane(tid >> 6);
    GAS unsigned char* wsg_ = (GAS unsigned char*)P.ws; asm volatile("" : "+s"(wsg_)); unsigned char* ws = (unsigned char*)wsg_;
    const bf16_t* Z = (const bf16_t*)(ws + WS_Z); bf16_t* Y = (bf16_t*)(ws + WS_Y); unsigned char* qkv = ws + WS_QKV;
    bf16_t *QA = (bf16_t*)(qkv + O_QA), *KA = (bf16_t*)(qkv + O_KA), *VAT = (bf16_t*)(qkv + O_VAT), *QC = (bf16_t*)(qkv + O_QC), *KC = (bf16_t*)(qkv + O_KC), *VCT = (bf16_t*)(qkv + O_VCT),
           *QD = (bf16_t*)(qkv + O_QD), *KD = (bf16_t*)(qkv + O_KD), *VDT = (bf16_t*)(qkv + O_VDT);
    const float* rope = (const float*)(ws + WS_ROPE);
    const float* convw = P.in[12] + l * 768; const float* qnw = P.in[19] + l * 64; const float* knw = P.in[20] + l * 64;
    LAS bf16_t* vt = (LAS bf16_t*)lds;
    for (int u = blockIdx.x; u < 1040; u += gridDim.x) {
        const int b = u / 520, kt = u % 520, kk0 = kt * 32; const bool isctx = kt < 8;
        __syncthreads();
        for (int ii = 0; ii < 4; ++ii) {
            const int i = wave * 4 + ii, kk = kk0 + i;
            const int r = isctx ? NLAT + b * CTXL + kk : b * SEQ + kk - CTXL;
            const int t = kk - CTXL, prow = (t >> 6) & 255, pcol = t & 63;
            const bf16_t* z = Z + (size_t)r * INW;
            float v[4];
            const int lkk = lane & 31;
            const bool hasp_ = isctx ? (kk > 0) : (t > 0), hasn_ = isctx ? (kk < CTXL - 1) : (t < SEQ - 1);
            u32x2 zr[16];
            zr[0] = *(const u32x2*)(z + 4 * lane); zr[1] = *(const u32x2*)(z + 256 + 4 * lane); zr[2] = *(const u32x2*)(z + 512 + 4 * lane);
            zr[3] = *(const u32x2*)(z + 768 + 4 * lane); zr[4] = *(const u32x2*)(z + 1024 + 4 * lane); zr[5] = *(const u32x2*)(z + 1280 + 4 * lane);
            zr[6] = (u32x2){0u, 0u}; zr[7] = zr[6]; zr[8] = zr[6]; zr[9] = zr[6];
            if (hasp_) { zr[6] = *(const u32x2*)(z - INW + 1024 + 4 * lane); zr[7] = *(const u32x2*)(z - INW + 1280 + 4 * lane); }
            if (hasn_) { zr[8] = *(const u32x2*)(z + INW + 1024 + 4 * lane); zr[9] = *(const u32x2*)(z + INW + 1280 + 4 * lane); }
            zr[10] = *(const u32x2*)(z + 1536 + 4 * lane); zr[11] = *(const u32x2*)(z + 1792 + 4 * lkk); zr[12] = *(const u32x2*)(z + 1920 + 4 * lkk);
            zr[13] = *(const u32x2*)(z + 2048 + 4 * lane); zr[14] = *(const u32x2*)(z + 2304 + 4 * lkk); zr[15] = *(const u32x2*)(z + 2432 + 4 * lkk);
            { const int h = lane >> 4, c = (4 * lane) & 63, quarter = (lane & 7) >> 1, e0 = (lane & 1) * 4; const int pos = quarter < 2 ? prow : pcol;
              const float* ct = rope + pos * 8 + e0; const float* st = rope + 2048 + pos * 8 + e0;
              up4(zr[0], v); if (!isctx) rope4(v, ct, st, quarter & 1, 2);
              st4(QA + ((size_t)(b * 4 + h) * NK + kk) * 64 + c, v, QSCALE_A);
              up4(zr[1], v); if (!isctx) rope4(v, ct, st, quarter & 1, 2);
              st4(KA + ((size_t)(b * 4 + h) * NK + kk) * 64 + c, v, 1.0f);
              up4(zr[2], v); st4lds(vt + i * 520 + 4 * lane, v); }
            { const bool hasp = isctx ? (kk > 0) : (t > 0), hasn = isctx ? (kk < CTXL - 1) : (t < SEQ - 1);
              float gb[4], gc[4], uu[4], hm[4], hp[4]; up4(zr[3], gb); up4(zr[4], gc); up4(zr[5], uu);
#pragma unroll
              for (int e = 0; e < 4; ++e) { hm[e] = 0.f; hp[e] = 0.f; }
              if (hasp) { float a[4], c2[4]; up4(zr[6], a); up4(zr[7], c2);
#pragma unroll
                  for (int e = 0; e < 4; ++e) hm[e] = a[e] * c2[e]; }
              if (hasn) { float a[4], c2[4]; up4(zr[8], a); up4(zr[9], c2);
#pragma unroll
                  for (int e = 0; e < 4; ++e) hp[e] = a[e] * c2[e]; }
              const f32x4 w0 = *(const f32x4*)(convw + 4 * lane), w1 = *(const f32x4*)(convw + 256 + 4 * lane), w2 = *(const f32x4*)(convw + 512 + 4 * lane);
#pragma unroll
              for (int e = 0; e < 4; ++e) v[e] = gb[e] * (w0[e] * hm[e] + w1[e] * (gc[e] * uu[e]) + w2[e] * hp[e]);
              st4(Y + (size_t)r * DM + 256 + 4 * lane, v, 1.0f); }
            { const int hq = lane >> 4, c = (4 * lane) & 63, quarter = (lane & 15) >> 2, e0 = (lane & 3) * 4; const int pos = quarter < 2 ? prow : pcol;
              const float* ct = rope + 4096 + pos * 16 + e0; const float* st = rope + 8192 + pos * 16 + e0;
              const int lk = lane & 31, hk = lk >> 4;
              up4(zr[10], v); if (!isctx) rope4(v, ct, st, quarter & 1, 4);
              st4(QC + ((size_t)(b * 4 + hq) * NK + kk) * 64 + c, v, QSCALE_H);
              up4(zr[11], v); if (!isctx) rope4(v, ct, st, quarter & 1, 4);
              if (lane < 32) st4(KC + ((size_t)(b * 2 + hk) * NK + kk) * 64 + c, v, 1.0f);
              up4(zr[12], v); if (lane < 32) st4lds(vt + i * 520 + 256 + 4 * lk, v);
              up4(zr[13], v);
              { float ss = v[0] * v[0] + v[1] * v[1] + v[2] * v[2] + v[3] * v[3]; ss += __shfl_xor(ss, 1); ss += __shfl_xor(ss, 2); ss += __shfl_xor(ss, 4); ss += __shfl_xor(ss, 8);
                const float rs = 1.0f / sqrtf(ss * (1.0f / 64.0f) + 1e-6f); const f32x4 w = *(const f32x4*)(qnw + c);
#pragma unroll
                for (int e = 0; e < 4; ++e) v[e] = v[e] * rs * w[e]; }
              if (!isctx) rope4(v, ct, st, quarter & 1, 4);
              st4(QD + ((size_t)(b * 4 + hq) * NK + kk) * 64 + c, v, QSCALE_H);
              up4(zr[14], v);
              { float ss = v[0] * v[0] + v[1] * v[1] + v[2] * v[2] + v[3] * v[3]; ss += __shfl_xor(ss, 1); ss += __shfl_xor(ss, 2); ss += __shfl_xor(ss, 4); ss += __shfl_xor(ss, 8);
                const float rs = 1.0f / sqrtf(ss * (1.0f / 64.0f) + 1e-6f); const f32x4 w = *(const f32x4*)(knw + c);
#pragma unroll
                for (int e = 0; e < 4; ++e) v[e] = v[e] * rs * w[e]; }
              if (!isctx) rope4(v, ct, st, quarter & 1, 4);
              if (lane < 32) st4(KD + ((size_t)(b * 2 + hk) * NK + kk) * 64 + c, v, 1.0f);
              up4(zr[15], v); if (lane < 32) st4lds(vt + i * 520 + 384 + 4 * lk, v); }
        }
        __syncthreads();
#pragma unroll 2
        for (int it = 0; it < 4; ++it) { const int vc = it * 128 + (tid >> 2), g = tid & 3; bf16_t* dst;
          if (vc < 256) dst = VAT + ((size_t)(b * 4 + (vc >> 6)) * 64 + (vc & 63)) * NK;
          else if (vc < 384) dst = VCT + ((size_t)(b * 2 + ((vc - 256) >> 6)) * 64 + (vc & 63)) * NK;
          else dst = VDT + ((size_t)(b * 2 + ((vc - 384) >> 6)) * 64 + (vc & 63)) * NK;
          unsigned w[4];
#pragma unroll
          for (int i2 = 0; i2 < 4; ++i2) { const int ia = 2 * i2, ib = 2 * i2 + 1;
              const int ta = 16 * (g >> 1) + 8 * (ia >> 2) + 4 * (g & 1) + (ia & 3), tb = 16 * (g >> 1) + 8 * (ib >> 2) + 4 * (g & 1) + (ib & 3);
              w[i2] = (unsigned)vt[ta * 520 + vc] | ((unsigned)vt[tb * 520 + vc] << 16); }
          *(u32x4*)(dst + kk0 + 8 * g) = (u32x4){w[0], w[1], w[2], w[3]}; }
    }
}

__device__ __forceinline__ float fmax3(float a, float b, float c) { float r; asm("v_max3_f32 %0, %1, %2, %3" : "=v"(r) : "v"(a), "v"(b), "v"(c)); return r; }
__device__ __forceinline__ void g2_first(f32x16& acc, bf16x8 a, bf16x8 b, const f32x16& c, float& e0, float& e1, float& e2, float& e3, float p0, float p1, float p2, float p3) {
    asm volatile("s_nop 4\n\tv_mfma_f32_32x32x16_bf16 %0, %5, %6, %7\n\tv_exp_f32_e32 %1, %8\n\tv_exp_f32_e32 %2, %9\n\tv_exp_f32_e32 %3, %10\n\tv_exp_f32_e32 %4, %11\n\ts_nop 0"
                 : "=&v"(acc), "=&v"(e0), "=&v"(e1), "=&v"(e2), "=&v"(e3) : "v"(a), "v"(b), "v"(c), "v"(p0), "v"(p1), "v"(p2), "v"(p3)); }
__device__ __forceinline__ void g2_acc(f32x16& acc, bf16x8 a, bf16x8 b, float& e0, float& e1, float& e2, float& e3, float p0, float p1, float p2, float p3) {
    asm volatile("v_mfma_f32_32x32x16_bf16 %0, %5, %6, %0\n\tv_exp_f32_e32 %1, %7\n\tv_exp_f32_e32 %2, %8\n\tv_exp_f32_e32 %3, %9\n\tv_exp_f32_e32 %4, %10\n\ts_nop 0"
                 : "+v"(acc), "=&v"(e0), "=&v"(e1), "=&v"(e2), "=&v"(e3) : "v"(a), "v"(b), "v"(p0), "v"(p1), "v"(p2), "v"(p3)); }
__device__ __forceinline__ void g2_none(float& e0, float& e1, float& e2, float& e3, float p0, float p1, float p2, float p3) {
    asm volatile("v_exp_f32_e32 %0, %4\n\tv_exp_f32_e32 %1, %5\n\tv_exp_f32_e32 %2, %6\n\tv_exp_f32_e32 %3, %7\n\ts_nop 0"
                 : "=&v"(e0), "=&v"(e1), "=&v"(e2), "=&v"(e3) : "v"(p0), "v"(p1), "v"(p2), "v"(p3)); }
__device__ __forceinline__ bf16x8 pack8(const f32x16& e, int b) { const u32x4 t = (u32x4){cvtpk(e[b], e[b + 1]), cvtpk(e[b + 2], e[b + 3]), cvtpk(e[b + 4], e[b + 5]), cvtpk(e[b + 6], e[b + 7])}; return __builtin_bit_cast(bf16x8, t); }
__device__ __forceinline__ float sum4(const f32x16& e, int b) { return (e[b] + e[b + 1]) + (e[b + 2] + e[b + 3]); }
__device__ __forceinline__ void g1_a0(f32x16& o, bf16x8 vf, bf16x8 pw, float& ps, float a0, float a1, float a2, float a3) {
    asm volatile("s_nop 1\n\tv_mfma_f32_32x32x16_bf16 %0, %2, %3, %0\n\tv_add_f32_e32 %1, %1, %4\n\tv_add_f32_e32 %1, %1, %5\n\tv_add_f32_e32 %1, %1, %6\n\tv_add_f32_e32 %1, %1, %7"
                 : "+v"(o), "+v"(ps) : "v"(vf), "v"(pw), "v"(a0), "v"(a1), "v"(a2), "v"(a3)); }
__device__ __forceinline__ void g1_b0(f32x16& o, bf16x8 vf, bf16x8 pw, float& ps, float a0, float a1, float a2, float a3,
                                      unsigned& w0, unsigned& w1, unsigned& w2, unsigned& w3, float c0, float c1, float c2, float c3, float c4, float c5, float c6, float c7) {
    asm volatile("s_nop 1\n\tv_mfma_f32_32x32x16_bf16 %0, %6, %7, %0\n\tv_add_f32_e32 %1, %1, %8\n\tv_add_f32_e32 %1, %1, %9\n\tv_add_f32_e32 %1, %1, %10\n\tv_add_f32_e32 %1, %1, %11\n\t"
                 "v_cvt_pk_bf16_f32 %2, %12, %13\n\tv_cvt_pk_bf16_f32 %3, %14, %15\n\tv_cvt_pk_bf16_f32 %4, %16, %17\n\tv_cvt_pk_bf16_f32 %5, %18, %19"
                 : "+v"(o), "+v"(ps), "=&v"(w0), "=&v"(w1), "=&v"(w2), "=&v"(w3)
                 : "v"(vf), "v"(pw), "v"(a0), "v"(a1), "v"(a2), "v"(a3), "v"(c0), "v"(c1), "v"(c2), "v"(c3), "v"(c4), "v"(c5), "v"(c6), "v"(c7)); }
__device__ __forceinline__ void g1_a(f32x16& o, bf16x8 vf, bf16x8 pw, float& mx, float m0, float m1, float m2, float m3, float& ps, float a0, float a1, float a2, float a3) {
    asm volatile("s_nop 1\n\tv_mfma_f32_32x32x16_bf16 %0, %3, %4, %0\n\tv_max3_f32 %1, %1, %5, %6\n\tv_max3_f32 %1, %1, %7, %8\n\t"
                 "v_add_f32_e32 %2, %2, %9\n\tv_add_f32_e32 %2, %2, %10\n\tv_add_f32_e32 %2, %2, %11\n\tv_add_f32_e32 %2, %2, %12"
                 : "+v"(o), "+v"(mx), "+v"(ps) : "v"(vf), "v"(pw), "v"(m0), "v"(m1), "v"(m2), "v"(m3), "v"(a0), "v"(a1), "v"(a2), "v"(a3)); }
__device__ __forceinline__ void g1_b(f32x16& o, bf16x8 vf, bf16x8 pw, float& mx, float m0, float m1, float m2, float m3, float& ps, float a0, float a1, float a2, float a3,
                                     unsigned& w0, unsigned& w1, unsigned& w2, unsigned& w3, float c0, float c1, float c2, float c3, float c4, float c5, float c6, float c7) {
    asm volatile("s_nop 1\n\tv_mfma_f32_32x32x16_bf16 %0, %7, %8, %0\n\tv_max3_f32 %1, %1, %9, %10\n\tv_max3_f32 %1, %1, %11, %12\n\t"
                 "v_add_f32_e32 %2, %2, %13\n\tv_add_f32_e32 %2, %2, %14\n\tv_add_f32_e32 %2, %2, %15\n\tv_add_f32_e32 %2, %2, %16\n\t"
                 "v_cvt_pk_bf16_f32 %3, %17, %18\n\tv_cvt_pk_bf16_f32 %4, %19, %20\n\tv_cvt_pk_bf16_f32 %5, %21, %22\n\tv_cvt_pk_bf16_f32 %6, %23, %24"
                 : "+v"(o), "+v"(mx), "+v"(ps), "=&v"(w0), "=&v"(w1), "=&v"(w2), "=&v"(w3)
                 : "v"(vf), "v"(pw), "v"(m0), "v"(m1), "v"(m2), "v"(m3), "v"(a0), "v"(a1), "v"(a2), "v"(a3), "v"(c0), "v"(c1), "v"(c2), "v"(c3), "v"(c4), "v"(c5), "v"(c6), "v"(c7)); }
struct AttnPtrs { const bf16_t* Q; const bf16_t* K; const bf16_t* Vt; bf16_t* Y; const float* subw; const float* sink; float lam; float oml; };
template <int MODE>
__device__ __forceinline__ void attn_unit(LAS unsigned char* lds, const AttnPtrs& A, int b, int head, int qt) {
    int tid_ = threadIdx.x; asm volatile("" : "+v"(tid_)); const int tid = tid_, lane = tid & 63, r32 = lane & 31, hi = lane >> 5;
    const int wid = __builtin_amdgcn_readfirstlane(tid >> 6), sub = wid >> 2, rq = (wid & 3) * 32;
    constexpr int DQ = (MODE == 0) ? 32 : 64, NCH = DQ / 16, NKVH = (MODE == 0) ? 4 : 2;
    constexpr int KBUF = 9216, VBUF = 9216, VS0 = 4 * KBUF, XB0 = VS0 + 5 * VBUF;
    constexpr float THR = 8.0f;
    const int q0 = qt * 128;
    const int qhead = (MODE == 0) ? head : head * 2 + sub;
    const int doff = (MODE == 0) ? sub * 32 : 0;
    const bf16_t* Qrow = A.Q + ((size_t)(b * 4 + qhead) * NK + q0 + rq + r32) * 64 + doff;
    const bf16_t* Kb = A.K + (size_t)(b * NKVH + head) * NK * 64;
    const bf16_t* Vb = A.Vt + (size_t)(b * NKVH + head) * 64 * NK;
    bf16x8 qf[NCH];
#pragma unroll
    for (int j = 0; j < NCH; ++j) qf[j] = *(const bf16x8*)(Qrow + 16 * j + 8 * hi);
    int lo = 4, hit = 4;
    if (qt >= 2) { if (MODE == 1) { lo = (q0 - 128) >> 6; if (lo < 4) lo = 4; hit = (q0 + 256) >> 6; if (hit > 260) hit = 260; } else { hit = 260; } }
    const int nsteps = 4 + hit - lo;
#define ATT_TILE(s) ((s) < 4 ? (s) : lo + (s) - 4)
    const int srow = tid >> 3, sch = tid & 7;
    const bf16_t* kg = Kb + (size_t)srow * 64 + sch * 8;
    const bf16_t* vg = Vb + (size_t)srow * NK + sch * 8;
    const unsigned sofs = srow * 144 + sch * 16;
    LAS unsigned char* Ks = lds; LAS unsigned char* Vs = lds + VS0;
    const LAS unsigned char* kp0 = Ks + r32 * 144 + (doff + 8 * hi) * 2;
    const LAS unsigned char* vp0 = Vs + r32 * 144 + hi * 16;
    const int qrel = q0 + rq + r32;
    f32x16 negm, p0, p1, o0, o1;
#pragma unroll
    for (int r = 0; r < 16; ++r) { negm[r] = 0.f; o0[r] = 0.f; o1[r] = 0.f; }
    asm volatile("" : "+v"(negm));
#define ATT_QK(D0, D1, kbuf) do { const LAS unsigned char* kp_ = kp0 + (kbuf) * KBUF; \
        _Pragma("unroll") for (int j = 0; j < NCH; ++j) { const bf16x8 k0_ = *(const LAS bf16x8*)(kp_ + j * 32); const bf16x8 k1_ = *(const LAS bf16x8*)(kp_ + 32 * 144 + j * 32); \
            if (j == 0) { D0 = __builtin_amdgcn_mfma_f32_32x32x16_bf16(k0_, qf[0], negm, 0, 0, 0); D1 = __builtin_amdgcn_mfma_f32_32x32x16_bf16(k1_, qf[0], negm, 0, 0, 0); } \
            else { D0 = __builtin_amdgcn_mfma_f32_32x32x16_bf16(k0_, qf[j], D0, 0, 0, 0); D1 = __builtin_amdgcn_mfma_f32_32x32x16_bf16(k1_, qf[j], D1, 0, 0, 0); } } } while (0)
#define ATT_MASK(D0, D1, s) do { if (MODE == 1 && (s) >= 4) { asm volatile("s_nop 7\n\ts_nop 3" ::: "memory");     \
        const int db_ = (lo + (s) - 4) * 64 - qrel; \
        _Pragma("unroll") for (int r = 0; r < 16; ++r) { const int d0_ = db_ + crow(r, hi), d1_ = d0_ + 32; \
            if (d0_ > 128 || d0_ < -128) D0[r] = -1e30f; if (d1_ > 128 || d1_ < -128) D1[r] = -1e30f; } } } while (0)
#define ATT_LDK(s) (*(const u32x4*)(kg + (size_t)ATT_TILE(s) * 4096))
#define ATT_LDV(s) (*(const u32x4*)(vg + ATT_TILE(s) * 64))

    __syncthreads();
    u32x4 kqa = (u32x4){0u, 0u, 0u, 0u}, vqa = kqa, kqb = kqa, vqb = kqa;
    { const u32x4 k0r = ATT_LDK(0); const u32x4 v0r = ATT_LDV(0); const u32x4 k1r = ATT_LDK(1); const u32x4 k2r = ATT_LDK(2); const u32x4 v1r = ATT_LDV(1);
      kqb = ATT_LDK(3); vqb = ATT_LDV(2);
      *(LAS u32x4*)(Ks + sofs) = k0r; *(LAS u32x4*)(Vs + sofs) = v0r; *(LAS u32x4*)(Ks + KBUF + sofs) = k1r; *(LAS u32x4*)(Ks + 2 * KBUF + sofs) = k2r; *(LAS u32x4*)(Vs + VBUF + sofs) = v1r; }
    __syncthreads();
    f32x16 pb0, pb1;
    ATT_QK(p0, p1, 0);
    float m = 0.f, lsum = 0.f;
    int kb_cur = 0;
#define ATT_MAXUPD(S, P0, P1) do { \
        float mx = fmax3(fmax3(P0[0], P1[0], P0[1]), P1[1], P0[2]); \
        _Pragma("unroll") for (int r = 2; r < 14; r += 2) mx = fmax3(fmax3(mx, P1[r], P0[r + 1]), P1[r + 1], P0[r + 2]); \
        mx = fmax3(fmax3(mx, P1[14], P0[15]), P1[15], P1[15]); \
        mx = xhalf_max(mx); \
        if ((S) == 0 || __any(mx > THR)) { \
            const float dl = ((S) == 0) ? mx : fmaxf(mx, 0.f); \
            m += dl; \
            _Pragma("unroll") for (int r = 0; r < 16; ++r) { P0[r] -= dl; P1[r] -= dl; negm[r] = -m; } \
            asm volatile("" : "+v"(negm)); \
            if ((S) > 0) { const float f = __builtin_amdgcn_exp2f(-dl); lsum *= f; \
                _Pragma("unroll") for (int r = 0; r < 16; ++r) { o0[r] *= f; o1[r] *= f; } } \
        } } while (0)
#define ATT_EXPPACK(P0, P1, PW) do { \
        float ps = 0.f; \
        _Pragma("unroll") for (int r = 0; r < 16; ++r) { P0[r] = __builtin_amdgcn_exp2f(P0[r]); P1[r] = __builtin_amdgcn_exp2f(P1[r]); ps += P0[r] + P1[r]; } \
        lsum += ps; \
        { u32x4 t; \
          t.x = cvtpk(P0[0], P0[1]); t.y = cvtpk(P0[2], P0[3]); t.z = cvtpk(P0[4], P0[5]); t.w = cvtpk(P0[6], P0[7]); PW[0] = __builtin_bit_cast(bf16x8, t); \
          t.x = cvtpk(P0[8], P0[9]); t.y = cvtpk(P0[10], P0[11]); t.z = cvtpk(P0[12], P0[13]); t.w = cvtpk(P0[14], P0[15]); PW[1] = __builtin_bit_cast(bf16x8, t); \
          t.x = cvtpk(P1[0], P1[1]); t.y = cvtpk(P1[2], P1[3]); t.z = cvtpk(P1[4], P1[5]); t.w = cvtpk(P1[6], P1[7]); PW[2] = __builtin_bit_cast(bf16x8, t); \
          t.x = cvtpk(P1[8], P1[9]); t.y = cvtpk(P1[10], P1[11]); t.z = cvtpk(P1[12], P1[13]); t.w = cvtpk(P1[14], P1[15]); PW[3] = __builtin_bit_cast(bf16x8, t); } } while (0)
#define ATT_PV(PW, vslot) do { const LAS unsigned char* vp_ = vp0 + (vslot) * VBUF; \
        _Pragma("unroll") for (int c = 0; c < 4; ++c) { const bf16x8 v0_ = *(const LAS bf16x8*)(vp_ + c * 32); const bf16x8 v1_ = *(const LAS bf16x8*)(vp_ + 32 * 144 + c * 32); \
            o0 = __builtin_amdgcn_mfma_f32_32x32x16_bf16(v0_, PW[c], o0, 0, 0, 0); o1 = __builtin_amdgcn_mfma_f32_32x32x16_bf16(v1_, PW[c], o1, 0, 0, 0); } } while (0)
    bf16x8 pwk[4];
#pragma unroll
    for (int c = 0; c < 4; ++c) pwk[c] = (bf16x8){0, 0, 0, 0, 0, 0, 0, 0};
#define ATT_LDVF(VF, vslot) do { const LAS unsigned char* vp_ = vp0 + (vslot) * VBUF; \
        _Pragma("unroll") for (int c = 0; c < 4; ++c) { VF[2 * c] = *(const LAS bf16x8*)(vp_ + c * 32); VF[2 * c + 1] = *(const LAS bf16x8*)(vp_ + 32 * 144 + c * 32); } } while (0)
#define ATT_LDKF(KF, kslot) do { const LAS unsigned char* kp_ = kp0 + (kslot) * KBUF; \
        _Pragma("unroll") for (int j = 0; j < NCH; ++j) { KF[2 * j] = *(const LAS bf16x8*)(kp_ + j * 32); KF[2 * j + 1] = *(const LAS bf16x8*)(kp_ + 32 * 144 + j * 32); } } while (0)
#define ATT_PVF(VF, PW) do { \
        _Pragma("unroll") for (int c = 0; c < 4; ++c) { o0 = __builtin_amdgcn_mfma_f32_32x32x16_bf16(VF[2 * c], PW[c], o0, 0, 0, 0); o1 = __builtin_amdgcn_mfma_f32_32x32x16_bf16(VF[2 * c + 1], PW[c], o1, 0, 0, 0); } } while (0)
#define ATT_QKF(KF, D0, D1) do { \
        D0 = __builtin_amdgcn_mfma_f32_32x32x16_bf16(KF[0], qf[0], negm, 0, 0, 0); D1 = __builtin_amdgcn_mfma_f32_32x32x16_bf16(KF[1], qf[0], negm, 0, 0, 0); \
        _Pragma("unroll") for (int j = 1; j < NCH; ++j) { D0 = __builtin_amdgcn_mfma_f32_32x32x16_bf16(KF[2 * j], qf[j], D0, 0, 0, 0); D1 = __builtin_amdgcn_mfma_f32_32x32x16_bf16(KF[2 * j + 1], qf[j], D1, 0, 0, 0); } } while (0)
#define ATT_VV(P0, P1, i) ((i) < 16 ? P0[(i) & 15] : P1[(i) & 15])
#define ATT_MXOP(P0, P1, k) do { if ((k) == 0) mx_ = fmax3(P0[0], P0[1], P0[2]); else if ((k) == 15) mx_ = fmax3(mx_, P1[15], P1[15]); \
        else mx_ = fmax3(mx_, ATT_VV(P0, P1, 1 + 2 * (k)), ATT_VV(P0, P1, 2 + 2 * (k))); } while (0)
#define ATT_SB() __builtin_amdgcn_sched_barrier(0)
#define ATT_STEP(BAR, S, FIRST, CHK, P0, P1, N0, N1, KN, VN, KO, VO) do { \
        if (BAR) __syncthreads(); \
        const int kb_n1 = (kb_cur + 1) & 3; const int vb_prev = vb_cur == 0 ? 4 : vb_cur - 1; \
        bf16x8 kf_[2 * NCH]; \
        float mx_; \
        if (!(FIRST)) { \
            if (BAR) { ATT_LDVF(vf_, vb_prev); }     \
            ATT_SB(); \
            __builtin_amdgcn_s_setprio(1); \
              \
            float ps_ = 0.f; mx_ = P0[0]; bf16x8 pwa_ = pack8(N0, 0), pwb_; unsigned w0_, w1_, w2_, w3_; \
            if (CHK) { \
            g1_a(o0, vf_[0], pwa_, mx_, P0[1], P0[2], P0[3], P0[4], ps_, N0[0], N0[1], N0[2], N0[3]); \
            g1_b(o1, vf_[1], pwa_, mx_, P0[5], P0[6], P0[7], P0[8], ps_, N0[4], N0[5], N0[6], N0[7], w0_, w1_, w2_, w3_, N0[8], N0[9], N0[10], N0[11], N0[12], N0[13], N0[14], N0[15]); \
            { const u32x4 t_ = (u32x4){w0_, w1_, w2_, w3_}; pwb_ = __builtin_bit_cast(bf16x8, t_); } \
            g1_a(o0, vf_[2], pwb_, mx_, P0[9], P0[10], P0[11], P0[12], ps_, N0[8], N0[9], N0[10], N0[11]); \
            g1_b(o1, vf_[3], pwb_, mx_, P0[13], P0[14], P0[15], P1[0], ps_, N0[12], N0[13], N0[14], N0[15], w0_, w1_, w2_, w3_, N1[0], N1[1], N1[2], N1[3], N1[4], N1[5], N1[6], N1[7]); \
            { const u32x4 t_ = (u32x4){w0_, w1_, w2_, w3_}; pwa_ = __builtin_bit_cast(bf16x8, t_); } \
            g1_a(o0, vf_[4], pwa_, mx_, P1[1], P1[2], P1[3], P1[4], ps_, N1[0], N1[1], N1[2], N1[3]); \
            g1_b(o1, vf_[5], pwa_, mx_, P1[5], P1[6], P1[7], P1[8], ps_, N1[4], N1[5], N1[6], N1[7], w0_, w1_, w2_, w3_, N1[8], N1[9], N1[10], N1[11], N1[12], N1[13], N1[14], N1[15]); \
            { const u32x4 t_ = (u32x4){w0_, w1_, w2_, w3_}; pwb_ = __builtin_bit_cast(bf16x8, t_); } \
            g1_a(o0, vf_[6], pwb_, mx_, P1[9], P1[10], P1[11], P1[12], ps_, N1[8], N1[9], N1[10], N1[11]); \
            g1_a(o1, vf_[7], pwb_, mx_, P1[13], P1[14], P1[15], P1[15], ps_, N1[12], N1[13], N1[14], N1[15]); \
            } else { \
            g1_a0(o0, vf_[0], pwa_, ps_, N0[0], N0[1], N0[2], N0[3]); \
            g1_b0(o1, vf_[1], pwa_, ps_, N0[4], N0[5], N0[6], N0[7], w0_, w1_, w2_, w3_, N0[8], N0[9], N0[10], N0[11], N0[12], N0[13], N0[14], N0[15]); \
            { const u32x4 t_ = (u32x4){w0_, w1_, w2_, w3_}; pwb_ = __builtin_bit_cast(bf16x8, t_); } \
            g1_a0(o0, vf_[2], pwb_, ps_, N0[8], N0[9], N0[10], N0[11]); \
            g1_b0(o1, vf_[3], pwb_, ps_, N0[12], N0[13], N0[14], N0[15], w0_, w1_, w2_, w3_, N1[0], N1[1], N1[2], N1[3], N1[4], N1[5], N1[6], N1[7]); \
            { const u32x4 t_ = (u32x4){w0_, w1_, w2_, w3_}; pwa_ = __builtin_bit_cast(bf16x8, t_); } \
            g1_a0(o0, vf_[4], pwa_, ps_, N1[0], N1[1], N1[2], N1[3]); \
            g1_b0(o1, vf_[5], pwa_, ps_, N1[4], N1[5], N1[6], N1[7], w0_, w1_, w2_, w3_, N1[8], N1[9], N1[10], N1[11], N1[12], N1[13], N1[14], N1[15]); \
            { const u32x4 t_ = (u32x4){w0_, w1_, w2_, w3_}; pwb_ = __builtin_bit_cast(bf16x8, t_); } \
            g1_a0(o0, vf_[6], pwb_, ps_, N1[8], N1[9], N1[10], N1[11]); \
            g1_a0(o1, vf_[7], pwb_, ps_, N1[12], N1[13], N1[14], N1[15]); \
            } \
            lsum += ps_; \
        } else { \
            _Pragma("unroll") for (int k = 0; k < 16; ++k) ATT_MXOP(P0, P1, k); \
        } \
        __builtin_amdgcn_s_setprio(0); \
        ATT_LDKF(kf_, kb_n1); \
        { const int sk_ = (S) + 4 < nsteps ? (S) + 4 : nsteps - 1, sv_ = (S) + 3 < nsteps ? (S) + 3 : nsteps - 1;     \
          KN = ATT_LDK(sk_); VN = ATT_LDV(sv_); } \
        ATT_SB(); \
        if (CHK) { const float mx = xhalf_max(mx_); \
          if ((FIRST) || __any(mx > THR)) { \
            const float dl = (FIRST) ? mx : fmaxf(mx, 0.f); \
            m += dl; \
            _Pragma("unroll") for (int r = 0; r < 16; ++r) { P0[r] -= dl; P1[r] -= dl; negm[r] = -m; } \
            asm volatile("" : "+v"(negm)); \
            if (!(FIRST)) { asm volatile("s_nop 11" ::: "memory"); const float f = __builtin_amdgcn_exp2f(-dl); lsum *= f; \
                _Pragma("unroll") for (int r = 0; r < 16; ++r) { o0[r] *= f; o1[r] *= f; } } \
          } } \
        ATT_SB(); \
        { \
          _Pragma("unroll") for (int g = 0; g < 8; ++g) { \
            constexpr int GSTEP = 8 / (2 * NCH); \
            const float q0_ = g < 4 ? P0[(4 * g) & 15] : P1[(4 * g) & 15], q1_ = g < 4 ? P0[(4 * g + 1) & 15] : P1[(4 * g + 1) & 15], q2_ = g < 4 ? P0[(4 * g + 2) & 15] : P1[(4 * g + 2) & 15], q3_ = g < 4 ? P0[(4 * g + 3) & 15] : P1[(4 * g + 3) & 15]; \
            float e0, e1, e2, e3; \
            if ((g % GSTEP) == 0) { const int mi = g / GSTEP, j = mi >> 1; \
                if ((mi & 1) == 0) { if (j == 0) g2_first(N0, kf_[0], qf[0], negm, e0, e1, e2, e3, q0_, q1_, q2_, q3_); else g2_acc(N0, kf_[2 * j], qf[j], e0, e1, e2, e3, q0_, q1_, q2_, q3_); } \
                else { if (j == 0) g2_first(N1, kf_[1], qf[0], negm, e0, e1, e2, e3, q0_, q1_, q2_, q3_); else g2_acc(N1, kf_[2 * j + 1], qf[j], e0, e1, e2, e3, q0_, q1_, q2_, q3_); } } \
            else g2_none(e0, e1, e2, e3, q0_, q1_, q2_, q3_); \
            if (g < 4) { P0[(4 * g) & 15] = e0; P0[(4 * g + 1) & 15] = e1; P0[(4 * g + 2) & 15] = e2; P0[(4 * g + 3) & 15] = e3; } \
            else { P1[(4 * g) & 15] = e0; P1[(4 * g + 1) & 15] = e1; P1[(4 * g + 2) & 15] = e2; P1[(4 * g + 3) & 15] = e3; } \
            ATT_SB(); } } \
        ATT_MASK(N0, N1, (S) + 1); \
        *(LAS u32x4*)(Ks + ((kb_cur + 3) & 3) * KBUF + sofs) = KO; \
        *(LAS u32x4*)(Vs + (vb_cur >= 3 ? vb_cur - 3 : vb_cur + 2) * VBUF + sofs) = VO; \
        if (BAR) { ATT_LDVF(vf_, vb_cur); }     \
        kb_cur = kb_n1; vb_cur = vb_cur == 4 ? 0 : vb_cur + 1; } while (0)
    int vb_cur = 0;
    bf16x8 vf_[8];
    ATT_STEP(false, 0, true, true, p0, p1, pb0, pb1, kqa, vqa, kqb, vqb);
    int s = 1;
    for (; s + 7 < nsteps; s += 8) {
        ATT_STEP(true, s, false, false, pb0, pb1, p0, p1, kqb, vqb, kqa, vqa);
        ATT_STEP(false, s + 1, false, false, p0, p1, pb0, pb1, kqa, vqa, kqb, vqb);
        ATT_STEP(true, s + 2, false, false, pb0, pb1, p0, p1, kqb, vqb, kqa, vqa);
        ATT_STEP(false, s + 3, false, false, p0, p1, pb0, pb1, kqa, vqa, kqb, vqb);
        ATT_STEP(true, s + 4, false, false, pb0, pb1, p0, p1, kqb, vqb, kqa, vqa);
        ATT_STEP(false, s + 5, false, false, p0, p1, pb0, pb1, kqa, vqa, kqb, vqb);
        ATT_STEP(true, s + 6, false, false, pb0, pb1, p0, p1, kqb, vqb, kqa, vqa);
        ATT_STEP(false, s + 7, false, true, p0, p1, pb0, pb1, kqa, vqa, kqb, vqb);
    }
    for (; s + 1 < nsteps; s += 2) {
        ATT_STEP(true, s, false, false, pb0, pb1, p0, p1, kqb, vqb, kqa, vqa);
        ATT_STEP(false, s + 1, false, true, p0, p1, pb0, pb1, kqa, vqa, kqb, vqb);
    }
    ATT_STEP(true, nsteps - 1, false, false, pb0, pb1, p0, p1, kqb, vqb, kqa, vqa);
    { bf16x8 vfl[8]; ATT_LDVF(vfl, (vb_cur == 0 ? 4 : vb_cur - 1));
      const bf16x8 w0 = pack8(pb0, 0), w1 = pack8(pb0, 8), w2 = pack8(pb1, 0), w3 = pack8(pb1, 8);
      o0 = __builtin_amdgcn_mfma_f32_32x32x16_bf16(vfl[0], w0, o0, 0, 0, 0); o1 = __builtin_amdgcn_mfma_f32_32x32x16_bf16(vfl[1], w0, o1, 0, 0, 0);
      o0 = __builtin_amdgcn_mfma_f32_32x32x16_bf16(vfl[2], w1, o0, 0, 0, 0); o1 = __builtin_amdgcn_mfma_f32_32x32x16_bf16(vfl[3], w1, o1, 0, 0, 0);
      o0 = __builtin_amdgcn_mfma_f32_32x32x16_bf16(vfl[4], w2, o0, 0, 0, 0); o1 = __builtin_amdgcn_mfma_f32_32x32x16_bf16(vfl[5], w2, o1, 0, 0, 0);
      o0 = __builtin_amdgcn_mfma_f32_32x32x16_bf16(vfl[6], w3, o0, 0, 0, 0); o1 = __builtin_amdgcn_mfma_f32_32x32x16_bf16(vfl[7], w3, o1, 0, 0, 0);
      lsum += ((sum4(pb0, 0) + sum4(pb0, 4)) + (sum4(pb0, 8) + sum4(pb0, 12))) + ((sum4(pb1, 0) + sum4(pb1, 4)) + (sum4(pb1, 8) + sum4(pb1, 12))); }
#undef ATT_MAXUPD
#undef ATT_VV
#undef ATT_MXOP
#undef ATT_SB
#undef ATT_LDVF
#undef ATT_LDKF
#undef ATT_PVF
#undef ATT_QKF
#undef ATT_EXPPACK
#undef ATT_PV
#undef ATT_STEP
#undef ATT_LDK
#undef ATT_LDV
#undef ATT_TILE
#undef ATT_QK
#undef ATT_MASK
    float lt = xhalf_sum(lsum);
    if (MODE == 1) lt += __builtin_amdgcn_exp2f(A.sink[qhead] * LOG2E - m);
    const float inv = 1.0f / lt;
#pragma unroll
    for (int r = 0; r < 16; ++r) { o0[r] *= inv; o1[r] *= inv; }
    const int qq = q0 + rq + r32;
    const size_t yrow = qq < CTXL ? (size_t)(NLAT + b * CTXL + qq) : (size_t)b * SEQ + (qq - CTXL);
    if (MODE == 0) {
        LAS float* xb = (LAS float*)(lds + XB0) + (wid & 3) * 2048;
        if (sub == 1) {
#pragma unroll
            for (int r = 0; r < 16; ++r) { xb[r * 64 + lane] = o0[r]; xb[(16 + r) * 64 + lane] = o1[r]; } }
        __syncthreads();
        if (sub == 0) { float ss = 0.f;
#pragma unroll
            for (int r = 0; r < 16; ++r) { o0[r] -= A.lam * xb[r * 64 + lane]; o1[r] -= A.lam * xb[(16 + r) * 64 + lane]; ss += o0[r] * o0[r] + o1[r] * o1[r]; }
            ss = xhalf_sum(ss); const float rs = A.oml / sqrtf(ss * (1.0f / 64.0f) + 1e-6f);
            bf16_t* yp = A.Y + yrow * DM + head * 64;
#pragma unroll
            for (int rg = 0; rg < 4; ++rg) { const int dv = 8 * rg + 4 * hi; const f32x4 w0 = *(const f32x4*)(A.subw + dv), w1 = *(const f32x4*)(A.subw + 32 + dv);
                u32x2 a, c2; a.x = cvtpk(o0[4 * rg] * rs * w0[0], o0[4 * rg + 1] * rs * w0[1]); a.y = cvtpk(o0[4 * rg + 2] * rs * w0[2], o0[4 * rg + 3] * rs * w0[3]);
                c2.x = cvtpk(o1[4 * rg] * rs * w1[0], o1[4 * rg + 1] * rs * w1[1]); c2.y = cvtpk(o1[4 * rg + 2] * rs * w1[2], o1[4 * rg + 3] * rs * w1[3]);
                *(u32x2*)(yp + dv) = a; *(u32x2*)(yp + 32 + dv) = c2; } }
    } else {
        bf16_t* yp = A.Y + yrow * DM + (MODE == 1 ? 512 : 768) + qhead * 64;
#pragma unroll
        for (int rg = 0; rg < 4; ++rg) { const int dv = 8 * rg + 4 * hi;
            u32x2 a, c2; a.x = cvtpk(o0[4 * rg], o0[4 * rg + 1]); a.y = cvtpk(o0[4 * rg + 2], o0[4 * rg + 3]);
            c2.x = cvtpk(o1[4 * rg], o1[4 * rg + 1]); c2.y = cvtpk(o1[4 * rg + 2], o1[4 * rg + 3]);
            *(u32x2*)(yp + dv) = a; *(u32x2*)(yp + 32 + dv) = c2; }
    }
}
__device__ __forceinline__ unsigned xcc_id() { return (unsigned)__builtin_amdgcn_s_getreg((3 << 11) | 20) & 0xFu; }
__device__ __forceinline__ void attn_phase(const Params& P, LAS unsigned char* lds, int l) {
    GAS unsigned char* wsg_ = (GAS unsigned char*)P.ws; asm volatile("" : "+s"(wsg_)); unsigned char* ws = (unsigned char*)wsg_;
    unsigned char* qkv = ws + WS_QKV; bf16_t* Y = (bf16_t*)(ws + WS_Y);
    const float lam = ((const float*)(ws + WS_LAM))[l]; const float oml = 1.0f - (l == 0 ? 0.2f : 0.35550906759097f);
    const float* subw = P.in[17] + l * 64; const float* sink = P.in[18] + l * 4;
    const unsigned* xcnt = (const unsigned*)(ws + WS_XCNT);
    const int myx = (int)xcc_id(); const int rank = __builtin_amdgcn_readfirstlane(*(const LAS int*)(lds + LDS_RANK_OFF));
    int nx = 0, vx = 0, nloc = 1;
    for (int j = 0; j < 16; ++j) { const int cj = (int)xcnt[j]; if (cj > 0) { if (j < myx) ++vx; ++nx; } if (j == myx) nloc = cj; }
    if (nx < 1) nx = 1; if (nloc < 1) nloc = 1;
    const int nlist = (l == 0) ? 260 : 256;
    for (int g = vx; g < 8; g += nx) {
        for (int i = rank; i < nlist; i += nloc) {
            int mode, b, head, qt;
            if (i < 128) { mode = 0; b = g >> 2; head = g & 3; qt = 2 + i; }
            else if (i < 192) { mode = 2; b = (g & 3) >> 1; head = g & 1; qt = 2 + 64 * (g >> 2) + (i - 128); }
            else if (i < 256) { mode = 1; b = (g & 3) >> 1; head = g & 1; qt = 2 + 64 * (g >> 2) + (i - 192); }
            else if (i < 258) { mode = 0; b = g >> 2; head = g & 3; qt = i - 256; }
            else if (i == 258) { mode = 2; b = (g & 3) >> 1; head = g & 1; qt = g >> 2; }
            else { mode = 1; b = (g & 3) >> 1; head = g & 1; qt = g >> 2; }
            if (mode == 0) { const AttnPtrs A{(const bf16_t*)(qkv + O_QA), (const bf16_t*)(qkv + O_KA), (const bf16_t*)(qkv + O_VAT), Y, subw, sink, lam, oml}; attn_unit<0>(lds, A, b, head, qt); }
            else if (mode == 1) { const AttnPtrs A{(const bf16_t*)(qkv + O_QC), (const bf16_t*)(qkv + O_KC), (const bf16_t*)(qkv + O_VCT), Y, subw, sink, lam, oml}; attn_unit<1>(lds, A, b, head, qt); }
            else { const AttnPtrs A{(const bf16_t*)(qkv + O_QD), (const bf16_t*)(qkv + O_KD), (const bf16_t*)(qkv + O_VDT), Y, subw, sink, lam, oml}; attn_unit<2>(lds, A, b, head, qt); }
        }
    }
}

#define XB_TMO      128
#define XB_XCNT(j)  (256  + 64 * (j))
#define XB_XSUB(j)  (1280 + 64 * (j))
#define XB_XGEN(j)  (2304 + 64 * (j))
#define XB_TOP      3328
#define XB_TOPGEN   3392
#define XCD_BAR_WORDS 3456
#define XB_SPIN_CAP (1u << 23)

__device__ __forceinline__ unsigned xb_ld(unsigned* p)              { return __hip_atomic_load(p, __ATOMIC_RELAXED, __HIP_MEMORY_SCOPE_AGENT); }
__device__ __forceinline__ unsigned xb_add(unsigned* p, unsigned v) { return __hip_atomic_fetch_add(p, v, __ATOMIC_RELAXED, __HIP_MEMORY_SCOPE_AGENT); }
__device__ __forceinline__ unsigned xb_xcc_id() { return (unsigned)__builtin_amdgcn_s_getreg((3 << 11) | 20) & 0xFu; }
#define XB_SPIN(cond, bar) do { unsigned _sp = 0; while (cond) { __builtin_amdgcn_s_sleep(1); \
    if ((++_sp & 255u) == 0u) { if (xb_ld(&(bar)[XB_TMO])) break; if (_sp > XB_SPIN_CAP) { atomicAdd(&(bar)[XB_TMO], 1u); break; } } } } while (0)

struct XcdBarrier {
    unsigned* bar; unsigned x;
    volatile LAS unsigned* st;
};

__device__ __forceinline__ XcdBarrier xcd_barrier_post(unsigned* bar, volatile LAS unsigned* st) {
    XcdBarrier b; b.bar = bar; b.x = xb_xcc_id(); b.st = st;
    if (threadIdx.x == 0) (void)xb_add(&bar[XB_XCNT(b.x)], 1u);
    return b;
}
__device__ __forceinline__ void xcd_barrier_complete(unsigned* bar, unsigned x, unsigned& nloc, unsigned& nx) {
    const unsigned G = gridDim.x * gridDim.y * gridDim.z;
    unsigned sum, cnt, mine, sp = 0u;
    for (;;) {
        sum = 0u; cnt = 0u; mine = 0u;
#pragma unroll
        for (unsigned j = 0; j < 16; ++j) { const unsigned c = xb_ld(&bar[XB_XCNT(j)]); sum += c; cnt += (c > 0u) ? 1u : 0u; mine = (j == x) ? c : mine; }
        if (sum == G) break;
        __builtin_amdgcn_s_sleep(1);
        if ((++sp & 255u) == 0u) { if (xb_ld(&bar[XB_TMO])) break; if (sp > XB_SPIN_CAP) { atomicAdd(&bar[XB_TMO], 1u); break; } }
    }
    nloc = mine > 0u ? mine : 1u; nx = cnt > 0u ? cnt : 1u;
}

__device__ __forceinline__ void xcd_barrier(const XcdBarrier& b) {
    asm volatile("s_waitcnt vmcnt(0)" ::: "memory");
    __syncthreads();
    if (threadIdx.x == 0) {
        unsigned* bar = b.bar;
        __builtin_amdgcn_s_waitcnt(0);
        unsigned nloc = b.st[0], nx = b.st[1];
        if (nloc == 0u) { xcd_barrier_complete(bar, b.x, nloc, nx); b.st[0] = nloc; b.st[1] = nx; }
        const unsigned old = xb_add(&bar[XB_XSUB(b.x)], 1u);
        const unsigned gen = old / nloc;
        if (old + 1u == (gen + 1u) * nloc) {
            __builtin_amdgcn_fence(__ATOMIC_RELEASE, "agent");
            asm volatile("s_waitcnt vmcnt(0)" ::: "memory");
            const unsigned og = xb_add(&bar[XB_TOP], 1u);
            const unsigned tg = og / nx;
            if (og + 1u == (tg + 1u) * nx) xb_add(&bar[XB_TOPGEN], 1u);
            else XB_SPIN(xb_ld(&bar[XB_TOPGEN]) == tg, bar);
            __builtin_amdgcn_fence(__ATOMIC_ACQUIRE, "agent");
            xb_add(&bar[XB_XGEN(b.x)], 1u);
            asm volatile("s_waitcnt vmcnt(0)" ::: "memory");
        } else {
            XB_SPIN(xb_ld(&bar[XB_XGEN(b.x)]) == gen, bar);
            __builtin_amdgcn_fence(__ATOMIC_ACQUIRE, "agent");
            asm volatile("s_waitcnt vmcnt(0)" ::: "memory");
        }
    }
    __syncthreads();
}

__global__ void __launch_bounds__(512, 2) mega_fwd(Params P) {
    extern __shared__ __attribute__((aligned(16))) unsigned char lds_raw[];
    LAS unsigned char* lds = (LAS unsigned char*)lds_raw;
    cg::grid_group grid = cg::this_grid();
    unsigned char* ws = P.ws;
    const float* mod = (const float*)(ws + WS_MOD);
    const int G = gridDim.x, bx = blockIdx.x;

    if (threadIdx.x == 0) { const unsigned r_ = atomicAdd((unsigned*)(ws + WS_XCNT) + xcc_id(), 1u); *(LAS unsigned*)(lds + LDS_RANK_OFF) = r_; }
    if (threadIdx.x == 0) { *(volatile LAS unsigned*)(lds + LDS_XB_OFF) = 0u; *(volatile LAS unsigned*)(lds + LDS_XB_OFF + 4) = 0u; }
    __syncthreads();
    (void)xcd_barrier_post((unsigned*)(ws + WS_XBAR), (volatile LAS unsigned*)(lds + LDS_XB_OFF));
#define GBAR() do { XcdBarrier xb_; xb_.bar = (unsigned*)(P.ws + WS_XBAR); xb_.x = xb_xcc_id(); xb_.st = (volatile LAS unsigned*)(lds + LDS_XB_OFF); xcd_barrier(xb_); } while (0)
    prologue(P, lds);
    grid.sync();
    row_pass<false>(P, TROWS, nullptr, nullptr, mod + 0 * 1024, mod + 1 * 1024, true, false);
    GBAR();
#pragma unroll 1
    for (int l = 0; l < 2; ++l) {
        GAS unsigned char* wsg_ = (GAS unsigned char*)ws; asm volatile("" : "+s"(wsg_)); unsigned char* wsl = (unsigned char*)wsg_;
        const float* modl = (const float*)(wsl + WS_MOD) + (size_t)l * 3 * NMODW;
        const unsigned char* wl = wsl + WS_W + (size_t)l * W_LAYER;
        float* xctx = (float*)(wsl + WS_XCTX); bf16_t* H = (bf16_t*)(wsl + WS_H); bf16_t* ACT = (bf16_t*)(wsl + WS_ACT); bf16_t* Z = (bf16_t*)(wsl + WS_Z); bf16_t* Y = (bf16_t*)(wsl + WS_Y);
        const int Mtail = (l == 1) ? NLAT : TROWS;
        const float* lng = P.in[6] + l * 3 * DM; const float* lnb = P.in[7] + l * 3 * DM;
#pragma unroll 1
        for (int f = 0; f < 2; ++f) {
            const int Mf = f == 0 ? TROWS : Mtail;
            { pg8::Gemm g{H, (const bf16_t*)(wl + (f == 0 ? W_GU1 : W_GU2)), Mf, 2 * DFF, DM}; pg8::StaticOrder S; S.init(Mf, 2 * DFF, G, bx);
              pg8::EpiSwiglu E{ACT, DFF};
              pg8::gemm_phase<pg8::EpiSwiglu, pg8::StaticOrder, true, true>(lds, g, S, E); }
            GBAR();
            { pg8::Gemm g{ACT, (const bf16_t*)(wl + (f == 0 ? W_DN1 : W_DN2)), Mf, DM, DFF}; pg8::StaticOrder S; S.init(Mf, DM, G, bx);
              const int pli = (f == 0) ? (l == 0 ? 0 : 2) : 1;
              const float* plg = (f == 0) ? P.in[6] + (l == 0 ? 0 : (l - 1) * 3 * DM) + pli * DM : lng + DM; const float* plb = (f == 0) ? P.in[7] + (l == 0 ? 0 : (l - 1) * 3 * DM) + pli * DM : lnb + DM;
              const bool first_ = (f == 0 && l == 0);
              pg8::EpiResid E{P.out, xctx, modl + (f == 0 ? 2 : 8) * 1024, 0.5f, first_ ? P.in[0] : (const float*)P.out, first_ ? P.in[2] : (const float*)xctx, (const float*)(wsl + WS_STATS), plg, plb, first_ ? 1 : 0};
              pg8::gemm_phase<pg8::EpiResid, pg8::StaticOrder, true, true>(lds, g, S, E); }
            GBAR();
            if (f == 0) {
                row_pass<true>(P, TROWS, lng, lnb, modl + 3 * 1024, modl + 4 * 1024, true, false);
                GBAR();
                { pg8::Gemm g{H, (const bf16_t*)(wl + W_IN), TROWS, INW, DM}; pg8::StaticOrder S; S.init(TROWS, INW, G, bx);
                  pg8::EpiBf16<0> E{Z, INW, nullptr, 0, 0, 1.f};
                  pg8::gemm_phase<pg8::EpiBf16<0>, pg8::StaticOrder, true, true>(lds, g, S, E); }
                GBAR();
                zpost_phase(P, lds, l);
                GBAR();
                attn_phase(P, lds, l);
                GBAR();
                { pg8::Gemm g{Y, (const bf16_t*)(wl + W_OUT), Mtail, DM, DM}; pg8::StaticOrder S; S.init(Mtail, DM, G, bx);
                  pg8::EpiResid E{P.out, xctx, modl + 5 * 1024, 1.0f, (const float*)P.out, (const float*)xctx, (const float*)(wsl + WS_STATS), lng, lnb, 0};
                  pg8::gemm_phase<pg8::EpiResid, pg8::StaticOrder, true, true>(lds, g, S, E); }
                GBAR();
                row_pass<true>(P, Mtail, lng + DM, lnb + DM, modl + 6 * 1024, modl + 7 * 1024, true, false);
                GBAR();
            } else {
                const bool last = (l == 1);
                row_pass<true>(P, Mtail, lng + 2 * DM, lnb + 2 * DM, modl + 3 * NMODW + 0 * 1024, modl + 3 * NMODW + 1 * 1024, !last, last);
                if (!last) GBAR();
            }
        }
    }
}

extern "C" void kernel_launch(void* const* d_in, const int* in_sizes, int n_in, void* d_out, int out_size, void* d_ws, size_t ws_size, hipStream_t stream) {
    static int grid = 0;
    if (grid == 0) {
        if (n_in != 23 || out_size != NLAT * DM || ws_size < WS_END) { fprintf(stderr, "kernel_launch: unexpected shapes (n_in %d out %d ws %zu, need %zu)\n", n_in, out_size, ws_size, (size_t)WS_END); grid = -1; return; }
        int dev = 0, cus = 0, per_cu = 0;
        if (hipGetDevice(&dev) != hipSuccess || hipDeviceGetAttribute(&cus, hipDeviceAttributeMultiprocessorCount, dev) != hipSuccess) { grid = -1; return; }
        if (hipFuncSetAttribute((const void*)mega_fwd, hipFuncAttributeMaxDynamicSharedMemorySize, LDS_BYTES) != hipSuccess) { fprintf(stderr, "kernel_launch: hipFuncSetAttribute failed\n"); grid = -1; return; }
        if (hipOccupancyMaxActiveBlocksPerMultiprocessor(&per_cu, (const void*)mega_fwd, 512, LDS_BYTES) != hipSuccess || per_cu < 1) { fprintf(stderr, "kernel_launch: occupancy query says %d\n", per_cu); per_cu = 1; }
        (void)hipGetLastError();
        grid = cus * per_cu;
    }
    if (grid < 0) return;
    Params p{};
    for (int i = 0; i < 23; ++i) p.in[i] = (const float*)d_in[i];
    p.out = (float*)d_out; p.ws = (unsigned char*)d_ws;
    (void)hipMemsetAsync((unsigned char*)d_ws + WS_XCNT, 0, 64 * 1024, stream);
    void* args[] = {&p};
    hipError_t e = hipLaunchCooperativeKernel((const void*)mega_fwd, dim3(grid), dim3(512), args, LDS_BYTES, stream);
    if (e != hipSuccess) fprintf(stderr, "kernel_launch: cooperative launch failed: %s (grid %d)\n", hipGetErrorString(e), grid);
}
```

```cpp
#include <hip/hip_runtime.h>
#include <hip/hip_cooperative_groups.h>
#include <cstdio>
#include <cstdint>
namespace cg = cooperative_groups;
namespace pg8 {
#define PG8_LAS __attribute__((address_space(3)))
typedef unsigned short bf16_t;
typedef short bf16x8 __attribute__((ext_vector_type(8)));
typedef float f32x4 __attribute__((ext_vector_type(4)));
typedef unsigned u32x4 __attribute__((ext_vector_type(4)));
constexpr int BM = 256, BK = 64, HALF = 128, HTB = HALF * BK * 2  , STAGE_BYTES = 8 * HTB, NXCD = 8, WGM = 8;

__host__ __device__ __forceinline__ int lds_byte(int r, int c) { const int st = (r >> 4) * 2 + (c >> 5), rr = r & 15, cc = c & 31, ob = rr * 64 + cc * 2; return st * 1024 + (ob ^ (((ob >> 9) & 1) << 5)); }
__host__ __device__ __forceinline__ void stage_rc(int b, int& R, int& C) { const int st = b / 1024, sb = b % 1024, swz = sb ^ (((sb >> 9) & 1) << 5); R = (st >> 1) * 16 + swz / 64; C = (st & 1) * 32 + (swz % 64) / 2; }
__host__ __device__ __forceinline__ int perm32(int rho) { const int n = rho >> 4, i = rho & 15; return 8 * (i >> 2) + 4 * n + (i & 3); }

struct Unit { int pm, pn; };
struct Gemm { const bf16_t* A; const bf16_t* Bt; int M, N, K; };

struct StaticOrder {
    int nM, nN, nwg, G, c;
    __host__ __device__ void init(int M, int N, int G_, int c_) { nM = M / BM; nN = N / BM; nwg = nM * nN; G = G_; c = c_; }
    __host__ __device__ bool next(int i, Unit& u) const {
        const long L = (long)i * G + c; if (L >= nwg) return false;
        int wgid = (int)L; { const int q = nwg / NXCD, r = nwg % NXCD, xcd = wgid % NXCD, off = wgid / NXCD; wgid = (xcd < r ? xcd * (q + 1) : r * (q + 1) + (xcd - r) * q) + off; }
        const int nig = WGM * nN, gid = wgid / nig, fm = gid * WGM, gsz = (nM - fm) < WGM ? (nM - fm) : WGM;
        u.pm = fm + ((wgid % nig) % gsz); u.pn = (wgid % nig) / gsz; return true;
    }
    __device__ __forceinline__ void a_ready(const Unit&) const {}
    __device__ __forceinline__ void done(const Unit&) const {}
};

__device__ __forceinline__ unsigned cvt_pk_bf16(float lo, float hi) { unsigned r; asm volatile("v_cvt_pk_bf16_f32 %0, %1, %2" : "=v"(r) : "v"(lo), "v"(hi)); return r; }
typedef float f32x2 __attribute__((ext_vector_type(2)));
__device__ __forceinline__ f32x2 gelu_pk(f32x2 v) {
    const f32x2 av = __builtin_elementwise_abs(v), d = av * 0.2316418882f + 1.0f;
    f32x2 t; t.x = __builtin_amdgcn_rcpf(d.x); t.y = __builtin_amdgcn_rcpf(d.y);
    f32x2 q = t * 0.5307027145f + (-0.7265760135f); q = q * t + 0.7107068705f; q = q * t + (-0.142248368f); q = q * t + 0.127414796f; q = q * t;
    const f32x2 s = (v * v) * (-0.72134752044f);
    f32x2 e; e.x = __builtin_amdgcn_exp2f(s.x); e.y = __builtin_amdgcn_exp2f(s.y);
    const f32x2 m = v * (q * e), r = v - m;
    f32x2 o; o.x = v.x < 0.f ? m.x : r.x; o.y = v.y < 0.f ? m.y : r.y; return o;
}

template <int ACT  > struct EpiBf16 {
    static constexpr bool PERM = true, AFTER_DRAIN = false; static_assert(ACT == 0 || ACT == 1, "EpiBf16: ACT is 0 (none) or 1 (gelu_pk)");
    bf16_t* O; int ldc; const float* bias; int split_cols; size_t split_stride; float scale0;
    __device__ __forceinline__ void operator()(const f32x4 (&acc)[2][2][4][2], const Unit& u, int wr, int wc, int fr, int fq) const {
        const int row0 = u.pm * BM + wr * 64 + fr; int colt = u.pn * BM; bf16_t* base = O;
        float sc = 1.f; if (split_cols) { const int t = colt / split_cols; base += (size_t)t * split_stride; colt -= t * split_cols; if (t == 0) sc = scale0; }
        const int col0 = colt + wc * 32 + 8 * fq, bcol0 = u.pn * BM + wc * 32 + 8 * fq;
        f32x4 bv[2][2];
#pragma unroll
        for (int bj = 0; bj < 2; ++bj)
#pragma unroll
            for (int n = 0; n < 2; ++n) bv[bj][n] = bias ? *(const f32x4*)(bias + bcol0 + bj * HALF + 4 * n) : (f32x4){0.f, 0.f, 0.f, 0.f};
#pragma unroll
        for (int ai = 0; ai < 2; ++ai)
#pragma unroll
            for (int m = 0; m < 4; ++m) { bf16_t* rowp = base + (size_t)(row0 + ai * HALF + m * 16) * ldc + col0;
#pragma unroll
                for (int bj = 0; bj < 2; ++bj) { f32x4 v0 = acc[ai][bj][m][0] + bv[bj][0], v1 = acc[ai][bj][m][1] + bv[bj][1];
                    if (ACT == 1) { f32x2 a = gelu_pk((f32x2){v0[0], v0[1]}), b = gelu_pk((f32x2){v0[2], v0[3]}), c = gelu_pk((f32x2){v1[0], v1[1]}), d = gelu_pk((f32x2){v1[2], v1[3]});
                        v0 = (f32x4){a.x, a.y, b.x, b.y}; v1 = (f32x4){c.x, c.y, d.x, d.y}; }
                    v0 = v0 * sc; v1 = v1 * sc; u32x4 w; w.x = cvt_pk_bf16(v0[0], v0[1]); w.y = cvt_pk_bf16(v0[2], v0[3]); w.z = cvt_pk_bf16(v1[0], v1[1]); w.w = cvt_pk_bf16(v1[2], v1[3]);
                    *(u32x4*)(rowp + bj * HALF) = w; } }
    }
};
struct EpiSwiglu {
    static constexpr bool PERM = true, AFTER_DRAIN = false;
    bf16_t* O; int ldc;
    __device__ __forceinline__ void operator()(const f32x4 (&acc)[2][2][4][2], const Unit& u, int wr, int wc, int fr, int fq) const {
        const int row0 = u.pm * BM + wr * 64 + fr; const int col0 = u.pn * HALF + wc * 32 + 8 * fq;
#pragma unroll
        for (int ai = 0; ai < 2; ++ai)
#pragma unroll
            for (int m = 0; m < 4; ++m) { bf16_t* rowp = O + (size_t)(row0 + ai * HALF + m * 16) * ldc + col0;
                float r[8];
#pragma unroll
                for (int n = 0; n < 2; ++n)
#pragma unroll
                    for (int e = 0; e < 4; ++e) { const float g = acc[ai][0][m][n][e], uu = acc[ai][1][m][n][e];
                        const float sg = __builtin_amdgcn_rcpf(1.0f + __builtin_amdgcn_exp2f(-1.4426950408889634f * g)); r[n * 4 + e] = g * sg * uu; }
                u32x4 w; w.x = cvt_pk_bf16(r[0], r[1]); w.y = cvt_pk_bf16(r[2], r[3]); w.z = cvt_pk_bf16(r[4], r[5]); w.w = cvt_pk_bf16(r[6], r[7]);
                *(u32x4*)rowp = w; }
    }
};
struct EpiResid {
    static constexpr bool PERM = true, AFTER_DRAIN = false;
    float* Xlat; float* Xctx; const float* gate; float coef;
    const float* Slat; const float* Sctx;
    const float* stats; const float* lg; const float* lb; int ident;
    __device__ __forceinline__ void operator()(const f32x4 (&acc)[2][2][4][2], const Unit& u, int wr, int wc, int fr, int fq) const {
        const int rowt = u.pm * BM; float* base; int set;
        const float* sbase;
        if (rowt < 32768) { base = Xlat + (size_t)rowt * 1024; sbase = Slat + (size_t)rowt * 1024; set = rowt >> 14; } else { base = Xctx + (size_t)(rowt - 32768) * 1024; sbase = Sctx + (size_t)(rowt - 32768) * 1024; set = 2; }
        const int col0 = u.pn * BM + wc * 32 + 8 * fq; const float* gp = gate + set * 9216 + col0;
        float mean[2][4], rstd[2][4];
#pragma unroll
        for (int ai = 0; ai < 2; ++ai)
#pragma unroll
            for (int m = 0; m < 4; ++m) { mean[ai][m] = 0.f; rstd[ai][m] = 1.f;
                if (!ident) { const f32x2 st = *(const f32x2*)(stats + 2 * (size_t)(rowt + wr * 64 + fr + ai * HALF + m * 16)); mean[ai][m] = st[0]; rstd[ai][m] = st[1]; } }
#pragma unroll
        for (int bj = 0; bj < 2; ++bj)
#pragma unroll
            for (int n = 0; n < 2; ++n) { const f32x4 gvv = *(const f32x4*)(gp + bj * HALF + 4 * n) * coef; f32x4 g4v, b4v;
                if (ident) { g4v = (f32x4){1.41421356237f, 1.41421356237f, 1.41421356237f, 1.41421356237f}; b4v = (f32x4){0.f, 0.f, 0.f, 0.f}; }
                else { g4v = *(const f32x4*)(lg + col0 + bj * HALF + 4 * n) * 1.41421356237f; b4v = *(const f32x4*)(lb + col0 + bj * HALF + 4 * n) * 1.41421356237f; }
#pragma unroll
                for (int ai = 0; ai < 2; ++ai)
#pragma unroll
                    for (int m = 0; m < 4; ++m) { const size_t eo_ = (size_t)(wr * 64 + fr + ai * HALF + m * 16) * 1024 + col0 + bj * HALF + 4 * n; f32x4* p = (f32x4*)(base + eo_); const f32x4 x = *(const f32x4*)(sbase + eo_);
                        *p = ((x - mean[ai][m]) * rstd[ai][m]) * g4v + b4v + gvv * acc[ai][bj][m][n]; } }
    }
};
template <class Epi, class Sched, bool ALIGN_EPI = false, bool SP2 = false>
__device__ __forceinline__ void gemm_phase(PG8_LAS unsigned char* lds, const Gemm g, const Sched& S, const Epi& E) {
    int tid_ = threadIdx.x; asm volatile("" : "+v"(tid_)); const int tid = tid_, wid = __builtin_amdgcn_readfirstlane(tid >> 6), lane = tid & 63, wr = wid >> 2, wc = wid & 3, fr = lane & 15, fq = lane >> 4;
    const int K = g.K, nt = K / BK;
    unsigned voffA[2], voffB[2];
#pragma unroll
    for (int i = 0; i < 2; ++i) { int R, C; stage_rc(tid * 16 + i * 8192, R, C); const int Rb = Epi::PERM ? ((R & ~31) + perm32(R & 31)) : R;
        voffA[i] = (unsigned)(R * K + C) * 2u; voffB[i] = (unsigned)(Rb * K + C) * 2u; }
    const size_t kstep = (size_t)(BK * 2);
    const size_t hstep = (size_t)HALF * K * 2;
    const size_t tstep = 2 * hstep;
    const unsigned ldsw = (unsigned)wid * 1024u;
    const int aoff = lds_byte(wr * 64 + fr, fq * 8), boff = lds_byte(wc * 32 + fr, fq * 8);
#define PG8_SA(b, h) (((b) * 2 + (h)) * HTB)
#define PG8_SB(b, h) ((4 + (b) * 2 + (h)) * HTB)
#define PG8_STAGE(bufoff, gbase, voff) do { _Pragma("unroll") for (int _i = 0; _i < 2; ++_i) \
        __builtin_amdgcn_global_load_lds((const unsigned*)((const char*)(gbase) + (voff)[_i]), (PG8_LAS unsigned*)(lds + (bufoff) + ldsw + _i * 8192), 16, 0, 0); } while (0)
#define PG8_LDA(dst, b, h) do { _Pragma("unroll") for (int m = 0; m < 4; ++m) _Pragma("unroll") for (int k = 0; k < 2; ++k) dst[m][k] = *(const PG8_LAS bf16x8*)(lds + PG8_SA(b, h) + aoff + m * 2048 + k * 1024); } while (0)
#define PG8_LDB(dst, b, h) do { _Pragma("unroll") for (int n = 0; n < 2; ++n) _Pragma("unroll") for (int k = 0; k < 2; ++k) dst[n][k] = *(const PG8_LAS bf16x8*)(lds + PG8_SB(b, h) + boff + n * 2048 + k * 1024); } while (0)
#define PG8_MMA(ai, bj, At, Bt) do { __builtin_amdgcn_s_setprio(1); _Pragma("unroll") for (int m = 0; m < 4; ++m) _Pragma("unroll") for (int n = 0; n < 2; ++n) _Pragma("unroll") for (int k = 0; k < 2; ++k) \
        acc[ai][bj][m][n] = __builtin_amdgcn_mfma_f32_16x16x32_bf16(Bt[n][k], At[m][k], acc[ai][bj][m][n], 0, 0, 0); __builtin_amdgcn_s_setprio(0); } while (0)
#define PG8_WAIT_V(n) asm volatile("s_waitcnt vmcnt(" #n ")" ::: "memory")
#define PG8_WAIT_L(n) asm volatile("s_waitcnt lgkmcnt(" #n ")" ::: "memory")
#define PG8_BAR __builtin_amdgcn_s_barrier()
#define PG8_SCHED __builtin_amdgcn_sched_barrier(0)
    Unit cur, nxt; int ui = 0;
    if (!S.next(0, cur)) return;
    f32x4 acc[2][2][4][2];
#pragma unroll
    for (int a = 0; a < 2; ++a)
#pragma unroll
        for (int b = 0; b < 2; ++b)
#pragma unroll
            for (int m = 0; m < 4; ++m)
#pragma unroll
                for (int n = 0; n < 2; ++n) acc[a][b][m][n] = (f32x4){0.f, 0.f, 0.f, 0.f};
    bf16x8 At[4][2], B0[2][2], B1[2][2];
    const char* cA = (const char*)g.A + (size_t)cur.pm * tstep; const char* cB = (const char*)g.Bt + (size_t)cur.pn * tstep;
    S.a_ready(cur);
    if constexpr (SP2) {
        PG8_STAGE(PG8_SB(0, 0), cB, voffB); PG8_STAGE(PG8_SB(0, 1), cB + hstep, voffB); PG8_STAGE(PG8_SA(0, 0), cA, voffA); PG8_STAGE(PG8_SA(0, 1), cA + hstep, voffA);
        if (wr == 1) PG8_BAR;
        PG8_WAIT_V(2); PG8_BAR;
        PG8_STAGE(PG8_SB(1, 0), cB + kstep, voffB); PG8_STAGE(PG8_SA(1, 0), cA + kstep, voffA); PG8_STAGE(PG8_SB(1, 1), cB + hstep + kstep, voffB);
        PG8_WAIT_V(6); PG8_BAR;
    } else {
        PG8_STAGE(PG8_SB(0, 0), cB, voffB); PG8_STAGE(PG8_SA(0, 0), cA, voffA); PG8_STAGE(PG8_SB(0, 1), cB + hstep, voffB); PG8_STAGE(PG8_SA(0, 1), cA + hstep, voffA);
        if (wr == 1) PG8_BAR;
        PG8_WAIT_V(4); PG8_BAR;
        PG8_STAGE(PG8_SB(1, 0), cB + kstep, voffB); PG8_STAGE(PG8_SA(1, 0), cA + kstep, voffA); PG8_STAGE(PG8_SB(1, 1), cB + hstep + kstep, voffB);
        PG8_WAIT_V(6); PG8_BAR;
    }
    for (;;) {
        const bool has_next = S.next(ui + 1, nxt);
        const char* nA = has_next ? (const char*)g.A + (size_t)nxt.pm * tstep : cA; const char* nB = has_next ? (const char*)g.Bt + (size_t)nxt.pn * tstep : cB;
        for (int t = 0; t < nt; t += 2) {
            const bool last = (t == nt - 2);
            const char* a1 = cA + (size_t)(t + 1) * kstep;
            const char* a2 = last ? nA : cA + (size_t)(t + 2) * kstep; const char* b2 = last ? nB : cB + (size_t)(t + 2) * kstep;
            const char* a3 = a2 + kstep; const char* b3 = b2 + kstep;
            if (last && has_next) S.a_ready(nxt);
            if constexpr (SP2) {
            PG8_LDB(B0, 0, 0); PG8_LDB(B1, 0, 1); PG8_SCHED; PG8_LDA(At, 0, 0); PG8_STAGE(PG8_SA(1, 1), a1 + hstep, voffA);
            PG8_WAIT_V(8); PG8_WAIT_L(0); PG8_BAR; PG8_MMA(0, 0, At, B0); PG8_MMA(0, 1, At, B1); PG8_BAR; PG8_SCHED;
            PG8_LDA(At, 0, 1); PG8_STAGE(PG8_SB(0, 0), b2, voffB); PG8_STAGE(PG8_SB(0, 1), b2 + hstep, voffB); PG8_STAGE(PG8_SA(0, 0), a2, voffA);
            PG8_WAIT_V(8); PG8_WAIT_L(0); PG8_BAR; PG8_MMA(1, 0, At, B0); PG8_MMA(1, 1, At, B1); PG8_BAR; PG8_SCHED;
            PG8_LDB(B0, 1, 0); PG8_LDB(B1, 1, 1); PG8_SCHED; PG8_LDA(At, 1, 0); PG8_STAGE(PG8_SA(0, 1), a2 + hstep, voffA);
            PG8_WAIT_V(8); PG8_WAIT_L(0); PG8_BAR; PG8_MMA(0, 0, At, B0); PG8_MMA(0, 1, At, B1); PG8_BAR; PG8_SCHED;
            PG8_LDA(At, 1, 1); PG8_STAGE(PG8_SB(1, 0), b3, voffB); PG8_STAGE(PG8_SB(1, 1), b3 + hstep, voffB); PG8_STAGE(PG8_SA(1, 0), a3, voffA);
            PG8_WAIT_V(8); PG8_WAIT_L(0); PG8_BAR; PG8_MMA(1, 0, At, B0); PG8_MMA(1, 1, At, B1); PG8_BAR; PG8_SCHED;
            } else {
            PG8_LDB(B0, 0, 0); PG8_SCHED; PG8_LDA(At, 0, 0); PG8_STAGE(PG8_SA(1, 1), a1 + hstep, voffA);
            PG8_WAIT_L(8); PG8_BAR; PG8_WAIT_L(0); PG8_MMA(0, 0, At, B0); PG8_BAR; PG8_SCHED;
            PG8_LDB(B1, 0, 1); PG8_STAGE(PG8_SB(0, 0), b2, voffB);
            PG8_BAR; PG8_WAIT_L(0); PG8_MMA(0, 1, At, B1); PG8_BAR;
            PG8_LDA(At, 0, 1); PG8_STAGE(PG8_SA(0, 0), a2, voffA);
            PG8_BAR; PG8_WAIT_L(0); PG8_MMA(1, 0, At, B0); PG8_BAR; PG8_SCHED;
            PG8_STAGE(PG8_SB(0, 1), b2 + hstep, voffB);
            PG8_WAIT_V(6); PG8_BAR; PG8_MMA(1, 1, At, B1); PG8_BAR;
            PG8_LDB(B0, 1, 0); PG8_SCHED; PG8_LDA(At, 1, 0); PG8_STAGE(PG8_SA(0, 1), a2 + hstep, voffA);
            PG8_WAIT_L(8); PG8_BAR; PG8_WAIT_L(0); PG8_MMA(0, 0, At, B0); PG8_BAR; PG8_SCHED;
            PG8_LDB(B1, 1, 1); PG8_STAGE(PG8_SB(1, 0), b3, voffB);
            PG8_BAR; PG8_WAIT_L(0); PG8_MMA(0, 1, At, B1); PG8_BAR;
            PG8_LDA(At, 1, 1); PG8_STAGE(PG8_SA(1, 0), a3, voffA);
            PG8_BAR; PG8_WAIT_L(0); PG8_MMA(1, 0, At, B0); PG8_BAR; PG8_SCHED;
            PG8_STAGE(PG8_SB(1, 1), b3 + hstep, voffB);
            PG8_WAIT_V(6); PG8_BAR; PG8_MMA(1, 1, At, B1); PG8_BAR;
            }
        }
        if constexpr (ALIGN_EPI) { if (wr == 0) PG8_BAR; }
        if constexpr (!Epi::AFTER_DRAIN) { E(acc, cur, wr, wc, fr, fq); S.done(cur); }
        if (!has_next) break;
#pragma unroll
        for (int a = 0; a < 2; ++a)
#pragma unroll
            for (int b = 0; b < 2; ++b)
#pragma unroll
                for (int m = 0; m < 4; ++m)
#pragma unroll
                    for (int n = 0; n < 2; ++n) acc[a][b][m][n] = (f32x4){0.f, 0.f, 0.f, 0.f};
        cur = nxt; cA = nA; cB = nB; ++ui;
        if constexpr (ALIGN_EPI) { if (wr == 1) PG8_BAR; }
    }
    PG8_WAIT_V(0);
    if constexpr (!ALIGN_EPI) { if (wr == 0) PG8_BAR; }
    PG8_BAR;
    if constexpr (Epi::AFTER_DRAIN) { E.fused(acc, cur, wr, wc, fr, fq, lds, wid, lane); S.done(cur); }
#undef PG8_SA
#undef PG8_SB
#undef PG8_STAGE
#undef PG8_LDA
#undef PG8_LDB
#undef PG8_MMA
#undef PG8_WAIT_V
#undef PG8_WAIT_L
#undef PG8_BAR
#undef PG8_SCHED
}
}

#define LAS __attribute__((address_space(3)))
#define GAS __attribute__((address_space(1)))
typedef unsigned short bf16_t;
typedef short bf16x8 __attribute__((ext_vector_type(8)));
typedef float f32x4 __attribute__((ext_vector_type(4)));
typedef float f32x16 __attribute__((ext_vector_type(16)));
typedef float f32x2 __attribute__((ext_vector_type(2)));
typedef unsigned u32x4 __attribute__((ext_vector_type(4)));
typedef unsigned u32x2 __attribute__((ext_vector_type(2)));
constexpr int DM = 1024, SEQ = 16384, CTXL = 256, NLAT = 32768, TROWS = 33280, NK = SEQ + CTXL, DFF = 2816, INW = 2560, NMODW = 9216;
constexpr size_t MiB = (size_t)1 << 20;
constexpr size_t WS_MOD = 0, WS_LAM = 512 * 1024, WS_STATS = 3 * 512 * 1024 + 1024 * 1024 * 0, WS_XCNT = 768 * 1024, WS_XBAR = 800 * 1024, WS_ROPE = 1 * MiB, WS_XCTX = 2 * MiB, WS_W = 4 * MiB, WS_H = 84 * MiB, WS_BIG = 149 * MiB;
constexpr size_t W_GU1 = 0, W_DN1 = 11534336, W_IN = 17301504, W_OUT = 22544384, W_GU2 = 24641536, W_DN2 = 36175872, W_LAYER = 41943040;
constexpr size_t QU = 8519680;
constexpr size_t WS_ACT = WS_BIG, WS_Z = WS_BIG, WS_Y = WS_BIG + 163 * MiB, WS_QKV = WS_BIG + 228 * MiB;
constexpr size_t O_QA = 0, O_KA = 2 * QU, O_VAT = 4 * QU, O_QC = 6 * QU, O_KC = 8 * QU, O_VCT = 9 * QU, O_QD = 10 * QU, O_KD = 12 * QU, O_VDT = 13 * QU;
constexpr size_t WS_END = WS_QKV + 14 * QU;
constexpr int LDS_BYTES = 147456, LDS_RANK_OFF = 147440, LDS_XB_OFF = 147444;
constexpr float LOG2E = 1.4426950408889634f;
constexpr float QSCALE_A = 0.17677669529663687f * LOG2E;
constexpr float QSCALE_H = 0.125f * LOG2E;

struct Params { const float* in[23]; float* out; unsigned char* ws; };

__device__ __forceinline__ float bf2f(unsigned v) { return __uint_as_float(v << 16); }
typedef float f32x2_t __attribute__((ext_vector_type(2))); typedef __bf16 bf16x2_t __attribute__((ext_vector_type(2)));
__device__ __forceinline__ unsigned cvtpk(float lo, float hi) { f32x2_t v = {lo, hi}; bf16x2_t b = __builtin_convertvector(v, bf16x2_t); return __builtin_bit_cast(unsigned, b); }
__device__ __forceinline__ float wave_sum(float v) {
#pragma unroll
    for (int o = 1; o < 64; o <<= 1) v += __shfl_xor(v, o);
    return v;
}
__device__ __forceinline__ float xhalf_max(float v) { auto rr = __builtin_amdgcn_permlane32_swap(__float_as_uint(v), __float_as_uint(v), false, false); return fmaxf(__uint_as_float(rr[0]), __uint_as_float(rr[1])); }
__device__ __forceinline__ float xhalf_sum(float v) { auto rr = __builtin_amdgcn_permlane32_swap(__float_as_uint(v), __float_as_uint(v), false, false); return __uint_as_float(rr[0]) + __uint_as_float(rr[1]); }
__device__ __forceinline__ int crow(int r, int hi) { return (r & 3) + 8 * (r >> 2) + 4 * hi; }

__device__ __forceinline__ void transpose_item(const float* W, int K, int N, bf16_t* WT, bool gu, LAS float* scr, int item, int lane) {
    const int nblk = N / 32, kb = item / nblk, nb = item % nblk, k0 = 64 * kb, n0 = 32 * nb;
    int rbase = n0;
    if (gu) { const int half = n0 >= DFF ? 1 : 0, j0 = n0 - half * DFF; rbase = (j0 >> 7) * 256 + half * 128 + (j0 & 127); }
#pragma unroll 8
    for (int i = 0; i < 32; ++i) { const int kk = 2 * i + (lane >> 5); scr[kk * 33 + (lane & 31)] = W[(size_t)(k0 + kk) * N + n0 + (lane & 31)]; }
    asm volatile("s_waitcnt lgkmcnt(0)" ::: "memory");
    const int c = lane & 7;
#pragma unroll
    for (int j = 0; j < 4; ++j) { const int n = (lane >> 3) + 8 * j; const LAS float* s = scr + (8 * c) * 33 + n;
        u32x4 o; o.x = cvtpk(s[0 * 33], s[1 * 33]); o.y = cvtpk(s[2 * 33], s[3 * 33]); o.z = cvtpk(s[4 * 33], s[5 * 33]); o.w = cvtpk(s[6 * 33], s[7 * 33]);
        *(u32x4*)(WT + (size_t)(rbase + n) * K + k0 + 8 * c) = o; }
    asm volatile("s_waitcnt lgkmcnt(0)" ::: "memory");
}
__device__ __forceinline__ void dsincos(double a, float& c, float& s) {
    const double TWO_PI = 6.283185307179586476925286766559;
    const double k = __builtin_rint(a / TWO_PI); double r = a - k * TWO_PI;
    const double r2 = r * r; double tc = 1.0, ts = r, sc = 1.0, ss = r;
#pragma unroll 1
    for (int i = 1; i <= 16; ++i) { tc = -tc * r2 / (double)((2 * i - 1) * (2 * i)); ts = -ts * r2 / (double)((2 * i) * (2 * i + 1)); sc += tc; ss += ts; }
    c = (float)sc; s = (float)ss;
}
__device__ __forceinline__ void prologue(const Params& P, LAS unsigned char* lds) {
    int tid_ = threadIdx.x; asm volatile("" : "+v"(tid_)); const int tid = tid_, lane = tid & 63, wave = __builtin_amdgcn_readfirstlane(tid >> 6);
    GAS unsigned char* wsg_ = (GAS unsigned char*)P.ws; asm volatile("" : "+s"(wsg_)); unsigned char* ws = (unsigned char*)wsg_;
    LAS float* sv = (LAS float*)(lds + 69632); LAS float* red = sv + 3072;
    for (int k = tid; k < 3072; k += 512) { const int s = k >> 10, kk = k & 1023; const float c = s < 2 ? P.in[1][s * 1024 + kk] : P.in[3][kk]; sv[k] = c / (1.0f + __expf(-c)); }
    __syncthreads();
    float* mod = (float*)(ws + WS_MOD);
    for (int it = blockIdx.x; it < 288; it += gridDim.x) {
        const int l = it / 144, n0 = (it % 144) * 64;
        const float* w = P.in[4] + (size_t)l * 1024 * NMODW + (size_t)(wave * 128) * NMODW + n0 + lane;
        float a0 = 0.f, a1 = 0.f, a2 = 0.f;
#pragma unroll 8
        for (int k = 0; k < 128; ++k) { const float wv = w[(size_t)k * NMODW]; const int kk = wave * 128 + k; a0 += sv[kk] * wv; a1 += sv[1024 + kk] * wv; a2 += sv[2048 + kk] * wv; }
        red[(wave * 3 + 0) * 64 + lane] = a0; red[(wave * 3 + 1) * 64 + lane] = a1; red[(wave * 3 + 2) * 64 + lane] = a2;
        __syncthreads();
        if (tid < 192) { const int s = tid >> 6, ln = tid & 63; float t = 0.f;
#pragma unroll
            for (int w8 = 0; w8 < 8; ++w8) t += red[(w8 * 3 + s) * 64 + ln];
            mod[(size_t)(l * 3 + s) * NMODW + n0 + ln] = t + P.in[5][l * NMODW + n0 + ln]; }
        __syncthreads();
    }
    { const int gt = blockIdx.x * 512 + tid; float* rope = (float*)(ws + WS_ROPE);
      if (gt < 6144) { const int pos = gt / 24, f = gt % 24; double inv;
          if (f < 8) { inv = 1.0; for (int i = 0; i < (f >> 1); ++i) inv *= 0.1; if (f & 1) inv *= 0.31622776601683794; }
          else { const int i4 = f - 8; inv = 1.0; for (int i = 0; i < (i4 >> 2); ++i) inv *= 0.1; const int rm = i4 & 3; inv *= (rm == 0 ? 1.0 : rm == 1 ? 0.5623413251903491 : rm == 2 ? 0.31622776601683794 : 0.1778279410038923); }
          const float invf = (float)inv; const float ang = (float)pos * invf; float c, s; dsincos((double)ang, c, s);
          if (f < 8) { rope[pos * 8 + f] = c; rope[2048 + pos * 8 + f] = s; } else { rope[4096 + pos * 16 + (f - 8)] = c; rope[8192 + pos * 16 + (f - 8)] = s; } }
      if (gt == 6144 || gt == 6145) { const int l = gt - 6144; float s1 = 0.f, s2 = 0.f;
          for (int i = 0; i < 32; ++i) { s1 += P.in[13][l * 32 + i] * P.in[14][l * 32 + i]; s2 += P.in[15][l * 32 + i] * P.in[16][l * 32 + i]; }
          const float li = l == 0 ? 0.2f : 0.35550906759097f; ((float*)(ws + WS_LAM))[l] = expf(s1) - expf(s2) + li; } }
    { LAS float* scr = (LAS float*)(lds + wave * 8448);
      const int gw = blockIdx.x * 8 + wave, NGW = gridDim.x * 8;
      constexpr int I_GU = 16 * 176, I_DN = 44 * 32, I_IN = 16 * 80, I_OUT = 16 * 32, I_LAYER = 2 * I_GU + 2 * I_DN + I_IN + I_OUT;
      for (int it = gw; it < 2 * I_LAYER; it += NGW) {
          const int l = it / I_LAYER; int r = it % I_LAYER; unsigned char* wl = ws + WS_W + (size_t)l * W_LAYER;
          if (r < I_GU) { transpose_item(P.in[8] + (size_t)l * DM * 2 * DFF, DM, 2 * DFF, (bf16_t*)(wl + W_GU1), true, scr, r, lane); continue; } r -= I_GU;
          if (r < I_GU) { transpose_item(P.in[21] + (size_t)l * DM * 2 * DFF, DM, 2 * DFF, (bf16_t*)(wl + W_GU2), true, scr, r, lane); continue; } r -= I_GU;
          if (r < I_DN) { transpose_item(P.in[9] + (size_t)l * DFF * DM, DFF, DM, (bf16_t*)(wl + W_DN1), false, scr, r, lane); continue; } r -= I_DN;
          if (r < I_DN) { transpose_item(P.in[22] + (size_t)l * DFF * DM, DFF, DM, (bf16_t*)(wl + W_DN2), false, scr, r, lane); continue; } r -= I_DN;
          if (r < I_IN) { transpose_item(P.in[10] + (size_t)l * DM * INW, DM, INW, (bf16_t*)(wl + W_IN), false, scr, r, lane); continue; } r -= I_IN;
          transpose_item(P.in[11] + (size_t)l * DM * DM, DM, DM, (bf16_t*)(wl + W_OUT), false, scr, r, lane);
      } }
}

template <bool LN>
__device__ __forceinline__ void row_pass(const Params& P, int nrows, const float* gam, const float* bet, const float* shift0, const float* scale0, bool write_h, bool write_x) {
    int tid_ = threadIdx.x; asm volatile("" : "+v"(tid_)); const int tid = tid_, lane = tid & 63, wave = __builtin_amdgcn_readfirstlane(tid >> 6);
    const int gw = blockIdx.x * 8 + wave, NGW = gridDim.x * 8;
    GAS unsigned char* wsg_ = (GAS unsigned char*)P.ws; asm volatile("" : "+s"(wsg_)); unsigned char* ws = (unsigned char*)wsg_;
    float* xctx = (float*)(ws + WS_XCTX); bf16_t* H = (bf16_t*)(ws + WS_H); float* stats = (float*)(ws + WS_STATS);
    f32x4 sh[4], sc[4], g4[4], b4[4]; int curset = -1;
#pragma unroll
    for (int j = 0; j < 4; ++j) { sh[j] = (f32x4){0.f, 0.f, 0.f, 0.f}; sc[j] = sh[j]; g4[j] = sh[j]; b4[j] = sh[j]; }
    if (LN) {
#pragma unroll
        for (int j = 0; j < 4; ++j) { g4[j] = *(const f32x4*)(gam + 4 * lane + 256 * j); b4[j] = *(const f32x4*)(bet + 4 * lane + 256 * j); } }
    for (int r = gw; r < nrows; r += NGW) {
        const int set = r < SEQ ? 0 : (r < NLAT ? 1 : 2);
        if (write_h && set != curset) { curset = set;
#pragma unroll
            for (int j = 0; j < 4; ++j) { sh[j] = *(const f32x4*)(shift0 + set * NMODW + 4 * lane + 256 * j); sc[j] = *(const f32x4*)(scale0 + set * NMODW + 4 * lane + 256 * j); } }
        float* dst = r < NLAT ? P.out + (size_t)r * DM : xctx + (size_t)(r - NLAT) * DM;
        const float* src = LN ? dst : (r < NLAT ? P.in[0] + (size_t)r * DM : P.in[2] + (size_t)(r - NLAT) * DM);
        f32x4 v[4];
#pragma unroll
        for (int j = 0; j < 4; ++j) v[j] = *(const f32x4*)(src + 4 * lane + 256 * j);
        if (LN) {
            float s = 0.f;
#pragma unroll
            for (int j = 0; j < 4; ++j) s += (v[j][0] + v[j][1]) + (v[j][2] + v[j][3]);
            const float mean = wave_sum(s) * (1.0f / DM); float s2 = 0.f;
#pragma unroll
            for (int j = 0; j < 4; ++j) { v[j] = v[j] - mean; s2 += (v[j][0] * v[j][0] + v[j][1] * v[j][1]) + (v[j][2] * v[j][2] + v[j][3] * v[j][3]); }
            const float rstd = 1.0f / sqrtf(wave_sum(s2) * (1.0f / DM) + 1e-6f);
            if (!write_x && lane == 0) *(f32x2*)(stats + 2 * (size_t)r) = (f32x2){mean, rstd};
#pragma unroll
            for (int j = 0; j < 4; ++j) v[j] = v[j] * rstd * g4[j] + b4[j];
        }
        if (write_x) {
#pragma unroll
            for (int j = 0; j < 4; ++j) *(f32x4*)(dst + 4 * lane + 256 * j) = v[j]; }
        if (write_h) {
#pragma unroll
            for (int j = 0; j < 4; ++j) { const f32x4 h = v[j] * (sc[j] + 1.0f) + sh[j]; u32x2 o; o.x = cvtpk(h[0], h[1]); o.y = cvtpk(h[2], h[3]);
                *(u32x2*)(H + (size_t)r * DM + 4 * lane + 256 * j) = o; } }
    }
}

__device__ __forceinline__ void rope4(float (&v)[4], const float* ctab, const float* stab, bool odd, int xmask) {
    const f32x4 c = *(const f32x4*)ctab, s = *(const f32x4*)stab;
#pragma unroll
    for (int e = 0; e < 4; ++e) { const float p = __shfl_xor(v[e], xmask); v[e] = v[e] * c[e] + (odd ? p : -p) * s[e]; }
}
__device__ __forceinline__ void up4(const u32x2 raw, float (&v)[4]) { v[0] = bf2f(raw.x & 0xffffu); v[1] = bf2f(raw.x >> 16); v[2] = bf2f(raw.y & 0xffffu); v[3] = bf2f(raw.y >> 16); }
__device__ __forceinline__ void ld4(const bf16_t* p, float (&v)[4]) { const u32x2 raw = *(const u32x2*)p; v[0] = bf2f(raw.x & 0xffffu); v[1] = bf2f(raw.x >> 16); v[2] = bf2f(raw.y & 0xffffu); v[3] = bf2f(raw.y >> 16); }
__device__ __forceinline__ void st4(bf16_t* p, const float (&v)[4], float sc) { u32x2 o; o.x = cvtpk(v[0] * sc, v[1] * sc); o.y = cvtpk(v[2] * sc, v[3] * sc); *(u32x2*)p = o; }
__device__ __forceinline__ void st4lds(LAS bf16_t* p, const float (&v)[4]) { u32x2 o; o.x = cvtpk(v[0], v[1]); o.y = cvtpk(v[2], v[3]); *(LAS u32x2*)p = o; }

__device__ __forceinline__ void zpost_phase(const Params& P, LAS unsigned char* lds, int l) {
    int tid_ = threadIdx.x; asm volatile("" : "+v"(tid_)); const int tid = tid_, lane = tid & 63, wave = __builtin_amdgcn_readfirstlane(tid >> 6);
    GAS unsigned char* wsg_ = (GAS unsigned char*)P.ws; asm volatile("" : "+s"(wsg_)); unsigned char* ws = (unsigned char*)wsg_;
    const bf16_t* Z = (const bf16_t*)(ws + WS_Z); bf16_t* Y = (bf16_t*)(ws + WS_Y); unsigned char* qkv = ws + WS_QKV;
    bf16_t *QA = (bf16_t*)(qkv + O_QA), *KA = (bf16_t*)(qkv + O_KA), *VAT = (bf16_t*)(qkv + O_VAT), *QC = (bf16_t*)(qkv + O_QC), *KC = (bf16_t*)(qkv + O_KC), *VCT = (bf16_t*)(qkv + O_VCT),
           *QD = (bf16_t*)(qkv + O_QD), *KD = (bf16_t*)(qkv + O_KD), *VDT = (bf16_t*)(qkv + O_VDT);
    const float* rope = (const float*)(ws + WS_ROPE);
    const float* convw = P.in[12] + l * 768; const float* qnw = P.in[19] + l * 64; const float* knw = P.in[20] + l * 64;
    LAS bf16_t* vt = (LAS bf16_t*)lds;
    for (int u = blockIdx.x; u < 1040; u += gridDim.x) {
        const int b = u / 520, kt = u % 520, kk0 = kt * 32; const bool isctx = kt < 8;
        __syncthreads();
        for (int ii = 0; ii < 4; ++ii) {
            const int i = wave * 4 + ii, kk = kk0 + i;
            const int r = isctx ? NLAT + b * CTXL + kk : b * SEQ + kk - CTXL;
            const int t = kk - CTXL, prow = (t >> 6) & 255, pcol = t & 63;
            const bf16_t* z = Z + (size_t)r * INW;
            float v[4];
            const int lkk = lane & 31;
            const bool hasp_ = isctx ? (kk > 0) : (t > 0), hasn_ = isctx ? (kk < CTXL - 1) : (t < SEQ - 1);
            u32x2 zr[16];
            zr[0] = *(const u32x2*)(z + 4 * lane); zr[1] = *(const u32x2*)(z + 256 + 4 * lane); zr[2] = *(const u32x2*)(z + 512 + 4 * lane);
            zr[3] = *(const u32x2*)(z + 768 + 4 * lane); zr[4] = *(const u32x2*)(z + 1024 + 4 * lane); zr[5] = *(const u32x2*)(z + 1280 + 4 * lane);
            zr[6] = (u32x2){0u, 0u}; zr[7] = zr[6]; zr[8] = zr[6]; zr[9] = zr[6];
            if (hasp_) { zr[6] = *(const u32x2*)(z - INW + 1024 + 4 * lane); zr[7] = *(const u32x2*)(z - INW + 1280 + 4 * lane); }
            if (hasn_) { zr[8] = *(const u32x2*)(z + INW + 1024 + 4 * lane); zr[9] = *(const u32x2*)(z + INW + 1280 + 4 * lane); }
            zr[10] = *(const u32x2*)(z + 1536 + 4 * lane); zr[11] = *(const u32x2*)(z + 1792 + 4 * lkk); zr[12] = *(const u32x2*)(z + 1920 + 4 * lkk);
            zr[13] = *(const u32x2*)(z + 2048 + 4 * lane); zr[14] = *(const u32x2*)(z + 2304 + 4 * lkk); zr[15] = *(const u32x2*)(z + 2432 + 4 * lkk);
            { const int h = lane >> 4, c = (4 * lane) & 63, quarter = (lane & 7) >> 1, e0 = (lane & 1) * 4; const int pos = quarter < 2 ? prow : pcol;
              const float* ct = rope + pos * 8 + e0; const float* st = rope + 2048 + pos * 8 + e0;
              up4(zr[0], v); if (!isctx) rope4(v, ct, st, quarter & 1, 2);
              st4(QA + ((size_t)(b * 4 + h) * NK + kk) * 64 + c, v, QSCALE_A);
              up4(zr[1], v); if (!isctx) rope4(v, ct, st, quarter & 1, 2);
              st4(KA + ((size_t)(b * 4 + h) * NK + kk) * 64 + c, v, 1.0f);
              up4(zr[2], v); st4lds(vt + i * 520 + 4 * lane, v); }
            { const bool hasp = isctx ? (kk > 0) : (t > 0), hasn = isctx ? (kk < CTXL - 1) : (t < SEQ - 1);
              float gb[4], gc[4], uu[4], hm[4], hp[4]; up4(zr[3], gb); up4(zr[4], gc); up4(zr[5], uu);
#pragma unroll
              for (int e = 0; e < 4; ++e) { hm[e] = 0.f; hp[e] = 0.f; }
              if (hasp) { float a[4], c2[4]; up4(zr[6], a); up4(zr[7], c2);
#pragma unroll
                  for (int e = 0; e < 4; ++e) hm[e] = a[e] * c2[e]; }
              if (hasn) { float a[4], c2[4]; up4(zr[8], a); up4(zr[9], c2);
#pragma unroll
                  for (int e = 0; e < 4; ++e) hp[e] = a[e] * c2[e]; }
              const f32x4 w0 = *(const f32x4*)(convw + 4 * lane), w1 = *(const f32x4*)(convw + 256 + 4 * lane), w2 = *(const f32x4*)(convw + 512 + 4 * lane);
#pragma unroll
              for (int e = 0; e < 4; ++e) v[e] = gb[e] * (w0[e] * hm[e] + w1[e] * (gc[e] * uu[e]) + w2[e] * hp[e]);
              st4(Y + (size_t)r * DM + 256 + 4 * lane, v, 1.0f); }
            { const int hq = lane >> 4, c = (4 * lane) & 63, quarter = (lane & 15) >> 2, e0 = (lane & 3) * 4; const int pos = quarter < 2 ? prow : pcol;
              const float* ct = rope + 4096 + pos * 16 + e0; const float* st = rope + 8192 + pos * 16 + e0;
              const int lk = lane & 31, hk = lk >> 4;
              up4(zr[10], v); if (!isctx) rope4(v, ct, st, quarter & 1, 4);
              st4(QC + ((size_t)(b * 4 + hq) * NK + kk) * 64 + c, v, QSCALE_H);
              up4(zr[11], v); if (!isctx) rope4(v, ct, st, quarter & 1, 4);
              if (lane < 32) st4(KC + ((size_t)(b * 2 + hk) * NK + kk) * 64 + c, v, 1.0f);
              up4(zr[12], v); if (lane < 32) st4lds(vt + i * 520 + 256 + 4 * lk, v);
              up4(zr[13], v);
              { float ss = v[0] * v[0] + v[1] * v[1] + v[2] * v[2] + v[3] * v[3]; ss += __shfl_xor(ss, 1); ss += __shfl_xor(ss, 2); ss += __shfl_xor(ss, 4); ss += __shfl_xor(ss, 8);
                const float rs = 1.0f / sqrtf(ss * (1.0f / 64.0f) + 1e-6f); const f32x4 w = *(const f32x4*)(qnw + c);
#pragma unroll
                for (int e = 0; e < 4; ++e) v[e] = v[e] * rs * w[e]; }
              if (!isctx) rope4(v, ct, st, quarter & 1, 4);
              st4(QD + ((size_t)(b * 4 + hq) * NK + kk) * 64 + c, v, QSCALE_H);
              up4(zr[14], v);
              { float ss = v[0] * v[0] + v[1] * v[1] + v[2] * v[2] + v[3] * v[3]; ss += __shfl_xor(ss, 1); ss += __shfl_xor(ss, 2); ss += __shfl_xor(ss, 4); ss += __shfl_xor(ss, 8);
                const float rs = 1.0f / sqrtf(ss * (1.0f / 64.0f) + 1e-6f); const f32x4 w = *(const f32x4*)(knw + c);
#pragma unroll
                for (int e = 0; e < 4; ++e) v[e] = v[e] * rs * w[e]; }
              if (!isctx) rope4(v, ct, st, quarter & 1, 4);
              if (lane < 32) st4(KD + ((size_t)(b * 2 + hk) * NK + kk) * 64 + c, v, 1.0f);
              up4(zr[15], v); if (lane < 32) st4lds(vt + i * 520 + 384 + 4 * lk, v); }
        }
        __syncthreads();
#pragma unroll 2
        for (int it = 0; it < 4; ++it) { const int vc = it * 128 + (tid >> 2), g = tid & 3; bf16_t* dst;
          if (vc < 256) dst = VAT + ((size_t)(b * 4 + (vc >> 6)) * 64 + (vc & 63)) * NK;
          else if (vc < 384) dst = VCT + ((size_t)(b * 2 + ((vc - 256) >> 6)) * 64 + (vc & 63)) * NK;
          else dst = VDT + ((size_t)(b * 2 + ((vc - 384) >> 6)) * 64 + (vc & 63)) * NK;
          unsigned w[4];
#pragma unroll
          for (int i2 = 0; i2 < 4; ++i2) { const int ia = 2 * i2, ib = 2 * i2 + 1;
              const int ta = 16 * (g >> 1) + 8 * (ia >> 2) + 4 * (g & 1) + (ia & 3), tb = 16 * (g >> 1) + 8 * (ib >> 2) + 4 * (g & 1) + (ib & 3);
              w[i2] = (unsigned)vt[ta * 520 + vc] | ((unsigned)vt[tb * 520 + vc] << 16); }
          *(u32x4*)(dst + kk0 + 8 * g) = (u32x4){w[0], w[1], w[2], w[3]}; }
    }
}

__device__ __forceinline__ float fmax3(float a, float b, float c) { float r; asm("v_max3_f32 %0, %1, %2, %3" : "=v"(r) : "v"(a), "v"(b), "v"(c)); return r; }
__device__ __forceinline__ void g2_first(f32x16& acc, bf16x8 a, bf16x8 b, const f32x16& c, float& e0, float& e1, float& e2, float& e3, float p0, float p1, float p2, float p3) {
    asm volatile("s_nop 4\n\tv_mfma_f32_32x32x16_bf16 %0, %5, %6, %7\n\tv_exp_f32_e32 %1, %8\n\tv_exp_f32_e32 %2, %9\n\tv_exp_f32_e32 %3, %10\n\tv_exp_f32_e32 %4, %11\n\ts_nop 0"
                 : "=&v"(acc), "=&v"(e0), "=&v"(e1), "=&v"(e2), "=&v"(e3) : "v"(a), "v"(b), "v"(c), "v"(p0), "v"(p1), "v"(p2), "v"(p3)); }
__device__ __forceinline__ void g2_acc(f32x16& acc, bf16x8 a, bf16x8 b, float& e0, float& e1, float& e2, float& e3, float p0, float p1, float p2, float p3) {
    asm volatile("v_mfma_f32_32x32x16_bf16 %0, %5, %6, %0\n\tv_exp_f32_e32 %1, %7\n\tv_exp_f32_e32 %2, %8\n\tv_exp_f32_e32 %3, %9\n\tv_exp_f32_e32 %4, %10\n\ts_nop 0"
                 : "+v"(acc), "=&v"(e0), "=&v"(e1), "=&v"(e2), "=&v"(e3) : "v"(a), "v"(b), "v"(p0), "v"(p1), "v"(p2), "v"(p3)); }
__device__ __forceinline__ void g2_none(float& e0, float& e1, float& e2, float& e3, float p0, float p1, float p2, float p3) {
    asm volatile("v_exp_f32_e32 %0, %4\n\tv_exp_f32_e32 %1, %5\n\tv_exp_f32_e32 %2, %6\n\tv_exp_f32_e32 %3, %7\n\ts_nop 0"
                 : "=&v"(e0), "=&v"(e1), "=&v"(e2), "=&v"(e3) : "v"(p0), "v"(p1), "v"(p2), "v"(p3)); }
__device__ __forceinline__ bf16x8 pack8(const f32x16& e, int b) { const u32x4 t = (u32x4){cvtpk(e[b], e[b + 1]), cvtpk(e[b + 2], e[b + 3]), cvtpk(e[b + 4], e[b + 5]), cvtpk(e[b + 6], e[b + 7])}; return __builtin_bit_cast(bf16x8, t); }
__device__ __forceinline__ float sum4(const f32x16& e, int b) { return (e[b] + e[b + 1]) + (e[b + 2] + e[b + 3]); }
__device__ __forceinline__ void g1_a0(f32x16& o, bf16x8 vf, bf16x8 pw, float& ps, float a0, float a1, float a2, float a3) {
    asm volatile("s_nop 1\n\tv_mfma_f32_32x32x16_bf16 %0, %2, %3, %0\n\tv_add_f32_e32 %1, %1, %4\n\tv_add_f32_e32 %1, %1, %5\n\tv_add_f32_e32 %1, %1, %6\n\tv_add_f32_e32 %1, %1, %7"
                 : "+v"(o), "+v"(ps) : "v"(vf), "v"(pw), "v"(a0), "v"(a1), "v"(a2), "v"(a3)); }
__device__ __forceinline__ void g1_b0(f32x16& o, bf16x8 vf, bf16x8 pw, float& ps, float a0, float a1, float a2, float a3,
                                      unsigned& w0, unsigned& w1, unsigned& w2, unsigned& w3, float c0, float c1, float c2, float c3, float c4, float c5, float c6, float c7) {
    asm volatile("s_nop 1\n\tv_mfma_f32_32x32x16_bf16 %0, %6, %7, %0\n\tv_add_f32_e32 %1, %1, %8\n\tv_add_f32_e32 %1, %1, %9\n\tv_add_f32_e32 %1, %1, %10\n\tv_add_f32_e32 %1, %1, %11\n\t"
                 "v_cvt_pk_bf16_f32 %2, %12, %13\n\tv_cvt_pk_bf16_f32 %3, %14, %15\n\tv_cvt_pk_bf16_f32 %4, %16, %17\n\tv_cvt_pk_bf16_f32 %5, %18, %19"
                 : "+v"(o), "+v"(ps), "=&v"(w0), "=&v"(w1), "=&v"(w2), "=&v"(w3)
                 : "v"(vf), "v"(pw), "v"(a0), "v"(a1), "v"(a2), "v"(a3), "v"(c0), "v"(c1), "v"(c2), "v"(c3), "v"(c4), "v"(c5), "v"(c6), "v"(c7)); }
__device__ __forceinline__ void g1_a(f32x16& o, bf16x8 vf, bf16x8 pw, float& mx, float m0, float m1, float m2, float m3, float& ps, float a0, float a1, float a2, float a3) {
    asm volatile("s_nop 1\n\tv_mfma_f32_32x32x16_bf16 %0, %3, %4, %0\n\tv_max3_f32 %1, %1, %5, %6\n\tv_max3_f32 %1, %1, %7, %8\n\t"
                 "v_add_f32_e32 %2, %2, %9\n\tv_add_f32_e32 %2, %2, %10\n\tv_add_f32_e32 %2, %2, %11\n\tv_add_f32_e32 %2, %2, %12"
                 : "+v"(o), "+v"(mx), "+v"(ps) : "v"(vf), "v"(pw), "v"(m0), "v"(m1), "v"(m2), "v"(m3), "v"(a0), "v"(a1), "v"(a2), "v"(a3)); }
__device__ __forceinline__ void g1_b(f32x16& o, bf16x8 vf, bf16x8 pw, float& mx, float m0, float m1, float m2, float m3, float& ps, float a0, float a1, float a2, float a3,
                                     unsigned& w0, unsigned& w1, unsigned& w2, unsigned& w3, float c0, float c1, float c2, float c3, float c4, float c5, float c6, float c7) {
    asm volatile("s_nop 1\n\tv_mfma_f32_32x32x16_bf16 %0, %7, %8, %0\n\tv_max3_f32 %1, %1, %9, %10\n\tv_max3_f32 %1, %1, %11, %12\n\t"
                 "v_add_f32_e32 %2, %2, %13\n\tv_add_f32_e32 %2, %2, %14\n\tv_add_f32_e32 %2, %2, %15\n\tv_add_f32_e32 %2, %2, %16\n\t"
                 "v_cvt_pk_bf16_f32 %3, %17, %18\n\tv_cvt_pk_bf16_f32 %4, %19, %20\n\tv_cvt_pk_bf16_f32 %5, %21, %22\n\tv_cvt_pk_bf16_f32 %6, %23, %24"
                 : "+v"(o), "+v"(mx), "+v"(ps), "=&v"(w0), "=&v"(w1), "=&v"(w2), "=&v"(w3)
                 : "v"(vf), "v"(pw), "v"(m0), "v"(m1), "v"(m2), "v"(m3), "v"(a0), "v"(a1), "v"(a2), "v"(a3), "v"(c0), "v"(c1), "v"(c2), "v"(c3), "v"(c4), "v"(c5), "v"(c6), "v"(c7)); }
struct AttnPtrs { const bf16_t* Q; const bf16_t* K; const bf16_t* Vt; bf16_t* Y; const float* subw; const float* sink; float lam; float oml; };
template <int MODE>
__device__ __forceinline__ void attn_unit(LAS unsigned char* lds, const AttnPtrs& A, int b, int head, int qt) {
    int tid_ = threadIdx.x; asm volatile("" : "+v"(tid_)); const int tid = tid_, lane = tid & 63, r32 = lane & 31, hi = lane >> 5;
    const int wid = __builtin_amdgcn_readfirstlane(tid >> 6), sub = wid >> 2, rq = (wid & 3) * 32;
    constexpr int DQ = (MODE == 0) ? 32 : 64, NCH = DQ / 16, NKVH = (MODE == 0) ? 4 : 2;
    constexpr int KBUF = 9216, VBUF = 9216, VS0 = 4 * KBUF, XB0 = VS0 + 5 * VBUF;
    constexpr float THR = 8.0f;
    const int q0 = qt * 128;
    const int qhead = (MODE == 0) ? head : head * 2 + sub;
    const int doff = (MODE == 0) ? sub * 32 : 0;
    const bf16_t* Qrow = A.Q + ((size_t)(b * 4 + qhead) * NK + q0 + rq + r32) * 64 + doff;
    const bf16_t* Kb = A.K + (size_t)(b * NKVH + head) * NK * 64;
    const bf16_t* Vb = A.Vt + (size_t)(b * NKVH + head) * 64 * NK;
    bf16x8 qf[NCH];
#pragma unroll
    for (int j = 0; j < NCH; ++j) qf[j] = *(const bf16x8*)(Qrow + 16 * j + 8 * hi);
    int lo = 4, hit = 4;
    if (qt >= 2) { if (MODE == 1) { lo = (q0 - 128) >> 6; if (lo < 4) lo = 4; hit = (q0 + 256) >> 6; if (hit > 260) hit = 260; } else { hit = 260; } }
    const int nsteps = 4 + hit - lo;
#define ATT_TILE(s) ((s) < 4 ? (s) : lo + (s) - 4)
    const int srow = tid >> 3, sch = tid & 7;
    const bf16_t* kg = Kb + (size_t)srow * 64 + sch * 8;
    const bf16_t* vg = Vb + (size_t)srow * NK + sch * 8;
    const unsigned sofs = srow * 144 + sch * 16;
    LAS unsigned char* Ks = lds; LAS unsigned char* Vs = lds + VS0;
    const LAS unsigned char* kp0 = Ks + r32 * 144 + (doff + 8 * hi) * 2;
    const LAS unsigned char* vp0 = Vs + r32 * 144 + hi * 16;
    const int qrel = q0 + rq + r32;
    f32x16 negm, p0, p1, o0, o1;
#pragma unroll
    for (int r = 0; r < 16; ++r) { negm[r] = 0.f; o0[r] = 0.f; o1[r] = 0.f; }
    asm volatile("" : "+v"(negm));
#define ATT_QK(D0, D1, kbuf) do { const LAS unsigned char* kp_ = kp0 + (kbuf) * KBUF; \
        _Pragma("unroll") for (int j = 0; j < NCH; ++j) { const bf16x8 k0_ = *(const LAS bf16x8*)(kp_ + j * 32); const bf16x8 k1_ = *(const LAS bf16x8*)(kp_ + 32 * 144 + j * 32); \
            if (j == 0) { D0 = __builtin_amdgcn_mfma_f32_32x32x16_bf16(k0_, qf[0], negm, 0, 0, 0); D1 = __builtin_amdgcn_mfma_f32_32x32x16_bf16(k1_, qf[0], negm, 0, 0, 0); } \
            else { D0 = __builtin_amdgcn_mfma_f32_32x32x16_bf16(k0_, qf[j], D0, 0, 0, 0); D1 = __builtin_amdgcn_mfma_f32_32x32x16_bf16(k1_, qf[j], D1, 0, 0, 0); } } } while (0)
#define ATT_MASK(D0, D1, s) do { if (MODE == 1 && (s) >= 4) { asm volatile("s_nop 7\n\ts_nop 3" ::: "memory");     \
        const int db_ = (lo + (s) - 4) * 64 - qrel; \
        _Pragma("unroll") for (int r = 0; r < 16; ++r) { const int d0_ = db_ + crow(r, hi), d1_ = d0_ + 32; \
            if (d0_ > 128 || d0_ < -128) D0[r] = -1e30f; if (d1_ > 128 || d1_ < -128) D1[r] = -1e30f; } } } while (0)
#define ATT_LDK(s) (*(const u32x4*)(kg + (size_t)ATT_TILE(s) * 4096))
#define ATT_LDV(s) (*(const u32x4*)(vg + ATT_TILE(s) * 64))

    __syncthreads();
    u32x4 kqa = (u32x4){0u, 0u, 0u, 0u}, vqa = kqa, kqb = kqa, vqb = kqa;
    { const u32x4 k0r = ATT_LDK(0); const u32x4 v0r = ATT_LDV(0); const u32x4 k1r = ATT_LDK(1); const u32x4 k2r = ATT_LDK(2); const u32x4 v1r = ATT_LDV(1);
      kqb = ATT_LDK(3); vqb = ATT_LDV(2);
      *(LAS u32x4*)(Ks + sofs) = k0r; *(LAS u32x4*)(Vs + sofs) = v0r; *(LAS u32x4*)(Ks + KBUF + sofs) = k1r; *(LAS u32x4*)(Ks + 2 * KBUF + sofs) = k2r; *(LAS u32x4*)(Vs + VBUF + sofs) = v1r; }
    __syncthreads();
    f32x16 pb0, pb1;
    ATT_QK(p0, p1, 0);
    float m = 0.f, lsum = 0.f;
    int kb_cur = 0;
#define ATT_MAXUPD(S, P0, P1) do { \
        float mx = fmax3(fmax3(P0[0], P1[0], P0[1]), P1[1], P0[2]); \
        _Pragma("unroll") for (int r = 2; r < 14; r += 2) mx = fmax3(fmax3(mx, P1[r], P0[r + 1]), P1[r + 1], P0[r + 2]); \
        mx = fmax3(fmax3(mx, P1[14], P0[15]), P1[15], P1[15]); \
        mx = xhalf_max(mx); \
        if ((S) == 0 || __any(mx > THR)) { \
            const float dl = ((S) == 0) ? mx : fmaxf(mx, 0.f); \
            m += dl; \
            _Pragma("unroll") for (int r = 0; r < 16; ++r) { P0[r] -= dl; P1[r] -= dl; negm[r] = -m; } \
            asm volatile("" : "+v"(negm)); \
            if ((S) > 0) { const float f = __builtin_amdgcn_exp2f(-dl); lsum *= f; \
                _Pragma("unroll") for (int r = 0; r < 16; ++r) { o0[r] *= f; o1[r] *= f; } } \
        } } while (0)
#define ATT_EXPPACK(P0, P1, PW) do { \
        float ps = 0.f; \
        _Pragma("unroll") for (int r = 0; r < 16; ++r) { P0[r] = __builtin_amdgcn_exp2f(P0[r]); P1[r] = __builtin_amdgcn_exp2f(P1[r]); ps += P0[r] + P1[r]; } \
        lsum += ps; \
        { u32x4 t; \
          t.x = cvtpk(P0[0], P0[1]); t.y = cvtpk(P0[2], P0[3]); t.z = cvtpk(P0[4], P0[5]); t.w = cvtpk(P0[6], P0[7]); PW[0] = __builtin_bit_cast(bf16x8, t); \
          t.x = cvtpk(P0[8], P0[9]); t.y = cvtpk(P0[10], P0[11]); t.z = cvtpk(P0[12], P0[13]); t.w = cvtpk(P0[14], P0[15]); PW[1] = __builtin_bit_cast(bf16x8, t); \
          t.x = cvtpk(P1[0], P1[1]); t.y = cvtpk(P1[2], P1[3]); t.z = cvtpk(P1[4], P1[5]); t.w = cvtpk(P1[6], P1[7]); PW[2] = __builtin_bit_cast(bf16x8, t); \
          t.x = cvtpk(P1[8], P1[9]); t.y = cvtpk(P1[10], P1[11]); t.z = cvtpk(P1[12], P1[13]); t.w = cvtpk(P1[14], P1[15]); PW[3] = __builtin_bit_cast(bf16x8, t); } } while (0)
#define ATT_PV(PW, vslot) do { const LAS unsigned char* vp_ = vp0 + (vslot) * VBUF; \
        _Pragma("unroll") for (int c = 0; c < 4; ++c) { const bf16x8 v0_ = *(const LAS bf16x8*)(vp_ + c * 32); const bf16x8 v1_ = *(const LAS bf16x8*)(vp_ + 32 * 144 + c * 32); \
            o0 = __builtin_amdgcn_mfma_f32_32x32x16_bf16(v0_, PW[c], o0, 0, 0, 0); o1 = __builtin_amdgcn_mfma_f32_32x32x16_bf16(v1_, PW[c], o1, 0, 0, 0); } } while (0)
    bf16x8 pwk[4];
#pragma unroll
    for (int c = 0; c < 4; ++c) pwk[c] = (bf16x8){0, 0, 0, 0, 0, 0, 0, 0};
#define ATT_LDVF(VF, vslot) do { const LAS unsigned char* vp_ = vp0 + (vslot) * VBUF; \
        _Pragma("unroll") for (int c = 0; c < 4; ++c) { VF[2 * c] = *(const LAS bf16x8*)(vp_ + c * 32); VF[2 * c + 1] = *(const LAS bf16x8*)(vp_ + 32 * 144 + c * 32); } } while (0)
#define ATT_LDKF(KF, kslot) do { const LAS unsigned char* kp_ = kp0 + (kslot) * KBUF; \
        _Pragma("unroll") for (int j = 0; j < NCH; ++j) { KF[2 * j] = *(const LAS bf16x8*)(kp_ + j * 32); KF[2 * j + 1] = *(const LAS bf16x8*)(kp_ + 32 * 144 + j * 32); } } while (0)
#define ATT_PVF(VF, PW) do { \
        _Pragma("unroll") for (int c = 0; c < 4; ++c) { o0 = __builtin_amdgcn_mfma_f32_32x32x16_bf16(VF[2 * c], PW[c], o0, 0, 0, 0); o1 = __builtin_amdgcn_mfma_f32_32x32x16_bf16(VF[2 * c + 1], PW[c], o1, 0, 0, 0); } } while (0)
#define ATT_QKF(KF, D0, D1) do { \
        D0 = __builtin_amdgcn_mfma_f32_32x32x16_bf16(KF[0], qf[0], negm, 0, 0, 0); D1 = __builtin_amdgcn_mfma_f32_32x32x16_bf16(KF[1], qf[0], negm, 0, 0, 0); \
        _Pragma("unroll") for (int j = 1; j < NCH; ++j) { D0 = __builtin_amdgcn_mfma_f32_32x32x16_bf16(KF[2 * j], qf[j], D0, 0, 0, 0); D1 = __builtin_amdgcn_mfma_f32_32x32x16_bf16(KF[2 * j + 1], qf[j], D1, 0, 0, 0); } } while (0)
#define ATT_VV(P0, P1, i) ((i) < 16 ? P0[(i) & 15] : P1[(i) & 15])
#define ATT_MXOP(P0, P1, k) do { if ((k) == 0) mx_ = fmax3(P0[0], P0[1], P0[2]); else if ((k) == 15) mx_ = fmax3(mx_, P1[15], P1[15]); \
        else mx_ = fmax3(mx_, ATT_VV(P0, P1, 1 + 2 * (k)), ATT_VV(P0, P1, 2 + 2 * (k))); } while (0)
#define ATT_SB() __builtin_amdgcn_sched_barrier(0)
#define ATT_STEP(BAR, S, FIRST, CHK, P0, P1, N0, N1, KN, VN, KO, VO) do { \
        if (BAR) __syncthreads(); \
        const int kb_n1 = (kb_cur + 1) & 3; const int vb_prev = vb_cur == 0 ? 4 : vb_cur - 1; \
        { const int sk_ = (S) + 4 < nsteps ? (S) + 4 : nsteps - 1, sv_ = (S) + 3 < nsteps ? (S) + 3 : nsteps - 1;     \
          KN = ATT_LDK(sk_); VN = ATT_LDV(sv_); } \
        bf16x8 kf_[2 * NCH]; \
        float mx_; \
        if (!(FIRST)) { \
            if (BAR) { ATT_LDVF(vf_, vb_prev); }     \
            ATT_SB(); \
            __builtin_amdgcn_s_setprio(1); \
              \
            float ps_ = 0.f; mx_ = P0[0]; bf16x8 pwa_ = pack8(N0, 0), pwb_; unsigned w0_, w1_, w2_, w3_; \
            if (CHK) { \
            g1_a(o0, vf_[0], pwa_, mx_, P0[1], P0[2], P0[3], P0[4], ps_, N0[0], N0[1], N0[2], N0[3]); \
            g1_b(o1, vf_[1], pwa_, mx_, P0[5], P0[6], P0[7], P0[8], ps_, N0[4], N0[5], N0[6], N0[7], w0_, w1_, w2_, w3_, N0[8], N0[9], N0[10], N0[11], N0[12], N0[13], N0[14], N0[15]); \
            { const u32x4 t_ = (u32x4){w0_, w1_, w2_, w3_}; pwb_ = __builtin_bit_cast(bf16x8, t_); } \
            g1_a(o0, vf_[2], pwb_, mx_, P0[9], P0[10], P0[11], P0[12], ps_, N0[8], N0[9], N0[10], N0[11]); \
            g1_b(o1, vf_[3], pwb_, mx_, P0[13], P0[14], P0[15], P1[0], ps_, N0[12], N0[13], N0[14], N0[15], w0_, w1_, w2_, w3_, N1[0], N1[1], N1[2], N1[3], N1[4], N1[5], N1[6], N1[7]); \
            { const u32x4 t_ = (u32x4){w0_, w1_, w2_, w3_}; pwa_ = __builtin_bit_cast(bf16x8, t_); } \
            g1_a(o0, vf_[4], pwa_, mx_, P1[1], P1[2], P1[3], P1[4], ps_, N1[0], N1[1], N1[2], N1[3]); \
            g1_b(o1, vf_[5], pwa_, mx_, P1[5], P1[6], P1[7], P1[8], ps_, N1[4], N1[5], N1[6], N1[7], w0_, w1_, w2_, w3_, N1[8], N1[9], N1[10], N1[11], N1[12], N1[13], N1[14], N1[15]); \
            { const u32x4 t_ = (u32x4){w0_, w1_, w2_, w3_}; pwb_ = __builtin_bit_cast(bf16x8, t_); } \
            g1_a(o0, vf_[6], pwb_, mx_, P1[9], P1[10], P1[11], P1[12], ps_, N1[8], N1[9], N1[10], N1[11]); \
            g1_a(o1, vf_[7], pwb_, mx_, P1[13], P1[14], P1[15], P1[15], ps_, N1[12], N1[13], N1[14], N1[15]); \
            } else { \
            g1_a0(o0, vf_[0], pwa_, ps_, N0[0], N0[1], N0[2], N0[3]); \
            g1_b0(o1, vf_[1], pwa_, ps_, N0[4], N0[5], N0[6], N0[7], w0_, w1_, w2_, w3_, N0[8], N0[9], N0[10], N0[11], N0[12], N0[13], N0[14], N0[15]); \
            { const u32x4 t_ = (u32x4){w0_, w1_, w2_, w3_}; pwb_ = __builtin_bit_cast(bf16x8, t_); } \
            g1_a0(o0, vf_[2], pwb_, ps_, N0[8], N0[9], N0[10], N0[11]); \
            g1_b0(o1, vf_[3], pwb_, ps_, N0[12], N0[13], N0[14], N0[15], w0_, w1_, w2_, w3_, N1[0], N1[1], N1[2], N1[3], N1[4], N1[5], N1[6], N1[7]); \
            { const u32x4 t_ = (u32x4){w0_, w1_, w2_, w3_}; pwa_ = __builtin_bit_cast(bf16x8, t_); } \
            g1_a0(o0, vf_[4], pwa_, ps_, N1[0], N1[1], N1[2], N1[3]); \
            g1_b0(o1, vf_[5], pwa_, ps_, N1[4], N1[5], N1[6], N1[7], w0_, w1_, w2_, w3_, N1[8], N1[9], N1[10], N1[11], N1[12], N1[13], N1[14], N1[15]); \
            { const u32x4 t_ = (u32x4){w0_, w1_, w2_, w3_}; pwb_ = __builtin_bit_cast(bf16x8, t_); } \
            g1_a0(o0, vf_[6], pwb_, ps_, N1[8], N1[9], N1[10], N1[11]); \
            g1_a0(o1, vf_[7], pwb_, ps_, N1[12], N1[13], N1[14], N1[15]); \
            } \
            lsum += ps_; \
        } else { \
            _Pragma("unroll") for (int k = 0; k < 16; ++k) ATT_MXOP(P0, P1, k); \
        } \
        __builtin_amdgcn_s_setprio(0); \
        ATT_LDKF(kf_, kb_n1); \
        ATT_SB(); \
        if (CHK) { const float mx = xhalf_max(mx_); \
          if ((FIRST) || __any(mx > THR)) { \
            const float dl = (FIRST) ? mx : fmaxf(mx, 0.f); \
            m += dl; \
            _Pragma("unroll") for (int r = 0; r < 16; ++r) { P0[r] -= dl; P1[r] -= dl; negm[r] = -m; } \
            asm volatile("" : "+v"(negm)); \
            if (!(FIRST)) { asm volatile("s_nop 11" ::: "memory"); const float f = __builtin_amdgcn_exp2f(-dl); lsum *= f; \
                _Pragma("unroll") for (int r = 0; r < 16; ++r) { o0[r] *= f; o1[r] *= f; } } \
          } } \
        ATT_SB(); \
        { \
          _Pragma("unroll") for (int g = 0; g < 8; ++g) { \
            constexpr int GSTEP = 8 / (2 * NCH); \
            const float q0_ = g < 4 ? P0[(4 * g) & 15] : P1[(4 * g) & 15], q1_ = g < 4 ? P0[(4 * g + 1) & 15] : P1[(4 * g + 1) & 15], q2_ = g < 4 ? P0[(4 * g + 2) & 15] : P1[(4 * g + 2) & 15], q3_ = g < 4 ? P0[(4 * g + 3) & 15] : P1[(4 * g + 3) & 15]; \
            float e0, e1, e2, e3; \
            if ((g % GSTEP) == 0) { const int mi = g / GSTEP, j = mi >> 1; \
                if ((mi & 1) == 0) { if (j == 0) g2_first(N0, kf_[0], qf[0], negm, e0, e1, e2, e3, q0_, q1_, q2_, q3_); else g2_acc(N0, kf_[2 * j], qf[j], e0, e1, e2, e3, q0_, q1_, q2_, q3_); } \
                else { if (j == 0) g2_first(N1, kf_[1], qf[0], negm, e0, e1, e2, e3, q0_, q1_, q2_, q3_); else g2_acc(N1, kf_[2 * j + 1], qf[j], e0, e1, e2, e3, q0_, q1_, q2_, q3_); } } \
            else g2_none(e0, e1, e2, e3, q0_, q1_, q2_, q3_); \
            if (g < 4) { P0[(4 * g) & 15] = e0; P0[(4 * g + 1) & 15] = e1; P0[(4 * g + 2) & 15] = e2; P0[(4 * g + 3) & 15] = e3; } \
            else { P1[(4 * g) & 15] = e0; P1[(4 * g + 1) & 15] = e1; P1[(4 * g + 2) & 15] = e2; P1[(4 * g + 3) & 15] = e3; } \
            ATT_SB(); } } \
        ATT_MASK(N0, N1, (S) + 1); \
        *(LAS u32x4*)(Ks + ((kb_cur + 3) & 3) * KBUF + sofs) = KO; \
        *(LAS u32x4*)(Vs + (vb_cur >= 3 ? vb_cur - 3 : vb_cur + 2) * VBUF + sofs) = VO; \
        if (BAR) { ATT_LDVF(vf_, vb_cur); }     \
        kb_cur = kb_n1; vb_cur = vb_cur == 4 ? 0 : vb_cur + 1; } while (0)
    int vb_cur = 0;
    bf16x8 vf_[8];
    ATT_STEP(false, 0, true, true, p0, p1, pb0, pb1, kqa, vqa, kqb, vqb);
    int s = 1;
    for (; s + 7 < nsteps; s += 8) {
        ATT_STEP(true, s, false, false, pb0, pb1, p0, p1, kqb, vqb, kqa, vqa);
        ATT_STEP(false, s + 1, false, false, p0, p1, pb0, pb1, kqa, vqa, kqb, vqb);
        ATT_STEP(true, s + 2, false, false, pb0, pb1, p0, p1, kqb, vqb, kqa, vqa);
        ATT_STEP(false, s + 3, false, false, p0, p1, pb0, pb1, kqa, vqa, kqb, vqb);
        ATT_STEP(true, s + 4, false, false, pb0, pb1, p0, p1, kqb, vqb, kqa, vqa);
        ATT_STEP(false, s + 5, false, false, p0, p1, pb0, pb1, kqa, vqa, kqb, vqb);
        ATT_STEP(true, s + 6, false, true, pb0, pb1, p0, p1, kqb, vqb, kqa, vqa);
        ATT_STEP(false, s + 7, false, false, p0, p1, pb0, pb1, kqa, vqa, kqb, vqb);
    }
    for (; s + 1 < nsteps; s += 2) {
        ATT_STEP(true, s, false, false, pb0, pb1, p0, p1, kqb, vqb, kqa, vqa);
        ATT_STEP(false, s + 1, false, true, p0, p1, pb0, pb1, kqa, vqa, kqb, vqb);
    }
    ATT_STEP(true, nsteps - 1, false, false, pb0, pb1, p0, p1, kqb, vqb, kqa, vqa);
    { bf16x8 vfl[8]; ATT_LDVF(vfl, (vb_cur == 0 ? 4 : vb_cur - 1));
      const bf16x8 w0 = pack8(pb0, 0), w1 = pack8(pb0, 8), w2 = pack8(pb1, 0), w3 = pack8(pb1, 8);
      o0 = __builtin_amdgcn_mfma_f32_32x32x16_bf16(vfl[0], w0, o0, 0, 0, 0); o1 = __builtin_amdgcn_mfma_f32_32x32x16_bf16(vfl[1], w0, o1, 0, 0, 0);
      o0 = __builtin_amdgcn_mfma_f32_32x32x16_bf16(vfl[2], w1, o0, 0, 0, 0); o1 = __builtin_amdgcn_mfma_f32_32x32x16_bf16(vfl[3], w1, o1, 0, 0, 0);
      o0 = __builtin_amdgcn_mfma_f32_32x32x16_bf16(vfl[4], w2, o0, 0, 0, 0); o1 = __builtin_amdgcn_mfma_f32_32x32x16_bf16(vfl[5], w2, o1, 0, 0, 0);
      o0 = __builtin_amdgcn_mfma_f32_32x32x16_bf16(vfl[6], w3, o0, 0, 0, 0); o1 = __builtin_amdgcn_mfma_f32_32x32x16_bf16(vfl[7], w3, o1, 0, 0, 0);
      lsum += ((sum4(pb0, 0) + sum4(pb0, 4)) + (sum4(pb0, 8) + sum4(pb0, 12))) + ((sum4(pb1, 0) + sum4(pb1, 4)) + (sum4(pb1, 8) + sum4(pb1, 12))); }
#undef ATT_MAXUPD
#undef ATT_VV
#undef ATT_MXOP
#undef ATT_SB
#undef ATT_LDVF
#undef ATT_LDKF
#undef ATT_PVF
#undef ATT_QKF
#undef ATT_EXPPACK
#undef ATT_PV
#undef ATT_STEP
#undef ATT_LDK
#undef ATT_LDV
#undef ATT_TILE
#undef ATT_QK
#undef ATT_MASK
    float lt = xhalf_sum(lsum);
    if (MODE == 1) lt += __builtin_amdgcn_exp2f(A.sink[qhead] * LOG2E - m);
    const float inv = 1.0f / lt;
#pragma unroll
    for (int r = 0; r < 16; ++r) { o0[r] *= inv; o1[r] *= inv; }
    const int qq = q0 + rq + r32;
    const size_t yrow = qq < CTXL ? (size_t)(NLAT + b * CTXL + qq) : (size_t)b * SEQ + (qq - CTXL);
    if (MODE == 0) {
        LAS float* xb = (LAS float*)(lds + XB0) + (wid & 3) * 2048;
        if (sub == 1) {
#pragma unroll
            for (int r = 0; r < 16; ++r) { xb[r * 64 + lane] = o0[r]; xb[(16 + r) * 64 + lane] = o1[r]; } }
        __syncthreads();
        if (sub == 0) { float ss = 0.f;
#pragma unroll
            for (int r = 0; r < 16; ++r) { o0[r] -= A.lam * xb[r * 64 + lane]; o1[r] -= A.lam * xb[(16 + r) * 64 + lane]; ss += o0[r] * o0[r] + o1[r] * o1[r]; }
            ss = xhalf_sum(ss); const float rs = A.oml / sqrtf(ss * (1.0f / 64.0f) + 1e-6f);
            bf16_t* yp = A.Y + yrow * DM + head * 64;
#pragma unroll
            for (int rg = 0; rg < 4; ++rg) { const int dv = 8 * rg + 4 * hi; const f32x4 w0 = *(const f32x4*)(A.subw + dv), w1 = *(const f32x4*)(A.subw + 32 + dv);
                u32x2 a, c2; a.x = cvtpk(o0[4 * rg] * rs * w0[0], o0[4 * rg + 1] * rs * w0[1]); a.y = cvtpk(o0[4 * rg + 2] * rs * w0[2], o0[4 * rg + 3] * rs * w0[3]);
                c2.x = cvtpk(o1[4 * rg] * rs * w1[0], o1[4 * rg + 1] * rs * w1[1]); c2.y = cvtpk(o1[4 * rg + 2] * rs * w1[2], o1[4 * rg + 3] * rs * w1[3]);
                *(u32x2*)(yp + dv) = a; *(u32x2*)(yp + 32 + dv) = c2; } }
    } else {
        bf16_t* yp = A.Y + yrow * DM + (MODE == 1 ? 512 : 768) + qhead * 64;
#pragma unroll
        for (int rg = 0; rg < 4; ++rg) { const int dv = 8 * rg + 4 * hi;
            u32x2 a, c2; a.x = cvtpk(o0[4 * rg], o0[4 * rg + 1]); a.y = cvtpk(o0[4 * rg + 2], o0[4 * rg + 3]);
            c2.x = cvtpk(o1[4 * rg], o1[4 * rg + 1]); c2.y = cvtpk(o1[4 * rg + 2], o1[4 * rg + 3]);
            *(u32x2*)(yp + dv) = a; *(u32x2*)(yp + 32 + dv) = c2; }
    }
}
__device__ __forceinline__ unsigned xcc_id() { return (unsigned)__builtin_amdgcn_s_getreg((3 << 11) | 20) & 0xFu; }
__device__ __forceinline__ void attn_phase(const Params& P, LAS unsigned char* lds, int l) {
    GAS unsigned char* wsg_ = (GAS unsigned char*)P.ws; asm volatile("" : "+s"(wsg_)); unsigned char* ws = (unsigned char*)wsg_;
    unsigned char* qkv = ws + WS_QKV; bf16_t* Y = (bf16_t*)(ws + WS_Y);
    const float lam = ((const float*)(ws + WS_LAM))[l]; const float oml = 1.0f - (l == 0 ? 0.2f : 0.35550906759097f);
    const float* subw = P.in[17] + l * 64; const float* sink = P.in[18] + l * 4;
    const unsigned* xcnt = (const unsigned*)(ws + WS_XCNT);
    const int myx = (int)xcc_id(); const int rank = __builtin_amdgcn_readfirstlane(*(const LAS int*)(lds + LDS_RANK_OFF));
    int nx = 0, vx = 0, nloc = 1;
    for (int j = 0; j < 16; ++j) { const int cj = (int)xcnt[j]; if (cj > 0) { if (j < myx) ++vx; ++nx; } if (j == myx) nloc = cj; }
    if (nx < 1) nx = 1; if (nloc < 1) nloc = 1;
    const int nlist = (l == 0) ? 260 : 256;
    for (int g = vx; g < 8; g += nx) {
        for (int i = rank; i < nlist; i += nloc) {
            int mode, b, head, qt;
            if (i < 128) { mode = 0; b = g >> 2; head = g & 3; qt = 2 + i; }
            else if (i < 192) { mode = 2; b = (g & 3) >> 1; head = g & 1; qt = 2 + 64 * (g >> 2) + (i - 128); }
            else if (i < 256) { mode = 1; b = (g & 3) >> 1; head = g & 1; qt = 2 + 64 * (g >> 2) + (i - 192); }
            else if (i < 258) { mode = 0; b = g >> 2; head = g & 3; qt = i - 256; }
            else if (i == 258) { mode = 2; b = (g & 3) >> 1; head = g & 1; qt = g >> 2; }
            else { mode = 1; b = (g & 3) >> 1; head = g & 1; qt = g >> 2; }
            if (mode == 0) { const AttnPtrs A{(const bf16_t*)(qkv + O_QA), (const bf16_t*)(qkv + O_KA), (const bf16_t*)(qkv + O_VAT), Y, subw, sink, lam, oml}; attn_unit<0>(lds, A, b, head, qt); }
            else if (mode == 1) { const AttnPtrs A{(const bf16_t*)(qkv + O_QC), (const bf16_t*)(qkv + O_KC), (const bf16_t*)(qkv + O_VCT), Y, subw, sink, lam, oml}; attn_unit<1>(lds, A, b, head, qt); }
            else { const AttnPtrs A{(const bf16_t*)(qkv + O_QD), (const bf16_t*)(qkv + O_KD), (const bf16_t*)(qkv + O_VDT), Y, subw, sink, lam, oml}; attn_unit<2>(lds, A, b, head, qt); }
        }
    }
}

#define XB_TMO      128
#define XB_XCNT(j)  (256  + 64 * (j))
#define XB_XSUB(j)  (1280 + 64 * (j))
#define XB_XGEN(j)  (2304 + 64 * (j))
#define XB_TOP      3328
#define XB_TOPGEN   3392
#define XCD_BAR_WORDS 3456
#define XB_SPIN_CAP (1u << 23)

__device__ __forceinline__ unsigned xb_ld(unsigned* p)              { return __hip_atomic_load(p, __ATOMIC_RELAXED, __HIP_MEMORY_SCOPE_AGENT); }
__device__ __forceinline__ unsigned xb_add(unsigned* p, unsigned v) { return __hip_atomic_fetch_add(p, v, __ATOMIC_RELAXED, __HIP_MEMORY_SCOPE_AGENT); }
__device__ __forceinline__ unsigned xb_xcc_id() { return (unsigned)__builtin_amdgcn_s_getreg((3 << 11) | 20) & 0xFu; }
#define XB_SPIN(cond, bar) do { unsigned _sp = 0; while (cond) { __builtin_amdgcn_s_sleep(1); \
    if ((++_sp & 255u) == 0u) { if (xb_ld(&(bar)[XB_TMO])) break; if (_sp > XB_SPIN_CAP) { atomicAdd(&(bar)[XB_TMO], 1u); break; } } } } while (0)

struct XcdBarrier {
    unsigned* bar; unsigned x;
    volatile LAS unsigned* st;
};

__device__ __forceinline__ XcdBarrier xcd_barrier_post(unsigned* bar, volatile LAS unsigned* st) {
    XcdBarrier b; b.bar = bar; b.x = xb_xcc_id(); b.st = st;
    if (threadIdx.x == 0) (void)xb_add(&bar[XB_XCNT(b.x)], 1u);
    return b;
}
__device__ __forceinline__ void xcd_barrier_complete(unsigned* bar, unsigned x, unsigned& nloc, unsigned& nx) {
    const unsigned G = gridDim.x * gridDim.y * gridDim.z;
    unsigned sum, cnt, mine, sp = 0u;
    for (;;) {
        sum = 0u; cnt = 0u; mine = 0u;
#pragma unroll
        for (unsigned j = 0; j < 16; ++j) { const unsigned c = xb_ld(&bar[XB_XCNT(j)]); sum += c; cnt += (c > 0u) ? 1u : 0u; mine = (j == x) ? c : mine; }
        if (sum == G) break;
        __builtin_amdgcn_s_sleep(1);
        if ((++sp & 255u) == 0u) { if (xb_ld(&bar[XB_TMO])) break; if (sp > XB_SPIN_CAP) { atomicAdd(&bar[XB_TMO], 1u); break; } }
    }
    nloc = mine > 0u ? mine : 1u; nx = cnt > 0u ? cnt : 1u;
}

__device__ __forceinline__ void xcd_barrier(const XcdBarrier& b) {
    asm volatile("s_waitcnt vmcnt(0)" ::: "memory");
    __syncthreads();
    if (threadIdx.x == 0) {
        unsigned* bar = b.bar;
        __builtin_amdgcn_s_waitcnt(0);
        unsigned nloc = b.st[0], nx = b.st[1];
        if (nloc == 0u) { xcd_barrier_complete(bar, b.x, nloc, nx); b.st[0] = nloc; b.st[1] = nx; }
        const unsigned old = xb_add(&bar[XB_XSUB(b.x)], 1u);
        const unsigned gen = old / nloc;
        if (old + 1u == (gen + 1u) * nloc) {
            __builtin_amdgcn_fence(__ATOMIC_RELEASE, "agent");
            asm volatile("s_waitcnt vmcnt(0)" ::: "memory");
            const unsigned og = xb_add(&bar[XB_TOP], 1u);
            const unsigned tg = og / nx;
            if (og + 1u == (tg + 1u) * nx) xb_add(&bar[XB_TOPGEN], 1u);
            else XB_SPIN(xb_ld(&bar[XB_TOPGEN]) == tg, bar);
            __builtin_amdgcn_fence(__ATOMIC_ACQUIRE, "agent");
            xb_add(&bar[XB_XGEN(b.x)], 1u);
            asm volatile("s_waitcnt vmcnt(0)" ::: "memory");
        } else {
            XB_SPIN(xb_ld(&bar[XB_XGEN(b.x)]) == gen, bar);
            __builtin_amdgcn_fence(__ATOMIC_ACQUIRE, "agent");
            asm volatile("s_waitcnt vmcnt(0)" ::: "memory");
        }
    }
    __syncthreads();
}

__global__ void __launch_bounds__(512, 2) mega_fwd(Params P) {
    extern __shared__ __attribute__((aligned(16))) unsigned char lds_raw[];
    LAS unsigned char* lds = (LAS unsigned char*)lds_raw;
    cg::grid_group grid = cg::this_grid();
    unsigned char* ws = P.ws;
    const float* mod = (const float*)(ws + WS_MOD);
    const int G = gridDim.x, bx = blockIdx.x;

    if (threadIdx.x == 0) { const unsigned r_ = atomicAdd((unsigned*)(ws + WS_XCNT) + xcc_id(), 1u); *(LAS unsigned*)(lds + LDS_RANK_OFF) = r_; }
    if (threadIdx.x == 0) { *(volatile LAS unsigned*)(lds + LDS_XB_OFF) = 0u; *(volatile LAS unsigned*)(lds + LDS_XB_OFF + 4) = 0u; }
    __syncthreads();
    (void)xcd_barrier_post((unsigned*)(ws + WS_XBAR), (volatile LAS unsigned*)(lds + LDS_XB_OFF));
#define GBAR() do { XcdBarrier xb_; xb_.bar = (unsigned*)(P.ws + WS_XBAR); xb_.x = xb_xcc_id(); xb_.st = (volatile LAS unsigned*)(lds + LDS_XB_OFF); xcd_barrier(xb_); } while (0)
    prologue(P, lds);
    grid.sync();
    row_pass<false>(P, TROWS, nullptr, nullptr, mod + 0 * 1024, mod + 1 * 1024, true, false);
    GBAR();
#pragma unroll 1
    for (int l = 0; l < 2; ++l) {
        GAS unsigned char* wsg_ = (GAS unsigned char*)ws; asm volatile("" : "+s"(wsg_)); unsigned char* wsl = (unsigned char*)wsg_;
        const float* modl = (const float*)(wsl + WS_MOD) + (size_t)l * 3 * NMODW;
        const unsigned char* wl = wsl + WS_W + (size_t)l * W_LAYER;
        float* xctx = (float*)(wsl + WS_XCTX); bf16_t* H = (bf16_t*)(wsl + WS_H); bf16_t* ACT = (bf16_t*)(wsl + WS_ACT); bf16_t* Z = (bf16_t*)(wsl + WS_Z); bf16_t* Y = (bf16_t*)(wsl + WS_Y);
        const int Mtail = (l == 1) ? NLAT : TROWS;
        const float* lng = P.in[6] + l * 3 * DM; const float* lnb = P.in[7] + l * 3 * DM;
#pragma unroll 1
        for (int f = 0; f < 2; ++f) {
            const int Mf = f == 0 ? TROWS : Mtail;
            { pg8::Gemm g{H, (const bf16_t*)(wl + (f == 0 ? W_GU1 : W_GU2)), Mf, 2 * DFF, DM}; pg8::StaticOrder S; S.init(Mf, 2 * DFF, G, bx);
              pg8::EpiSwiglu E{ACT, DFF};
              pg8::gemm_phase<pg8::EpiSwiglu, pg8::StaticOrder, true, true>(lds, g, S, E); }
            GBAR();
            { pg8::Gemm g{ACT, (const bf16_t*)(wl + (f == 0 ? W_DN1 : W_DN2)), Mf, DM, DFF}; pg8::StaticOrder S; S.init(Mf, DM, G, bx);
              const int pli = (f == 0) ? (l == 0 ? 0 : 2) : 1;
              const float* plg = (f == 0) ? P.in[6] + (l == 0 ? 0 : (l - 1) * 3 * DM) + pli * DM : lng + DM; const float* plb = (f == 0) ? P.in[7] + (l == 0 ? 0 : (l - 1) * 3 * DM) + pli * DM : lnb + DM;
              const bool first_ = (f == 0 && l == 0);
              pg8::EpiResid E{P.out, xctx, modl + (f == 0 ? 2 : 8) * 1024, 0.5f, first_ ? P.in[0] : (const float*)P.out, first_ ? P.in[2] : (const float*)xctx, (const float*)(wsl + WS_STATS), plg, plb, first_ ? 1 : 0};
              pg8::gemm_phase<pg8::EpiResid, pg8::StaticOrder, true, true>(lds, g, S, E); }
            GBAR();
            if (f == 0) {
                row_pass<true>(P, TROWS, lng, lnb, modl + 3 * 1024, modl + 4 * 1024, true, false);
                GBAR();
                { pg8::Gemm g{H, (const bf16_t*)(wl + W_IN), TROWS, INW, DM}; pg8::StaticOrder S; S.init(TROWS, INW, G, bx);
                  pg8::EpiBf16<0> E{Z, INW, nullptr, 0, 0, 1.f};
                  pg8::gemm_phase<pg8::EpiBf16<0>, pg8::StaticOrder, true, true>(lds, g, S, E); }
                GBAR();
                zpost_phase(P, lds, l);
                GBAR();
                attn_phase(P, lds, l);
                GBAR();
                { pg8::Gemm g{Y, (const bf16_t*)(wl + W_OUT), Mtail, DM, DM}; pg8::StaticOrder S; S.init(Mtail, DM, G, bx);
                  pg8::EpiResid E{P.out, xctx, modl + 5 * 1024, 1.0f, (const float*)P.out, (const float*)xctx, (const float*)(wsl + WS_STATS), lng, lnb, 0};
                  pg8::gemm_phase<pg8::EpiResid, pg8::StaticOrder, true, true>(lds, g, S, E); }
                GBAR();
                row_pass<true>(P, Mtail, lng + DM, lnb + DM, modl + 6 * 1024, modl + 7 * 1024, true, false);
                GBAR();
            } else {
                const bool last = (l == 1);
                row_pass<true>(P, Mtail, lng + 2 * DM, lnb + 2 * DM, modl + 3 * NMODW + 0 * 1024, modl + 3 * NMODW + 1 * 1024, !last, last);
                if (!last) GBAR();
            }
        }
    }
}

extern "C" void kernel_launch(void* const* d_in, const int* in_sizes, int n_in, void* d_out, int out_size, void* d_ws, size_t ws_size, hipStream_t stream) {
    static int grid = 0;
    if (grid == 0) {
        if (n_in != 23 || out_size != NLAT * DM || ws_size < WS_END) { fprintf(stderr, "kernel_launch: unexpected shapes (n_in %d out %d ws %zu, need %zu)\n", n_in, out_size, ws_size, (size_t)WS_END); grid = -1; return; }
        int dev = 0, cus = 0, per_cu = 0;
        if (hipGetDevice(&dev) != hipSuccess || hipDeviceGetAttribute(&cus, hipDeviceAttributeMultiprocessorCount, dev) != hipSuccess) { grid = -1; return; }
        if (hipFuncSetAttribute((const void*)mega_fwd, hipFuncAttributeMaxDynamicSharedMemorySize, LDS_BYTES) != hipSuccess) { fprintf(stderr, "kernel_launch: hipFuncSetAttribute failed\n"); grid = -1; return; }
        if (hipOccupancyMaxActiveBlocksPerMultiprocessor(&per_cu, (const void*)mega_fwd, 512, LDS_BYTES) != hipSuccess || per_cu < 1) { fprintf(stderr, "kernel_launch: occupancy query says %d\n", per_cu); per_cu = 1; }
        (void)hipGetLastError();
        grid = cus * per_cu;
    }
    if (grid < 0) return;
    Params p{};
    for (int i = 0; i < 23; ++i) p.in[i] = (const float*)d_in[i];
    p.out = (float*)d_out; p.ws = (unsigned char*)d_ws;
    (void)hipMemsetAsync((unsigned char*)d_ws + WS_XCNT, 0, 64 * 1024, stream);
    void* args[] = {&p};
    hipError_t e = hipLaunchCooperativeKernel((const void*)mega_fwd, dim3(grid), dim3(512), args, LDS_BYTES, stream);
    if (e != hipSuccess) fprintf(stderr, "kernel_launch: cooperative launch failed: %s (grid %d)\n", hipGetErrorString(e), grid);
}
```

```cpp
#include <hip/hip_runtime.h>
#include <hip/hip_cooperative_groups.h>
#include <cstdio>
#include <cstdint>
namespace cg = cooperative_groups;
namespace pg8 {
#define PG8_LAS __attribute__((address_space(3)))
typedef unsigned short bf16_t;
typedef short bf16x8 __attribute__((ext_vector_type(8)));
typedef float f32x4 __attribute__((ext_vector_type(4)));
typedef unsigned u32x4 __attribute__((ext_vector_type(4)));
constexpr int BM = 256, BK = 64, HALF = 128, HTB = HALF * BK * 2  , STAGE_BYTES = 8 * HTB, NXCD = 8, WGM = 8;

__host__ __device__ __forceinline__ int lds_byte(int r, int c) { const int st = (r >> 4) * 2 + (c >> 5), rr = r & 15, cc = c & 31, ob = rr * 64 + cc * 2; return st * 1024 + (ob ^ (((ob >> 9) & 1) << 5)); }
__host__ __device__ __forceinline__ void stage_rc(int b, int& R, int& C) { const int st = b / 1024, sb = b % 1024, swz = sb ^ (((sb >> 9) & 1) << 5); R = (st >> 1) * 16 + swz / 64; C = (st & 1) * 32 + (swz % 64) / 2; }
__host__ __device__ __forceinline__ int perm32(int rho) { const int n = rho >> 4, i = rho & 15; return 8 * (i >> 2) + 4 * n + (i & 3); }

struct Unit { int pm, pn; };
struct Gemm { const bf16_t* A; const bf16_t* Bt; int M, N, K; };

struct StaticOrder {
    int nM, nN, nwg, G, c;
    __host__ __device__ void init(int M, int N, int G_, int c_) { nM = M / BM; nN = N / BM; nwg = nM * nN; G = G_; c = c_; }
    __host__ __device__ bool next(int i, Unit& u) const {
        const long L = (long)i * G + c; if (L >= nwg) return false;
        int wgid = (int)L; { const int q = nwg / NXCD, r = nwg % NXCD, xcd = wgid % NXCD, off = wgid / NXCD; wgid = (xcd < r ? xcd * (q + 1) : r * (q + 1) + (xcd - r) * q) + off; }
        const int nig = WGM * nN, gid = wgid / nig, fm = gid * WGM, gsz = (nM - fm) < WGM ? (nM - fm) : WGM;
        u.pm = fm + ((wgid % nig) % gsz); u.pn = (wgid % nig) / gsz; return true;
    }
    __device__ __forceinline__ void a_ready(const Unit&) const {}
    __device__ __forceinline__ void done(const Unit&) const {}
};

__device__ __forceinline__ unsigned cvt_pk_bf16(float lo, float hi) { unsigned r; asm volatile("v_cvt_pk_bf16_f32 %0, %1, %2" : "=v"(r) : "v"(lo), "v"(hi)); return r; }
typedef float f32x2 __attribute__((ext_vector_type(2)));
__device__ __forceinline__ f32x2 gelu_pk(f32x2 v) {
    const f32x2 av = __builtin_elementwise_abs(v), d = av * 0.2316418882f + 1.0f;
    f32x2 t; t.x = __builtin_amdgcn_rcpf(d.x); t.y = __builtin_amdgcn_rcpf(d.y);
    f32x2 q = t * 0.5307027145f + (-0.7265760135f); q = q * t + 0.7107068705f; q = q * t + (-0.142248368f); q = q * t + 0.127414796f; q = q * t;
    const f32x2 s = (v * v) * (-0.72134752044f);
    f32x2 e; e.x = __builtin_amdgcn_exp2f(s.x); e.y = __builtin_amdgcn_exp2f(s.y);
    const f32x2 m = v * (q * e), r = v - m;
    f32x2 o; o.x = v.x < 0.f ? m.x : r.x; o.y = v.y < 0.f ? m.y : r.y; return o;
}

template <int ACT  > struct EpiBf16 {
    static constexpr bool PERM = true, AFTER_DRAIN = false; static_assert(ACT == 0 || ACT == 1, "EpiBf16: ACT is 0 (none) or 1 (gelu_pk)");
    bf16_t* O; int ldc; const float* bias; int split_cols; size_t split_stride; float scale0;
    __device__ __forceinline__ void operator()(const f32x4 (&acc)[2][2][4][2], const Unit& u, int wr, int wc, int fr, int fq) const {
        const int row0 = u.pm * BM + wr * 64 + fr; int colt = u.pn * BM; bf16_t* base = O;
        float sc = 1.f; if (split_cols) { const int t = colt / split_cols; base += (size_t)t * split_stride; colt -= t * split_cols; if (t == 0) sc = scale0; }
        const int col0 = colt + wc * 32 + 8 * fq, bcol0 = u.pn * BM + wc * 32 + 8 * fq;
        f32x4 bv[2][2];
#pragma unroll
        for (int bj = 0; bj < 2; ++bj)
#pragma unroll
            for (int n = 0; n < 2; ++n) bv[bj][n] = bias ? *(const f32x4*)(bias + bcol0 + bj * HALF + 4 * n) : (f32x4){0.f, 0.f, 0.f, 0.f};
#pragma unroll
        for (int ai = 0; ai < 2; ++ai)
#pragma unroll
            for (int m = 0; m < 4; ++m) { bf16_t* rowp = base + (size_t)(row0 + ai * HALF + m * 16) * ldc + col0;
#pragma unroll
                for (int bj = 0; bj < 2; ++bj) { f32x4 v0 = acc[ai][bj][m][0] + bv[bj][0], v1 = acc[ai][bj][m][1] + bv[bj][1];
                    if (ACT == 1) { f32x2 a = gelu_pk((f32x2){v0[0], v0[1]}), b = gelu_pk((f32x2){v0[2], v0[3]}), c = gelu_pk((f32x2){v1[0], v1[1]}), d = gelu_pk((f32x2){v1[2], v1[3]});
                        v0 = (f32x4){a.x, a.y, b.x, b.y}; v1 = (f32x4){c.x, c.y, d.x, d.y}; }
                    v0 = v0 * sc; v1 = v1 * sc; u32x4 w; w.x = cvt_pk_bf16(v0[0], v0[1]); w.y = cvt_pk_bf16(v0[2], v0[3]); w.z = cvt_pk_bf16(v1[0], v1[1]); w.w = cvt_pk_bf16(v1[2], v1[3]);
                    *(u32x4*)(rowp + bj * HALF) = w; } }
    }
};
struct EpiSwiglu {
    static constexpr bool PERM = true, AFTER_DRAIN = false;
    bf16_t* O; int ldc;
    __device__ __forceinline__ void operator()(const f32x4 (&acc)[2][2][4][2], const Unit& u, int wr, int wc, int fr, int fq) const {
        const int row0 = u.pm * BM + wr * 64 + fr; const int col0 = u.pn * HALF + wc * 32 + 8 * fq;
#pragma unroll
        for (int ai = 0; ai < 2; ++ai)
#pragma unroll
            for (int m = 0; m < 4; ++m) { bf16_t* rowp = O + (size_t)(row0 + ai * HALF + m * 16) * ldc + col0;
                float r[8];
#pragma unroll
                for (int n = 0; n < 2; ++n)
#pragma unroll
                    for (int e = 0; e < 4; ++e) { const float g = acc[ai][0][m][n][e], uu = acc[ai][1][m][n][e];
                        const float sg = __builtin_amdgcn_rcpf(1.0f + __builtin_amdgcn_exp2f(-1.4426950408889634f * g)); r[n * 4 + e] = g * sg * uu; }
                u32x4 w; w.x = cvt_pk_bf16(r[0], r[1]); w.y = cvt_pk_bf16(r[2], r[3]); w.z = cvt_pk_bf16(r[4], r[5]); w.w = cvt_pk_bf16(r[6], r[7]);
                *(u32x4*)rowp = w; }
    }
};
struct EpiResid {
    static constexpr bool PERM = true, AFTER_DRAIN = false;
    float* Xlat; float* Xctx; const float* gate; float coef;
    const float* Slat; const float* Sctx;
    const float* stats; const float* lg; const float* lb; int ident;
    __device__ __forceinline__ void operator()(const f32x4 (&acc)[2][2][4][2], const Unit& u, int wr, int wc, int fr, int fq) const {
        const int rowt = u.pm * BM; float* base; int set;
        const float* sbase;
        if (rowt < 32768) { base = Xlat + (size_t)rowt * 1024; sbase = Slat + (size_t)rowt * 1024; set = rowt >> 14; } else { base = Xctx + (size_t)(rowt - 32768) * 1024; sbase = Sctx + (size_t)(rowt - 32768) * 1024; set = 2; }
        const int col0 = u.pn * BM + wc * 32 + 8 * fq; const float* gp = gate + set * 9216 + col0;
        float mean[2][4], rstd[2][4];
#pragma unroll
        for (int ai = 0; ai < 2; ++ai)
#pragma unroll
            for (int m = 0; m < 4; ++m) { mean[ai][m] = 0.f; rstd[ai][m] = 1.f;
                if (!ident) { const f32x2 st = *(const f32x2*)(stats + 2 * (size_t)(rowt + wr * 64 + fr + ai * HALF + m * 16)); mean[ai][m] = st[0]; rstd[ai][m] = st[1]; } }
#pragma unroll
        for (int bj = 0; bj < 2; ++bj)
#pragma unroll
            for (int n = 0; n < 2; ++n) { const f32x4 gvv = *(const f32x4*)(gp + bj * HALF + 4 * n) * coef; f32x4 g4v, b4v;
                if (ident) { g4v = (f32x4){1.41421356237f, 1.41421356237f, 1.41421356237f, 1.41421356237f}; b4v = (f32x4){0.f, 0.f, 0.f, 0.f}; }
                else { g4v = *(const f32x4*)(lg + col0 + bj * HALF + 4 * n) * 1.41421356237f; b4v = *(const f32x4*)(lb + col0 + bj * HALF + 4 * n) * 1.41421356237f; }
#pragma unroll
                for (int ai = 0; ai < 2; ++ai)
#pragma unroll
                    for (int m = 0; m < 4; ++m) { const size_t eo_ = (size_t)(wr * 64 + fr + ai * HALF + m * 16) * 1024 + col0 + bj * HALF + 4 * n; f32x4* p = (f32x4*)(base + eo_); const f32x4 x = *(const f32x4*)(sbase + eo_);
                        *p = ((x - mean[ai][m]) * rstd[ai][m]) * g4v + b4v + gvv * acc[ai][bj][m][n]; } }
    }
};
template <class Epi, class Sched, bool ALIGN_EPI = false, bool SP2 = false>
__device__ __forceinline__ void gemm_phase(PG8_LAS unsigned char* lds, const Gemm g, const Sched& S, const Epi& E) {
    int tid_ = threadIdx.x; asm volatile("" : "+v"(tid_)); const int tid = tid_, wid = __builtin_amdgcn_readfirstlane(tid >> 6), lane = tid & 63, wr = wid >> 2, wc = wid & 3, fr = lane & 15, fq = lane >> 4;
    const int K = g.K, nt = K / BK;
    unsigned voffA[2], voffB[2];
#pragma unroll
    for (int i = 0; i < 2; ++i) { int R, C; stage_rc(tid * 16 + i * 8192, R, C); const int Rb = Epi::PERM ? ((R & ~31) + perm32(R & 31)) : R;
        voffA[i] = (unsigned)(R * K + C) * 2u; voffB[i] = (unsigned)(Rb * K + C) * 2u; }
    const size_t kstep = (size_t)(BK * 2);
    const size_t hstep = (size_t)HALF * K * 2;
    const size_t tstep = 2 * hstep;
    const unsigned ldsw = (unsigned)wid * 1024u;
    const int aoff = lds_byte(wr * 64 + fr, fq * 8), boff = lds_byte(wc * 32 + fr, fq * 8);
#define PG8_SA(b, h) (((b) * 2 + (h)) * HTB)
#define PG8_SB(b, h) ((4 + (b) * 2 + (h)) * HTB)
#define PG8_STAGE(bufoff, gbase, voff) do { _Pragma("unroll") for (int _i = 0; _i < 2; ++_i) \
        __builtin_amdgcn_global_load_lds((const unsigned*)((const char*)(gbase) + (voff)[_i]), (PG8_LAS unsigned*)(lds + (bufoff) + ldsw + _i * 8192), 16, 0, 0); } while (0)
#define PG8_LDA(dst, b, h) do { _Pragma("unroll") for (int m = 0; m < 4; ++m) _Pragma("unroll") for (int k = 0; k < 2; ++k) dst[m][k] = *(const PG8_LAS bf16x8*)(lds + PG8_SA(b, h) + aoff + m * 2048 + k * 1024); } while (0)
#define PG8_LDB(dst, b, h) do { _Pragma("unroll") for (int n = 0; n < 2; ++n) _Pragma("unroll") for (int k = 0; k < 2; ++k) dst[n][k] = *(const PG8_LAS bf16x8*)(lds + PG8_SB(b, h) + boff + n * 2048 + k * 1024); } while (0)
#define PG8_MMA(ai, bj, At, Bt) do { __builtin_amdgcn_s_setprio(1); _Pragma("unroll") for (int m = 0; m < 4; ++m) _Pragma("unroll") for (int n = 0; n < 2; ++n) _Pragma("unroll") for (int k = 0; k < 2; ++k) \
        acc[ai][bj][m][n] = __builtin_amdgcn_mfma_f32_16x16x32_bf16(Bt[n][k], At[m][k], acc[ai][bj][m][n], 0, 0, 0); __builtin_amdgcn_s_setprio(0); } while (0)
#define PG8_WAIT_V(n) asm volatile("s_waitcnt vmcnt(" #n ")" ::: "memory")
#define PG8_WAIT_L(n) asm volatile("s_waitcnt lgkmcnt(" #n ")" ::: "memory")
#define PG8_BAR __builtin_amdgcn_s_barrier()
#define PG8_SCHED __builtin_amdgcn_sched_barrier(0)
    Unit cur, nxt; int ui = 0;
    if (!S.next(0, cur)) return;
    f32x4 acc[2][2][4][2];
#pragma unroll
    for (int a = 0; a < 2; ++a)
#pragma unroll
        for (int b = 0; b < 2; ++b)
#pragma unroll
            for (int m = 0; m < 4; ++m)
#pragma unroll
                for (int n = 0; n < 2; ++n) acc[a][b][m][n] = (f32x4){0.f, 0.f, 0.f, 0.f};
    bf16x8 At[4][2], B0[2][2], B1[2][2];
    const char* cA = (const char*)g.A + (size_t)cur.pm * tstep; const char* cB = (const char*)g.Bt + (size_t)cur.pn * tstep;
    S.a_ready(cur);
    if constexpr (SP2) {
        PG8_STAGE(PG8_SB(0, 0), cB, voffB); PG8_STAGE(PG8_SB(0, 1), cB + hstep, voffB); PG8_STAGE(PG8_SA(0, 0), cA, voffA); PG8_STAGE(PG8_SA(0, 1), cA + hstep, voffA);
        if (wr == 1) PG8_BAR;
        PG8_WAIT_V(2); PG8_BAR;
        PG8_STAGE(PG8_SB(1, 0), cB + kstep, voffB); PG8_STAGE(PG8_SA(1, 0), cA + kstep, voffA); PG8_STAGE(PG8_SB(1, 1), cB + hstep + kstep, voffB);
        PG8_WAIT_V(6); PG8_BAR;
    } else {
        PG8_STAGE(PG8_SB(0, 0), cB, voffB); PG8_STAGE(PG8_SA(0, 0), cA, voffA); PG8_STAGE(PG8_SB(0, 1), cB + hstep, voffB); PG8_STAGE(PG8_SA(0, 1), cA + hstep, voffA);
        if (wr == 1) PG8_BAR;
        PG8_WAIT_V(4); PG8_BAR;
        PG8_STAGE(PG8_SB(1, 0), cB + kstep, voffB); PG8_STAGE(PG8_SA(1, 0), cA + kstep, voffA); PG8_STAGE(PG8_SB(1, 1), cB + hstep + kstep, voffB);
        PG8_WAIT_V(6); PG8_BAR;
    }
    for (;;) {
        const bool has_next = S.next(ui + 1, nxt);
        const char* nA = has_next ? (const char*)g.A + (size_t)nxt.pm * tstep : cA; const char* nB = has_next ? (const char*)g.Bt + (size_t)nxt.pn * tstep : cB;
        for (int t = 0; t < nt; t += 2) {
            const bool last = (t == nt - 2);
            const char* a1 = cA + (size_t)(t + 1) * kstep;
            const char* a2 = last ? nA : cA + (size_t)(t + 2) * kstep; const char* b2 = last ? nB : cB + (size_t)(t + 2) * kstep;
            const char* a3 = a2 + kstep; const char* b3 = b2 + kstep;
            if (last && has_next) S.a_ready(nxt);
            if constexpr (SP2) {
            PG8_LDB(B0, 0, 0); PG8_LDB(B1, 0, 1); PG8_SCHED; PG8_LDA(At, 0, 0); PG8_STAGE(PG8_SA(1, 1), a1 + hstep, voffA);
            PG8_WAIT_V(8); PG8_WAIT_L(0); PG8_BAR; PG8_MMA(0, 0, At, B0); PG8_MMA(0, 1, At, B1); PG8_BAR; PG8_SCHED;
            PG8_LDA(At, 0, 1); PG8_STAGE(PG8_SB(0, 0), b2, voffB); PG8_STAGE(PG8_SB(0, 1), b2 + hstep, voffB); PG8_STAGE(PG8_SA(0, 0), a2, voffA);
            PG8_WAIT_V(8); PG8_WAIT_L(0); PG8_BAR; PG8_MMA(1, 0, At, B0); PG8_MMA(1, 1, At, B1); PG8_BAR; PG8_SCHED;
            PG8_LDB(B0, 1, 0); PG8_LDB(B1, 1, 1); PG8_SCHED; PG8_LDA(At, 1, 0); PG8_STAGE(PG8_SA(0, 1), a2 + hstep, voffA);
            PG8_WAIT_V(8); PG8_WAIT_L(0); PG8_BAR; PG8_MMA(0, 0, At, B0); PG8_MMA(0, 1, At, B1); PG8_BAR; PG8_SCHED;
            PG8_LDA(At, 1, 1); PG8_STAGE(PG8_SB(1, 0), b3, voffB); PG8_STAGE(PG8_SB(1, 1), b3 + hstep, voffB); PG8_STAGE(PG8_SA(1, 0), a3, voffA);
            PG8_WAIT_V(8); PG8_WAIT_L(0); PG8_BAR; PG8_MMA(1, 0, At, B0); PG8_MMA(1, 1, At, B1); PG8_BAR; PG8_SCHED;
            } else {
            PG8_LDB(B0, 0, 0); PG8_SCHED; PG8_LDA(At, 0, 0); PG8_STAGE(PG8_SA(1, 1), a1 + hstep, voffA);
            PG8_WAIT_L(8); PG8_BAR; PG8_WAIT_L(0); PG8_MMA(0, 0, At, B0); PG8_BAR; PG8_SCHED;
            PG8_LDB(B1, 0, 1); PG8_STAGE(PG8_SB(0, 0), b2, voffB);
            PG8_BAR; PG8_WAIT_L(0); PG8_MMA(0, 1, At, B1); PG8_BAR;
            PG8_LDA(At, 0, 1); PG8_STAGE(PG8_SA(0, 0), a2, voffA);
            PG8_BAR; PG8_WAIT_L(0); PG8_MMA(1, 0, At, B0); PG8_BAR; PG8_SCHED;
            PG8_STAGE(PG8_SB(0, 1), b2 + hstep, voffB);
            PG8_WAIT_V(6); PG8_BAR; PG8_MMA(1, 1, At, B1); PG8_BAR;
            PG8_LDB(B0, 1, 0); PG8_SCHED; PG8_LDA(At, 1, 0); PG8_STAGE(PG8_SA(0, 1), a2 + hstep, voffA);
            PG8_WAIT_L(8); PG8_BAR; PG8_WAIT_L(0); PG8_MMA(0, 0, At, B0); PG8_BAR; PG8_SCHED;
            PG8_LDB(B1, 1, 1); PG8_STAGE(PG8_SB(1, 0), b3, voffB);
            PG8_BAR; PG8_WAIT_L(0); PG8_MMA(0, 1, At, B1); PG8_BAR;
            PG8_LDA(At, 1, 1); PG8_STAGE(PG8_SA(1, 0), a3, voffA);
            PG8_BAR; PG8_WAIT_L(0); PG8_MMA(1, 0, At, B0); PG8_BAR; PG8_SCHED;
            PG8_STAGE(PG8_SB(1, 1), b3 + hstep, voffB);
            PG8_WAIT_V(6); PG8_BAR; PG8_MMA(1, 1, At, B1); PG8_BAR;
            }
        }
        if constexpr (ALIGN_EPI) { if (wr == 0) PG8_BAR; }
        if constexpr (!Epi::AFTER_DRAIN) { E(acc, cur, wr, wc, fr, fq); S.done(cur); }
        if (!has_next) break;
#pragma unroll
        for (int a = 0; a < 2; ++a)
#pragma unroll
            for (int b = 0; b < 2; ++b)
#pragma unroll
                for (int m = 0; m < 4; ++m)
#pragma unroll
                    for (int n = 0; n < 2; ++n) acc[a][b][m][n] = (f32x4){0.f, 0.f, 0.f, 0.f};
        cur = nxt; cA = nA; cB = nB; ++ui;
        if constexpr (ALIGN_EPI) { if (wr == 1) PG8_BAR; }
    }
    PG8_WAIT_V(0);
    if constexpr (!ALIGN_EPI) { if (wr == 0) PG8_BAR; }
    PG8_BAR;
    if constexpr (Epi::AFTER_DRAIN) { E.fused(acc, cur, wr, wc, fr, fq, lds, wid, lane); S.done(cur); }
#undef PG8_SA
#undef PG8_SB
#undef PG8_STAGE
#undef PG8_LDA
#undef PG8_LDB
#undef PG8_MMA
#undef PG8_WAIT_V
#undef PG8_WAIT_L
#undef PG8_BAR
#undef PG8_SCHED
}
}

#define LAS __attribute__((address_space(3)))
#define GAS __attribute__((address_space(1)))
typedef unsigned short bf16_t;
typedef short bf16x8 __attribute__((ext_vector_type(8)));
typedef float f32x4 __attribute__((ext_vector_type(4)));
typedef float f32x16 __attribute__((ext_vector_type(16)));
typedef float f32x2 __attribute__((ext_vector_type(2)));
typedef unsigned u32x4 __attribute__((ext_vector_type(4)));
typedef unsigned u32x2 __attribute__((ext_vector_type(2)));
constexpr int DM = 1024, SEQ = 16384, CTXL = 256, NLAT = 32768, TROWS = 33280, NK = SEQ + CTXL, DFF = 2816, INW = 2560, NMODW = 9216;
constexpr size_t MiB = (size_t)1 << 20;
constexpr size_t WS_MOD = 0, WS_LAM = 512 * 1024, WS_STATS = 3 * 512 * 1024 + 1024 * 1024 * 0, WS_XCNT = 768 * 1024, WS_XBAR = 800 * 1024, WS_ROPE = 1 * MiB, WS_XCTX = 2 * MiB, WS_W = 4 * MiB, WS_H = 84 * MiB, WS_BIG = 149 * MiB;
constexpr size_t W_GU1 = 0, W_DN1 = 11534336, W_IN = 17301504, W_OUT = 22544384, W_GU2 = 24641536, W_DN2 = 36175872, W_LAYER = 41943040;
constexpr size_t QU = 8519680;
constexpr size_t WS_ACT = WS_BIG, WS_Z = WS_BIG, WS_Y = WS_BIG + 163 * MiB, WS_QKV = WS_BIG + 228 * MiB;
constexpr size_t O_QA = 0, O_KA = 2 * QU, O_VAT = 4 * QU, O_QC = 6 * QU, O_KC = 8 * QU, O_VCT = 9 * QU, O_QD = 10 * QU, O_KD = 12 * QU, O_VDT = 13 * QU;
constexpr size_t WS_END = WS_QKV + 14 * QU;
constexpr int LDS_BYTES = 147456, LDS_RANK_OFF = 147440, LDS_XB_OFF = 147444;
constexpr float LOG2E = 1.4426950408889634f;
constexpr float QSCALE_A = 0.17677669529663687f * LOG2E;
constexpr float QSCALE_H = 0.125f * LOG2E;

struct Params { const float* in[23]; float* out; unsigned char* ws; };

__device__ __forceinline__ float bf2f(unsigned v) { return __uint_as_float(v << 16); }
typedef float f32x2_t __attribute__((ext_vector_type(2))); typedef __bf16 bf16x2_t __attribute__((ext_vector_type(2)));
__device__ __forceinline__ unsigned cvtpk(float lo, float hi) { f32x2_t v = {lo, hi}; bf16x2_t b = __builtin_convertvector(v, bf16x2_t); return __builtin_bit_cast(unsigned, b); }
__device__ __forceinline__ float wave_sum(float v) {
#pragma unroll
    for (int o = 1; o < 64; o <<= 1) v += __shfl_xor(v, o);
    return v;
}
__device__ __forceinline__ float xhalf_max(float v) { auto rr = __builtin_amdgcn_permlane32_swap(__float_as_uint(v), __float_as_uint(v), false, false); return fmaxf(__uint_as_float(rr[0]), __uint_as_float(rr[1])); }
__device__ __forceinline__ float xhalf_sum(float v) { auto rr = __builtin_amdgcn_permlane32_swap(__float_as_uint(v), __float_as_uint(v), false, false); return __uint_as_float(rr[0]) + __uint_as_float(rr[1]); }
__device__ __forceinline__ int crow(int r, int hi) { return (r & 3) + 8 * (r >> 2) + 4 * hi; }

__device__ __forceinline__ void transpose_item(const float* W, int K, int N, bf16_t* WT, bool gu, LAS float* scr, int item, int lane) {
    const int nblk = N / 32, kb = item / nblk, nb = item % nblk, k0 = 64 * kb, n0 = 32 * nb;
    int rbase = n0;
    if (gu) { const int half = n0 >= DFF ? 1 : 0, j0 = n0 - half * DFF; rbase = (j0 >> 7) * 256 + half * 128 + (j0 & 127); }
#pragma unroll 8
    for (int i = 0; i < 32; ++i) { const int kk = 2 * i + (lane >> 5); scr[kk * 33 + (lane & 31)] = W[(size_t)(k0 + kk) * N + n0 + (lane & 31)]; }
    asm volatile("s_waitcnt lgkmcnt(0)" ::: "memory");
    const int c = lane & 7;
#pragma unroll
    for (int j = 0; j < 4; ++j) { const int n = (lane >> 3) + 8 * j; const LAS float* s = scr + (8 * c) * 33 + n;
        u32x4 o; o.x = cvtpk(s[0 * 33], s[1 * 33]); o.y = cvtpk(s[2 * 33], s[3 * 33]); o.z = cvtpk(s[4 * 33], s[5 * 33]); o.w = cvtpk(s[6 * 33], s[7 * 33]);
        *(u32x4*)(WT + (size_t)(rbase + n) * K + k0 + 8 * c) = o; }
    asm volatile("s_waitcnt lgkmcnt(0)" ::: "memory");
}
__device__ __forceinline__ void dsincos(double a, float& c, float& s) {
    const double TWO_PI = 6.283185307179586476925286766559;
    const double k = __builtin_rint(a / TWO_PI); double r = a - k * TWO_PI;
    const double r2 = r * r; double tc = 1.0, ts = r, sc = 1.0, ss = r;
#pragma unroll 1
    for (int i = 1; i <= 16; ++i) { tc = -tc * r2 / (double)((2 * i - 1) * (2 * i)); ts = -ts * r2 / (double)((2 * i) * (2 * i + 1)); sc += tc; ss += ts; }
    c = (float)sc; s = (float)ss;
}
__device__ __forceinline__ void prologue(const Params& P, LAS unsigned char* lds) {
    int tid_ = threadIdx.x; asm volatile("" : "+v"(tid_)); const int tid = tid_, lane = tid & 63, wave = __builtin_amdgcn_readfirstlane(tid >> 6);
    GAS unsigned char* wsg_ = (GAS unsigned char*)P.ws; asm volatile("" : "+s"(wsg_)); unsigned char* ws = (unsigned char*)wsg_;
    LAS float* sv = (LAS float*)(lds + 69632); LAS float* red = sv + 3072;
    for (int k = tid; k < 3072; k += 512) { const int s = k >> 10, kk = k & 1023; const float c = s < 2 ? P.in[1][s * 1024 + kk] : P.in[3][kk]; sv[k] = c / (1.0f + __expf(-c)); }
    __syncthreads();
    float* mod = (float*)(ws + WS_MOD);
    for (int it = blockIdx.x; it < 288; it += gridDim.x) {
        const int l = it / 144, n0 = (it % 144) * 64;
        const float* w = P.in[4] + (size_t)l * 1024 * NMODW + (size_t)(wave * 128) * NMODW + n0 + lane;
        float a0 = 0.f, a1 = 0.f, a2 = 0.f;
#pragma unroll 8
        for (int k = 0; k < 128; ++k) { const float wv = w[(size_t)k * NMODW]; const int kk = wave * 128 + k; a0 += sv[kk] * wv; a1 += sv[1024 + kk] * wv; a2 += sv[2048 + kk] * wv; }
        red[(wave * 3 + 0) * 64 + lane] = a0; red[(wave * 3 + 1) * 64 + lane] = a1; red[(wave * 3 + 2) * 64 + lane] = a2;
        __syncthreads();
        if (tid < 192) { const int s = tid >> 6, ln = tid & 63; float t = 0.f;
#pragma unroll
            for (int w8 = 0; w8 < 8; ++w8) t += red[(w8 * 3 + s) * 64 + ln];
            mod[(size_t)(l * 3 + s) * NMODW + n0 + ln] = t + P.in[5][l * NMODW + n0 + ln]; }
        __syncthreads();
    }
    { const int gt = blockIdx.x * 512 + tid; float* rope = (float*)(ws + WS_ROPE);
      if (gt < 6144) { const int pos = gt / 24, f = gt % 24; double inv;
          if (f < 8) { inv = 1.0; for (int i = 0; i < (f >> 1); ++i) inv *= 0.1; if (f & 1) inv *= 0.31622776601683794; }
          else { const int i4 = f - 8; inv = 1.0; for (int i = 0; i < (i4 >> 2); ++i) inv *= 0.1; const int rm = i4 & 3; inv *= (rm == 0 ? 1.0 : rm == 1 ? 0.5623413251903491 : rm == 2 ? 0.31622776601683794 : 0.1778279410038923); }
          const float invf = (float)inv; const float ang = (float)pos * invf; float c, s; dsincos((double)ang, c, s);
          if (f < 8) { rope[pos * 8 + f] = c; rope[2048 + pos * 8 + f] = s; } else { rope[4096 + pos * 16 + (f - 8)] = c; rope[8192 + pos * 16 + (f - 8)] = s; } }
      if (gt == 6144 || gt == 6145) { const int l = gt - 6144; float s1 = 0.f, s2 = 0.f;
          for (int i = 0; i < 32; ++i) { s1 += P.in[13][l * 32 + i] * P.in[14][l * 32 + i]; s2 += P.in[15][l * 32 + i] * P.in[16][l * 32 + i]; }
          const float li = l == 0 ? 0.2f : 0.35550906759097f; ((float*)(ws + WS_LAM))[l] = expf(s1) - expf(s2) + li; } }
    { LAS float* scr = (LAS float*)(lds + wave * 8448);
      const int gw = blockIdx.x * 8 + wave, NGW = gridDim.x * 8;
      constexpr int I_GU = 16 * 176, I_DN = 44 * 32, I_IN = 16 * 80, I_OUT = 16 * 32, I_LAYER = 2 * I_GU + 2 * I_DN + I_IN + I_OUT;
      for (int it = gw; it < 2 * I_LAYER; it += NGW) {
          const int l = it / I_LAYER; int r = it % I_LAYER; unsigned char* wl = ws + WS_W + (size_t)l * W_LAYER;
          if (r < I_GU) { transpose_item(P.in[8] + (size_t)l * DM * 2 * DFF, DM, 2 * DFF, (bf16_t*)(wl + W_GU1), true, scr, r, lane); continue; } r -= I_GU;
          if (r < I_GU) { transpose_item(P.in[21] + (size_t)l * DM * 2 * DFF, DM, 2 * DFF, (bf16_t*)(wl + W_GU2), true, scr, r, lane); continue; } r -= I_GU;
          if (r < I_DN) { transpose_item(P.in[9] + (size_t)l * DFF * DM, DFF, DM, (bf16_t*)(wl + W_DN1), false, scr, r, lane); continue; } r -= I_DN;
          if (r < I_DN) { transpose_item(P.in[22] + (size_t)l * DFF * DM, DFF, DM, (bf16_t*)(wl + W_DN2), false, scr, r, lane); continue; } r -= I_DN;
          if (r < I_IN) { transpose_item(P.in[10] + (size_t)l * DM * INW, DM, INW, (bf16_t*)(wl + W_IN), false, scr, r, lane); continue; } r -= I_IN;
          transpose_item(P.in[11] + (size_t)l * DM * DM, DM, DM, (bf16_t*)(wl + W_OUT), false, scr, r, lane);
      } }
}

template <bool LN>
__device__ __forceinline__ void row_pass(const Params& P, int nrows, const float* gam, const float* bet, const float* shift0, const float* scale0, bool write_h, bool write_x) {
    int tid_ = threadIdx.x; asm volatile("" : "+v"(tid_)); const int tid = tid_, lane = tid & 63, wave = __builtin_amdgcn_readfirstlane(tid >> 6);
    const int gw = blockIdx.x * 8 + wave, NGW = gridDim.x * 8;
    GAS unsigned char* wsg_ = (GAS unsigned char*)P.ws; asm volatile("" : "+s"(wsg_)); unsigned char* ws = (unsigned char*)wsg_;
    float* xctx = (float*)(ws + WS_XCTX); bf16_t* H = (bf16_t*)(ws + WS_H); float* stats = (float*)(ws + WS_STATS);
    f32x4 sh[4], sc[4], g4[4], b4[4]; int curset = -1;
#pragma unroll
    for (int j = 0; j < 4; ++j) { sh[j] = (f32x4){0.f, 0.f, 0.f, 0.f}; sc[j] = sh[j]; g4[j] = sh[j]; b4[j] = sh[j]; }
    if (LN) {
#pragma unroll
        for (int j = 0; j < 4; ++j) { g4[j] = *(const f32x4*)(gam + 4 * lane + 256 * j); b4[j] = *(const f32x4*)(bet + 4 * lane + 256 * j); } }
    for (int r = gw; r < nrows; r += NGW) {
        const int set = r < SEQ ? 0 : (r < NLAT ? 1 : 2);
        if (write_h && set != curset) { curset = set;
#pragma unroll
            for (int j = 0; j < 4; ++j) { sh[j] = *(const f32x4*)(shift0 + set * NMODW + 4 * lane + 256 * j); sc[j] = *(const f32x4*)(scale0 + set * NMODW + 4 * lane + 256 * j); } }
        float* dst = r < NLAT ? P.out + (size_t)r * DM : xctx + (size_t)(r - NLAT) * DM;
        const float* src = LN ? dst : (r < NLAT ? P.in[0] + (size_t)r * DM : P.in[2] + (size_t)(r - NLAT) * DM);
        f32x4 v[4];
#pragma unroll
        for (int j = 0; j < 4; ++j) v[j] = *(const f32x4*)(src + 4 * lane + 256 * j);
        if (LN) {
            float s = 0.f;
#pragma unroll
            for (int j = 0; j < 4; ++j) s += (v[j][0] + v[j][1]) + (v[j][2] + v[j][3]);
            const float mean = wave_sum(s) * (1.0f / DM); float s2 = 0.f;
#pragma unroll
            for (int j = 0; j < 4; ++j) { v[j] = v[j] - mean; s2 += (v[j][0] * v[j][0] + v[j][1] * v[j][1]) + (v[j][2] * v[j][2] + v[j][3] * v[j][3]); }
            const float rstd = 1.0f / sqrtf(wave_sum(s2) * (1.0f / DM) + 1e-6f);
            if (!write_x && lane == 0) *(f32x2*)(stats + 2 * (size_t)r) = (f32x2){mean, rstd};
#pragma unroll
            for (int j = 0; j < 4; ++j) v[j] = v[j] * rstd * g4[j] + b4[j];
        }
        if (write_x) {
#pragma unroll
            for (int j = 0; j < 4; ++j) *(f32x4*)(dst + 4 * lane + 256 * j) = v[j]; }
        if (write_h) {
#pragma unroll
            for (int j = 0; j < 4; ++j) { const f32x4 h = v[j] * (sc[j] + 1.0f) + sh[j]; u32x2 o; o.x = cvtpk(h[0], h[1]); o.y = cvtpk(h[2], h[3]);
                *(u32x2*)(H + (size_t)r * DM + 4 * lane + 256 * j) = o; } }
    }
}

__device__ __forceinline__ void rope4(float (&v)[4], const float* ctab, const float* stab, bool odd, int xmask) {
    const f32x4 c = *(const f32x4*)ctab, s = *(const f32x4*)stab;
#pragma unroll
    for (int e = 0; e < 4; ++e) { const float p = __shfl_xor(v[e], xmask); v[e] = v[e] * c[e] + (odd ? p : -p) * s[e]; }
}
__device__ __forceinline__ void up4(const u32x2 raw, float (&v)[4]) { v[0] = bf2f(raw.x & 0xffffu); v[1] = bf2f(raw.x >> 16); v[2] = bf2f(raw.y & 0xffffu); v[3] = bf2f(raw.y >> 16); }
__device__ __forceinline__ void ld4(const bf16_t* p, float (&v)[4]) { const u32x2 raw = *(const u32x2*)p; v[0] = bf2f(raw.x & 0xffffu); v[1] = bf2f(raw.x >> 16); v[2] = bf2f(raw.y & 0xffffu); v[3] = bf2f(raw.y >> 16); }
__device__ __forceinline__ void st4(bf16_t* p, const float (&v)[4], float sc) { u32x2 o; o.x = cvtpk(v[0] * sc, v[1] * sc); o.y = cvtpk(v[2] * sc, v[3] * sc); *(u32x2*)p = o; }
__device__ __forceinline__ void st4lds(LAS bf16_t* p, const float (&v)[4]) { u32x2 o; o.x = cvtpk(v[0], v[1]); o.y = cvtpk(v[2], v[3]); *(LAS u32x2*)p = o; }

__device__ __forceinline__ void zpost_phase(const Params& P, LAS unsigned char* lds, int l) {
    int tid_ = threadIdx.x; asm volatile("" : "+v"(tid_)); const int tid = tid_, lane = tid & 63, wave = __builtin_amdgcn_readfirstlane(tid >> 6);
    GAS unsigned char* wsg_ = (GAS unsigned char*)P.ws; asm volatile("" : "+s"(wsg_)); unsigned char* ws = (unsigned char*)wsg_;
    const bf16_t* Z = (const bf16_t*)(ws + WS_Z); bf16_t* Y = (bf16_t*)(ws + WS_Y); unsigned char* qkv = ws + WS_QKV;
    bf16_t *QA = (bf16_t*)(qkv + O_QA), *KA = (bf16_t*)(qkv + O_KA), *VAT = (bf16_t*)(qkv + O_VAT), *QC = (bf16_t*)(qkv + O_QC), *KC = (bf16_t*)(qkv + O_KC), *VCT = (bf16_t*)(qkv + O_VCT),
           *QD = (bf16_t*)(qkv + O_QD), *KD = (bf16_t*)(qkv + O_KD), *VDT = (bf16_t*)(qkv + O_VDT);
    const float* rope = (const float*)(ws + WS_ROPE);
    const float* convw = P.in[12] + l * 768; const float* qnw = P.in[19] + l * 64; const float* knw = P.in[20] + l * 64;
    LAS bf16_t* vt = (LAS bf16_t*)lds;
    for (int u = blockIdx.x; u < 1040; u += gridDim.x) {
        const int b = u / 520, kt = u % 520, kk0 = kt * 32; const bool isctx = kt < 8;
        __syncthreads();
        for (int ii = 0; ii < 4; ++ii) {
            const int i = wave * 4 + ii, kk = kk0 + i;
            const int r = isctx ? NLAT + b * CTXL + kk : b * SEQ + kk - CTXL;
            const int t = kk - CTXL, prow = (t >> 6) & 255, pcol = t & 63;
            const bf16_t* z = Z + (size_t)r * INW;
            float v[4];
            const int lkk = lane & 31;
            const bool hasp_ = isctx ? (kk > 0) : (t > 0), hasn_ = isctx ? (kk < CTXL - 1) : (t < SEQ - 1);
            u32x2 zr[16];
            zr[0] = *(const u32x2*)(z + 4 * lane); zr[1] = *(const u32x2*)(z + 256 + 4 * lane); zr[2] = *(const u32x2*)(z + 512 + 4 * lane);
            zr[3] = *(const u32x2*)(z + 768 + 4 * lane); zr[4] = *(const u32x2*)(z + 1024 + 4 * lane); zr[5] = *(const u32x2*)(z + 1280 + 4 * lane);
            zr[6] = (u32x2){0u, 0u}; zr[7] = zr[6]; zr[8] = zr[6]; zr[9] = zr[6];
            if (hasp_) { zr[6] = *(const u32x2*)(z - INW + 1024 + 4 * lane); zr[7] = *(const u32x2*)(z - INW + 1280 + 4 * lane); }
            if (hasn_) { zr[8] = *(const u32x2*)(z + INW + 1024 + 4 * lane); zr[9] = *(const u32x2*)(z + INW + 1280 + 4 * lane); }
            zr[10] = *(const u32x2*)(z + 1536 + 4 * lane); zr[11] = *(const u32x2*)(z + 1792 + 4 * lkk); zr[12] = *(const u32x2*)(z + 1920 + 4 * lkk);
            zr[13] = *(const u32x2*)(z + 2048 + 4 * lane); zr[14] = *(const u32x2*)(z + 2304 + 4 * lkk); zr[15] = *(const u32x2*)(z + 2432 + 4 * lkk);
            { const int h = lane >> 4, c = (4 * lane) & 63, quarter = (lane & 7) >> 1, e0 = (lane & 1) * 4; const int pos = quarter < 2 ? prow : pcol;
              const float* ct = rope + pos * 8 + e0; const float* st = rope + 2048 + pos * 8 + e0;
              up4(zr[0], v); if (!isctx) rope4(v, ct, st, quarter & 1, 2);
              st4(QA + ((size_t)(b * 4 + h) * NK + kk) * 64 + c, v, QSCALE_A);
              up4(zr[1], v); if (!isctx) rope4(v, ct, st, quarter & 1, 2);
              st4(KA + ((size_t)(b * 4 + h) * NK + kk) * 64 + c, v, 1.0f);
              up4(zr[2], v); st4lds(vt + i * 520 + 4 * lane, v); }
            { const bool hasp = isctx ? (kk > 0) : (t > 0), hasn = isctx ? (kk < CTXL - 1) : (t < SEQ - 1);
              float gb[4], gc[4], uu[4], hm[4], hp[4]; up4(zr[3], gb); up4(zr[4], gc); up4(zr[5], uu);
#pragma unroll
              for (int e = 0; e < 4; ++e) { hm[e] = 0.f; hp[e] = 0.f; }
              if (hasp) { float a[4], c2[4]; up4(zr[6], a); up4(zr[7], c2);
#pragma unroll
                  for (int e = 0; e < 4; ++e) hm[e] = a[e] * c2[e]; }
              if (hasn) { float a[4], c2[4]; up4(zr[8], a); up4(zr[9], c2);
#pragma unroll
                  for (int e = 0; e < 4; ++e) hp[e] = a[e] * c2[e]; }
              const f32x4 w0 = *(const f32x4*)(convw + 4 * lane), w1 = *(const f32x4*)(convw + 256 + 4 * lane), w2 = *(const f32x4*)(convw + 512 + 4 * lane);
#pragma unroll
              for (int e = 0; e < 4; ++e) v[e] = gb[e] * (w0[e] * hm[e] + w1[e] * (gc[e] * uu[e]) + w2[e] * hp[e]);
              st4(Y + (size_t)r * DM + 256 + 4 * lane, v, 1.0f); }
            { const int hq = lane >> 4, c = (4 * lane) & 63, quarter = (lane & 15) >> 2, e0 = (lane & 3) * 4; const int pos = quarter < 2 ? prow : pcol;
              const float* ct = rope + 4096 + pos * 16 + e0; const float* st = rope + 8192 + pos * 16 + e0;
              const int lk = lane & 31, hk = lk >> 4;
              up4(zr[10], v); if (!isctx) rope4(v, ct, st, quarter & 1, 4);
              st4(QC + ((size_t)(b * 4 + hq) * NK + kk) * 64 + c, v, QSCALE_H);
              up4(zr[11], v); if (!isctx) rope4(v, ct, st, quarter & 1, 4);
              if (lane < 32) st4(KC + ((size_t)(b * 2 + hk) * NK + kk) * 64 + c, v, 1.0f);
              up4(zr[12], v); if (lane < 32) st4lds(vt + i * 520 + 256 + 4 * lk, v);
              up4(zr[13], v);
              { float ss = v[0] * v[0] + v[1] * v[1] + v[2] * v[2] + v[3] * v[3]; ss += __shfl_xor(ss, 1); ss += __shfl_xor(ss, 2); ss += __shfl_xor(ss, 4); ss += __shfl_xor(ss, 8);
                const float rs = 1.0f / sqrtf(ss * (1.0f / 64.0f) + 1e-6f); const f32x4 w = *(const f32x4*)(qnw + c);
#pragma unroll
                for (int e = 0; e < 4; ++e) v[e] = v[e] * rs * w[e]; }
              if (!isctx) rope4(v, ct, st, quarter & 1, 4);
              st4(QD + ((size_t)(b * 4 + hq) * NK + kk) * 64 + c, v, QSCALE_H);
              up4(zr[14], v);
              { float ss = v[0] * v[0] + v[1] * v[1] + v[2] * v[2] + v[3] * v[3]; ss += __shfl_xor(ss, 1); ss += __shfl_xor(ss, 2); ss += __shfl_xor(ss, 4); ss += __shfl_xor(ss, 8);
                const float rs = 1.0f / sqrtf(ss * (1.0f / 64.0f) + 1e-6f); const f32x4 w = *(const f32x4*)(knw + c);
#pragma unroll
                for (int e = 0; e < 4; ++e) v[e] = v[e] * rs * w[e]; }
              if (!isctx) rope4(v, ct, st, quarter & 1, 4);
              if (lane < 32) st4(KD + ((size_t)(b * 2 + hk) * NK + kk) * 64 + c, v, 1.0f);
              up4(zr[15], v); if (lane < 32) st4lds(vt + i * 520 + 384 + 4 * lk, v); }
        }
        __syncthreads();
#pragma unroll 2
        for (int it = 0; it < 4; ++it) { const int vc = it * 128 + (tid >> 2), g = tid & 3; bf16_t* dst;
          if (vc < 256) dst = VAT + ((size_t)(b * 4 + (vc >> 6)) * 64 + (vc & 63)) * NK;
          else if (vc < 384) dst = VCT + ((size_t)(b * 2 + ((vc - 256) >> 6)) * 64 + (vc & 63)) * NK;
          else dst = VDT + ((size_t)(b * 2 + ((vc - 384) >> 6)) * 64 + (vc & 63)) * NK;
          unsigned w[4];
#pragma unroll
          for (int i2 = 0; i2 < 4; ++i2) { const int ia = 2 * i2, ib = 2 * i2 + 1;
              const int ta = 16 * (g >> 1) + 8 * (ia >> 2) + 4 * (g & 1) + (ia & 3), tb = 16 * (g >> 1) + 8 * (ib >> 2) + 4 * (g & 1) + (ib & 3);
              w[i2] = (unsigned)vt[ta * 520 + vc] | ((unsigned)vt[tb * 520 + vc] << 16); }
          *(u32x4*)(dst + kk0 + 8 * g) = (u32x4){w[0], w[1], w[2], w[3]}; }
    }
}

__device__ __forceinline__ float fmax3(float a, float b, float c) { float r; asm("v_max3_f32 %0, %1, %2, %3" : "=v"(r) : "v"(a), "v"(b), "v"(c)); return r; }
__device__ __forceinline__ void g2_first(f32x16& acc, bf16x8 a, bf16x8 b, const f32x16& c, float& e0, float& e1, float& e2, float& e3, float p0, float p1, float p2, float p3) {
    asm volatile("s_nop 4\n\tv_mfma_f32_32x32x16_bf16 %0, %5, %6, %7\n\tv_exp_f32_e32 %1, %8\n\tv_exp_f32_e32 %2, %9\n\tv_exp_f32_e32 %3, %10\n\tv_exp_f32_e32 %4, %11\n\ts_nop 0"
                 : "=&v"(acc), "=&v"(e0), "=&v"(e1), "=&v"(e2), "=&v"(e3) : "v"(a), "v"(b), "v"(c), "v"(p0), "v"(p1), "v"(p2), "v"(p3)); }
__device__ __forceinline__ void g2_acc(f32x16& acc, bf16x8 a, bf16x8 b, float& e0, float& e1, float& e2, float& e3, float p0, float p1, float p2, float p3) {
    asm volatile("v_mfma_f32_32x32x16_bf16 %0, %5, %6, %0\n\tv_exp_f32_e32 %1, %7\n\tv_exp_f32_e32 %2, %8\n\tv_exp_f32_e32 %3, %9\n\tv_exp_f32_e32 %4, %10\n\ts_nop 0"
                 : "+v"(acc), "=&v"(e0), "=&v"(e1), "=&v"(e2), "=&v"(e3) : "v"(a), "v"(b), "v"(p0), "v"(p1), "v"(p2), "v"(p3)); }
__device__ __forceinline__ void g2_none(float& e0, float& e1, float& e2, float& e3, float p0, float p1, float p2, float p3) {
    asm volatile("v_exp_f32_e32 %0, %4\n\tv_exp_f32_e32 %1, %5\n\tv_exp_f32_e32 %2, %6\n\tv_exp_f32_e32 %3, %7\n\ts_nop 0"
                 : "=&v"(e0), "=&v"(e1), "=&v"(e2), "=&v"(e3) : "v"(p0), "v"(p1), "v"(p2), "v"(p3)); }
__device__ __forceinline__ bf16x8 pack8(const f32x16& e, int b) { const u32x4 t = (u32x4){cvtpk(e[b], e[b + 1]), cvtpk(e[b + 2], e[b + 3]), cvtpk(e[b + 4], e[b + 5]), cvtpk(e[b + 6], e[b + 7])}; return __builtin_bit_cast(bf16x8, t); }
__device__ __forceinline__ float sum4(const f32x16& e, int b) { return (e[b] + e[b + 1]) + (e[b + 2] + e[b + 3]); }
__device__ __forceinline__ void g1_a0(f32x16& o, bf16x8 vf, bf16x8 pw, float& ps, float a0, float a1, float a2, float a3) {
    asm volatile("s_nop 1\n\tv_mfma_f32_32x32x16_bf16 %0, %2, %3, %0\n\tv_add_f32_e32 %1, %1, %4\n\tv_add_f32_e32 %1, %1, %5\n\tv_add_f32_e32 %1, %1, %6\n\tv_add_f32_e32 %1, %1, %7"
                 : "+v"(o), "+v"(ps) : "v"(vf), "v"(pw), "v"(a0), "v"(a1), "v"(a2), "v"(a3)); }
__device__ __forceinline__ void g1_b0(f32x16& o, bf16x8 vf, bf16x8 pw, float& ps, float a0, float a1, float a2, float a3,
                                      unsigned& w0, unsigned& w1, unsigned& w2, unsigned& w3, float c0, float c1, float c2, float c3, float c4, float c5, float c6, float c7) {
    asm volatile("s_nop 1\n\tv_mfma_f32_32x32x16_bf16 %0, %6, %7, %0\n\tv_add_f32_e32 %1, %1, %8\n\tv_add_f32_e32 %1, %1, %9\n\tv_add_f32_e32 %1, %1, %10\n\tv_add_f32_e32 %1, %1, %11\n\t"
                 "v_cvt_pk_bf16_f32 %2, %12, %13\n\tv_cvt_pk_bf16_f32 %3, %14, %15\n\tv_cvt_pk_bf16_f32 %4, %16, %17\n\tv_cvt_pk_bf16_f32 %5, %18, %19"
                 : "+v"(o), "+v"(ps), "=&v"(w0), "=&v"(w1), "=&v"(w2), "=&v"(w3)
                 : "v"(vf), "v"(pw), "v"(a0), "v"(a1), "v"(a2), "v"(a3), "v"(c0), "v"(c1), "v"(c2), "v"(c3), "v"(c4), "v"(c5), "v"(c6), "v"(c7)); }
__device__ __forceinline__ void g1_a(f32x16& o, bf16x8 vf, bf16x8 pw, float& mx, float m0, float m1, float m2, float m3, float& ps, float a0, float a1, float a2, float a3) {
    asm volatile("s_nop 1\n\tv_mfma_f32_32x32x16_bf16 %0, %3, %4, %0\n\tv_max3_f32 %1, %1, %5, %6\n\tv_max3_f32 %1, %1, %7, %8\n\t"
                 "v_add_f32_e32 %2, %2, %9\n\tv_add_f32_e32 %2, %2, %10\n\tv_add_f32_e32 %2, %2, %11\n\tv_add_f32_e32 %2, %2, %12"
                 : "+v"(o), "+v"(mx), "+v"(ps) : "v"(vf), "v"(pw), "v"(m0), "v"(m1), "v"(m2), "v"(m3), "v"(a0), "v"(a1), "v"(a2), "v"(a3)); }
__device__ __forceinline__ void g1_b(f32x16& o, bf16x8 vf, bf16x8 pw, float& mx, float m0, float m1, float m2, float m3, float& ps, float a0, float a1, float a2, float a3,
                                     unsigned& w0, unsigned& w1, unsigned& w2, unsigned& w3, float c0, float c1, float c2, float c3, float c4, float c5, float c6, float c7) {
    asm volatile("s_nop 1\n\tv_mfma_f32_32x32x16_bf16 %0, %7, %8, %0\n\tv_max3_f32 %1, %1, %9, %10\n\tv_max3_f32 %1, %1, %11, %12\n\t"
                 "v_add_f32_e32 %2, %2, %13\n\tv_add_f32_e32 %2, %2, %14\n\tv_add_f32_e32 %2, %2, %15\n\tv_add_f32_e32 %2, %2, %16\n\t"
                 "v_cvt_pk_bf16_f32 %3, %17, %18\n\tv_cvt_pk_bf16_f32 %4, %19, %20\n\tv_cvt_pk_bf16_f32 %5, %21, %22\n\tv_cvt_pk_bf16_f32 %6, %23, %24"
                 : "+v"(o), "+v"(mx), "+v"(ps), "=&v"(w0), "=&v"(w1), "=&v"(w2), "=&v"(w3)
                 : "v"(vf), "v"(pw), "v"(m0), "v"(m1), "v"(m2), "v"(m3), "v"(a0), "v"(a1), "v"(a2), "v"(a3), "v"(c0), "v"(c1), "v"(c2), "v"(c3), "v"(c4), "v"(c5), "v"(c6), "v"(c7)); }
struct AttnPtrs { const bf16_t* Q; const bf16_t* K; const bf16_t* Vt; bf16_t* Y; const float* subw; const float* sink; float lam; float oml; };
template <int MODE>
__device__ __forceinline__ void attn_unit(LAS unsigned char* lds, const AttnPtrs& A, int b, int head, int qt) {
    int tid_ = threadIdx.x; asm volatile("" : "+v"(tid_)); const int tid = tid_, lane = tid & 63, r32 = lane & 31, hi = lane >> 5;
    const int wid = __builtin_amdgcn_readfirstlane(tid >> 6), sub = wid >> 2, rq = (wid & 3) * 32;
    constexpr int DQ = (MODE == 0) ? 32 : 64, NCH = DQ / 16, NKVH = (MODE == 0) ? 4 : 2;
    constexpr int KBUF = 9216, VBUF = 9216, VS0 = 4 * KBUF, XB0 = VS0 + 5 * VBUF;
    constexpr float THR = 8.0f;
    const int q0 = qt * 128;
    const int qhead = (MODE == 0) ? head : head * 2 + sub;
    const int doff = (MODE == 0) ? sub * 32 : 0;
    const bf16_t* Qrow = A.Q + ((size_t)(b * 4 + qhead) * NK + q0 + rq + r32) * 64 + doff;
    const bf16_t* Kb = A.K + (size_t)(b * NKVH + head) * NK * 64;
    const bf16_t* Vb = A.Vt + (size_t)(b * NKVH + head) * 64 * NK;
    bf16x8 qf[NCH];
#pragma unroll
    for (int j = 0; j < NCH; ++j) qf[j] = *(const bf16x8*)(Qrow + 16 * j + 8 * hi);
    int lo = 4, hit = 4;
    if (qt >= 2) { if (MODE == 1) { lo = (q0 - 128) >> 6; if (lo < 4) lo = 4; hit = (q0 + 256) >> 6; if (hit > 260) hit = 260; } else { hit = 260; } }
    const int nsteps = 4 + hit - lo;
#define ATT_TILE(s) ((s) < 4 ? (s) : lo + (s) - 4)
    const int srow = tid >> 3, sch = tid & 7;
    const bf16_t* kg = Kb + (size_t)srow * 64 + sch * 8;
    const bf16_t* vg = Vb + (size_t)srow * NK + sch * 8;
    const unsigned sofs = srow * 144 + sch * 16;
    LAS unsigned char* Ks = lds; LAS unsigned char* Vs = lds + VS0;
    const LAS unsigned char* kp0 = Ks + r32 * 144 + (doff + 8 * hi) * 2;
    const LAS unsigned char* vp0 = Vs + r32 * 144 + hi * 16;
    const int qrel = q0 + rq + r32;
    f32x16 negm, p0, p1, o0, o1;
#pragma unroll
    for (int r = 0; r < 16; ++r) { negm[r] = 0.f; o0[r] = 0.f; o1[r] = 0.f; }
    asm volatile("" : "+v"(negm));
#define ATT_QK(D0, D1, kbuf) do { const LAS unsigned char* kp_ = kp0 + (kbuf) * KBUF; \
        _Pragma("unroll") for (int j = 0; j < NCH; ++j) { const bf16x8 k0_ = *(const LAS bf16x8*)(kp_ + j * 32); const bf16x8 k1_ = *(const LAS bf16x8*)(kp_ + 32 * 144 + j * 32); \
            if (j == 0) { D0 = __builtin_amdgcn_mfma_f32_32x32x16_bf16(k0_, qf[0], negm, 0, 0, 0); D1 = __builtin_amdgcn_mfma_f32_32x32x16_bf16(k1_, qf[0], negm, 0, 0, 0); } \
            else { D0 = __builtin_amdgcn_mfma_f32_32x32x16_bf16(k0_, qf[j], D0, 0, 0, 0); D1 = __builtin_amdgcn_mfma_f32_32x32x16_bf16(k1_, qf[j], D1, 0, 0, 0); } } } while (0)
#define ATT_MASK(D0, D1, s) do { if (MODE == 1 && (s) >= 4) { asm volatile("s_nop 7\n\ts_nop 3" ::: "memory");     \
        const int db_ = (lo + (s) - 4) * 64 - qrel; \
        _Pragma("unroll") for (int r = 0; r < 16; ++r) { const int d0_ = db_ + crow(r, hi), d1_ = d0_ + 32; \
            if (d0_ > 128 || d0_ < -128) D0[r] = -1e30f; if (d1_ > 128 || d1_ < -128) D1[r] = -1e30f; } } } while (0)
#define ATT_LDK(s) (*(const u32x4*)(kg + (size_t)ATT_TILE(s) * 4096))
#define ATT_LDV(s) (*(const u32x4*)(vg + ATT_TILE(s) * 64))

    __syncthreads();
    u32x4 kqa = (u32x4){0u, 0u, 0u, 0u}, vqa = kqa, kqb = kqa, vqb = kqa;
    { const u32x4 k0r = ATT_LDK(0); const u32x4 v0r = ATT_LDV(0); const u32x4 k1r = ATT_LDK(1); const u32x4 k2r = ATT_LDK(2); const u32x4 v1r = ATT_LDV(1);
      kqb = ATT_LDK(3); vqb = ATT_LDV(2);
      *(LAS u32x4*)(Ks + sofs) = k0r; *(LAS u32x4*)(Vs + sofs) = v0r; *(LAS u32x4*)(Ks + KBUF + sofs) = k1r; *(LAS u32x4*)(Ks + 2 * KBUF + sofs) = k2r; *(LAS u32x4*)(Vs + VBUF + sofs) = v1r; }
    __syncthreads();
    f32x16 pb0, pb1;
    ATT_QK(p0, p1, 0);
    float m = 0.f, lsum = 0.f;
    int kb_cur = 0;
#define ATT_MAXUPD(S, P0, P1) do { \
        float mx = fmax3(fmax3(P0[0], P1[0], P0[1]), P1[1], P0[2]); \
        _Pragma("unroll") for (int r = 2; r < 14; r += 2) mx = fmax3(fmax3(mx, P1[r], P0[r + 1]), P1[r + 1], P0[r + 2]); \
        mx = fmax3(fmax3(mx, P1[14], P0[15]), P1[15], P1[15]); \
        mx = xhalf_max(mx); \
        if ((S) == 0 || __any(mx > THR)) { \
            const float dl = ((S) == 0) ? mx : fmaxf(mx, 0.f); \
            m += dl; \
            _Pragma("unroll") for (int r = 0; r < 16; ++r) { P0[r] -= dl; P1[r] -= dl; negm[r] = -m; } \
            asm volatile("" : "+v"(negm)); \
            if ((S) > 0) { const float f = __builtin_amdgcn_exp2f(-dl); lsum *= f; \
                _Pragma("unroll") for (int r = 0; r < 16; ++r) { o0[r] *= f; o1[r] *= f; } } \
        } } while (0)
#define ATT_EXPPACK(P0, P1, PW) do { \
        float ps = 0.f; \
        _Pragma("unroll") for (int r = 0; r < 16; ++r) { P0[r] = __builtin_amdgcn_exp2f(P0[r]); P1[r] = __builtin_amdgcn_exp2f(P1[r]); ps += P0[r] + P1[r]; } \
        lsum += ps; \
        { u32x4 t; \
          t.x = cvtpk(P0[0], P0[1]); t.y = cvtpk(P0[2], P0[3]); t.z = cvtpk(P0[4], P0[5]); t.w = cvtpk(P0[6], P0[7]); PW[0] = __builtin_bit_cast(bf16x8, t); \
          t.x = cvtpk(P0[8], P0[9]); t.y = cvtpk(P0[10], P0[11]); t.z = cvtpk(P0[12], P0[13]); t.w = cvtpk(P0[14], P0[15]); PW[1] = __builtin_bit_cast(bf16x8, t); \
          t.x = cvtpk(P1[0], P1[1]); t.y = cvtpk(P1[2], P1[3]); t.z = cvtpk(P1[4], P1[5]); t.w = cvtpk(P1[6], P1[7]); PW[2] = __builtin_bit_cast(bf16x8, t); \
          t.x = cvtpk(P1[8], P1[9]); t.y = cvtpk(P1[10], P1[11]); t.z = cvtpk(P1[12], P1[13]); t.w = cvtpk(P1[14], P1[15]); PW[3] = __builtin_bit_cast(bf16x8, t); } } while (0)
#define ATT_PV(PW, vslot) do { const LAS unsigned char* vp_ = vp0 + (vslot) * VBUF; \
        _Pragma("unroll") for (int c = 0; c < 4; ++c) { const bf16x8 v0_ = *(const LAS bf16x8*)(vp_ + c * 32); const bf16x8 v1_ = *(const LAS bf16x8*)(vp_ + 32 * 144 + c * 32); \
            o0 = __builtin_amdgcn_mfma_f32_32x32x16_bf16(v0_, PW[c], o0, 0, 0, 0); o1 = __builtin_amdgcn_mfma_f32_32x32x16_bf16(v1_, PW[c], o1, 0, 0, 0); } } while (0)
    bf16x8 pwk[4];
#pragma unroll
    for (int c = 0; c < 4; ++c) pwk[c] = (bf16x8){0, 0, 0, 0, 0, 0, 0, 0};
#define ATT_LDVF(VF, vslot) do { const LAS unsigned char* vp_ = vp0 + (vslot) * VBUF; \
        _Pragma("unroll") for (int c = 0; c < 4; ++c) { VF[2 * c] = *(const LAS bf16x8*)(vp_ + c * 32); VF[2 * c + 1] = *(const LAS bf16x8*)(vp_ + 32 * 144 + c * 32); } } while (0)
#define ATT_LDKF(KF, kslot) do { const LAS unsigned char* kp_ = kp0 + (kslot) * KBUF; \
        _Pragma("unroll") for (int j = 0; j < NCH; ++j) { KF[2 * j] = *(const LAS bf16x8*)(kp_ + j * 32); KF[2 * j + 1] = *(const LAS bf16x8*)(kp_ + 32 * 144 + j * 32); } } while (0)
#define ATT_PVF(VF, PW) do { \
        _Pragma("unroll") for (int c = 0; c < 4; ++c) { o0 = __builtin_amdgcn_mfma_f32_32x32x16_bf16(VF[2 * c], PW[c], o0, 0, 0, 0); o1 = __builtin_amdgcn_mfma_f32_32x32x16_bf16(VF[2 * c + 1], PW[c], o1, 0, 0, 0); } } while (0)
#define ATT_QKF(KF, D0, D1) do { \
        D0 = __builtin_amdgcn_mfma_f32_32x32x16_bf16(KF[0], qf[0], negm, 0, 0, 0); D1 = __builtin_amdgcn_mfma_f32_32x32x16_bf16(KF[1], qf[0], negm, 0, 0, 0); \
        _Pragma("unroll") for (int j = 1; j < NCH; ++j) { D0 = __builtin_amdgcn_mfma_f32_32x32x16_bf16(KF[2 * j], qf[j], D0, 0, 0, 0); D1 = __builtin_amdgcn_mfma_f32_32x32x16_bf16(KF[2 * j + 1], qf[j], D1, 0, 0, 0); } } while (0)
#define ATT_VV(P0, P1, i) ((i) < 16 ? P0[(i) & 15] : P1[(i) & 15])
#define ATT_MXOP(P0, P1, k) do { if ((k) == 0) mx_ = fmax3(P0[0], P0[1], P0[2]); else if ((k) == 15) mx_ = fmax3(mx_, P1[15], P1[15]); \
        else mx_ = fmax3(mx_, ATT_VV(P0, P1, 1 + 2 * (k)), ATT_VV(P0, P1, 2 + 2 * (k))); } while (0)
#define ATT_SB() __builtin_amdgcn_sched_barrier(0)
#define ATT_STEP(BAR, S, FIRST, CHK, P0, P1, N0, N1, KN, VN, KO, VO) do { \
        if (BAR) __syncthreads(); \
        const int kb_n1 = (kb_cur + 1) & 3; const int vb_prev = vb_cur == 0 ? 4 : vb_cur - 1; \
        { const int sk_ = (S) + 4 < nsteps ? (S) + 4 : nsteps - 1, sv_ = (S) + 3 < nsteps ? (S) + 3 : nsteps - 1;     \
          KN = ATT_LDK(sk_); VN = ATT_LDV(sv_); } \
        bf16x8 kf_[2 * NCH]; \
        float mx_; \
        if (!(FIRST)) { \
            if (BAR) { ATT_LDVF(vf_, vb_prev); }     \
            ATT_SB(); \
            __builtin_amdgcn_s_setprio(1); \
              \
            float ps_ = 0.f; mx_ = P0[0]; bf16x8 pwa_ = pack8(N0, 0), pwb_; unsigned w0_, w1_, w2_, w3_; \
            if (CHK) { \
            g1_a(o0, vf_[0], pwa_, mx_, P0[1], P0[2], P0[3], P0[4], ps_, N0[0], N0[1], N0[2], N0[3]); \
            g1_b(o1, vf_[1], pwa_, mx_, P0[5], P0[6], P0[7], P0[8], ps_, N0[4], N0[5], N0[6], N0[7], w0_, w1_, w2_, w3_, N0[8], N0[9], N0[10], N0[11], N0[12], N0[13], N0[14], N0[15]); \
            { const u32x4 t_ = (u32x4){w0_, w1_, w2_, w3_}; pwb_ = __builtin_bit_cast(bf16x8, t_); } \
            g1_a(o0, vf_[2], pwb_, mx_, P0[9], P0[10], P0[11], P0[12], ps_, N0[8], N0[9], N0[10], N0[11]); \
            g1_b(o1, vf_[3], pwb_, mx_, P0[13], P0[14], P0[15], P1[0], ps_, N0[12], N0[13], N0[14], N0[15], w0_, w1_, w2_, w3_, N1[0], N1[1], N1[2], N1[3], N1[4], N1[5], N1[6], N1[7]); \
            { const u32x4 t_ = (u32x4){w0_, w1_, w2_, w3_}; pwa_ = __builtin_bit_cast(bf16x8, t_); } \
            g1_a(o0, vf_[4], pwa_, mx_, P1[1], P1[2], P1[3], P1[4], ps_, N1[0], N1[1], N1[2], N1[3]); \
            g1_b(o1, vf_[5], pwa_, mx_, P1[5], P1[6], P1[7], P1[8], ps_, N1[4], N1[5], N1[6], N1[7], w0_, w1_, w2_, w3_, N1[8], N1[9], N1[10], N1[11], N1[12], N1[13], N1[14], N1[15]); \
            { const u32x4 t_ = (u32x4){w0_, w1_, w2_, w3_}; pwb_ = __builtin_bit_cast(bf16x8, t_); } \
            g1_a(o0, vf_[6], pwb_, mx_, P1[9], P1[10], P1[11], P1[12], ps_, N1[8], N1[9], N1[10], N1[11]); \
            g1_a(o1, vf_[7], pwb_, mx_, P1[13], P1[14], P1[15], P1[15], ps_, N1[12], N1[13], N1[14], N1[15]); \
            } else { \
            g1_a0(o0, vf_[0], pwa_, ps_, N0[0], N0[1], N0[2], N0[3]); \
            g1_b0(o1, vf_[1], pwa_, ps_, N0[4], N0[5], N0[6], N0[7], w0_, w1_, w2_, w3_, N0[8], N0[9], N0[10], N0[11], N0[12], N0[13], N0[14], N0[15]); \
            { const u32x4 t_ = (u32x4){w0_, w1_, w2_, w3_}; pwb_ = __builtin_bit_cast(bf16x8, t_); } \
            g1_a0(o0, vf_[2], pwb_, ps_, N0[8], N0[9], N0[10], N0[11]); \
            g1_b0(o1, vf_[3], pwb_, ps_, N0[12], N0[13], N0[14], N0[15], w0_, w1_, w2_, w3_, N1[0], N1[1], N1[2], N1[3], N1[4], N1[5], N1[6], N1[7]); \
            { const u32x4 t_ = (u32x4){w0_, w1_, w2_, w3_}; pwa_ = __builtin_bit_cast(bf16x8, t_); } \
            g1_a0(o0, vf_[4], pwa_, ps_, N1[0], N1[1], N1[2], N1[3]); \
            g1_b0(o1, vf_[5], pwa_, ps_, N1[4], N1[5], N1[6], N1[7], w0_, w1_, w2_, w3_, N1[8], N1[9], N1[10], N1[11], N1[12], N1[13], N1[14], N1[15]); \
            { const u32x4 t_ = (u32x4){w0_, w1_, w2_, w3_}; pwb_ = __builtin_bit_cast(bf16x8, t_); } \
            g1_a0(o0, vf_[6], pwb_, ps_, N1[8], N1[9], N1[10], N1[11]); \
            g1_a0(o1, vf_[7], pwb_, ps_, N1[12], N1[13], N1[14], N1[15]); \
            } \
            lsum += ps_; \
        } else { \
            _Pragma("unroll") for (int k = 0; k < 16; ++k) ATT_MXOP(P0, P1, k); \
        } \
        __builtin_amdgcn_s_setprio(0); \
        ATT_LDKF(kf_, kb_n1); \
        ATT_SB(); \
        if (CHK) { const float mx = xhalf_max(mx_); \
          if ((FIRST) || __any(mx > THR)) { \
            const float dl = (FIRST) ? mx : fmaxf(mx, 0.f); \
            m += dl; \
            _Pragma("unroll") for (int r = 0; r < 16; ++r) { P0[r] -= dl; P1[r] -= dl; negm[r] = -m; } \
            asm volatile("" : "+v"(negm)); \
            if (!(FIRST)) { asm volatile("s_nop 11" ::: "memory"); const float f = __builtin_amdgcn_exp2f(-dl); lsum *= f; \
                _Pragma("unroll") for (int r = 0; r < 16; ++r) { o0[r] *= f; o1[r] *= f; } } \
          } } \
        ATT_SB(); \
        { \
          _Pragma("unroll") for (int g = 0; g < 8; ++g) { \
            constexpr int GSTEP = 8 / (2 * NCH); \
            const float q0_ = g < 4 ? P0[(4 * g) & 15] : P1[(4 * g) & 15], q1_ = g < 4 ? P0[(4 * g + 1) & 15] : P1[(4 * g + 1) & 15], q2_ = g < 4 ? P0[(4 * g + 2) & 15] : P1[(4 * g + 2) & 15], q3_ = g < 4 ? P0[(4 * g + 3) & 15] : P1[(4 * g + 3) & 15]; \
            float e0, e1, e2, e3; \
            if ((g % GSTEP) == 0) { const int mi = g / GSTEP, j = mi >> 1; \
                if ((mi & 1) == 0) { if (j == 0) g2_first(N0, kf_[0], qf[0], negm, e0, e1, e2, e3, q0_, q1_, q2_, q3_); else g2_acc(N0, kf_[2 * j], qf[j], e0, e1, e2, e3, q0_, q1_, q2_, q3_); } \
                else { if (j == 0) g2_first(N1, kf_[1], qf[0], negm, e0, e1, e2, e3, q0_, q1_, q2_, q3_); else g2_acc(N1, kf_[2 * j + 1], qf[j], e0, e1, e2, e3, q0_, q1_, q2_, q3_); } } \
            else g2_none(e0, e1, e2, e3, q0_, q1_, q2_, q3_); \
            if (g < 4) { P0[(4 * g) & 15] = e0; P0[(4 * g + 1) & 15] = e1; P0[(4 * g + 2) & 15] = e2; P0[(4 * g + 3) & 15] = e3; } \
            else { P1[(4 * g) & 15] = e0; P1[(4 * g + 1) & 15] = e1; P1[(4 * g + 2) & 15] = e2; P1[(4 * g + 3) & 15] = e3; } \
            ATT_SB(); } } \
        ATT_MASK(N0, N1, (S) + 1); \
        *(LAS u32x4*)(Ks + ((kb_cur + 3) & 3) * KBUF + sofs) = KO; \
        *(LAS u32x4*)(Vs + (vb_cur >= 3 ? vb_cur - 3 : vb_cur + 2) * VBUF + sofs) = VO; \
        if (BAR) { ATT_LDVF(vf_, vb_cur); }     \
        kb_cur = kb_n1; vb_cur = vb_cur == 4 ? 0 : vb_cur + 1; } while (0)
    int vb_cur = 0;
    bf16x8 vf_[8];
    ATT_STEP(false, 0, true, true, p0, p1, pb0, pb1, kqa, vqa, kqb, vqb);
    int s = 1;
    for (; s + 15 < nsteps; s += 16) {
        ATT_STEP(true, s + 0, false, false, pb0, pb1, p0, p1, kqb, vqb, kqa, vqa);
        ATT_STEP(false, s + 1, false, false, p0, p1, pb0, pb1, kqa, vqa, kqb, vqb);
        ATT_STEP(true, s + 2, false, false, pb0, pb1, p0, p1, kqb, vqb, kqa, vqa);
        ATT_STEP(false, s + 3, false, false, p0, p1, pb0, pb1, kqa, vqa, kqb, vqb);
        ATT_STEP(true, s + 4, false, false, pb0, pb1, p0, p1, kqb, vqb, kqa, vqa);
        ATT_STEP(false, s + 5, false, false, p0, p1, pb0, pb1, kqa, vqa, kqb, vqb);
        ATT_STEP(true, s + 6, false, false, pb0, pb1, p0, p1, kqb, vqb, kqa, vqa);
        ATT_STEP(false, s + 7, false, false, p0, p1, pb0, pb1, kqa, vqa, kqb, vqb);
        ATT_STEP(true, s + 8, false, false, pb0, pb1, p0, p1, kqb, vqb, kqa, vqa);
        ATT_STEP(false, s + 9, false, false, p0, p1, pb0, pb1, kqa, vqa, kqb, vqb);
        ATT_STEP(true, s + 10, false, false, pb0, pb1, p0, p1, kqb, vqb, kqa, vqa);
        ATT_STEP(false, s + 11, false, false, p0, p1, pb0, pb1, kqa, vqa, kqb, vqb);
        ATT_STEP(true, s + 12, false, false, pb0, pb1, p0, p1, kqb, vqb, kqa, vqa);
        ATT_STEP(false, s + 13, false, false, p0, p1, pb0, pb1, kqa, vqa, kqb, vqb);
        ATT_STEP(true, s + 14, false, false, pb0, pb1, p0, p1, kqb, vqb, kqa, vqa);
        ATT_STEP(false, s + 15, false, true, p0, p1, pb0, pb1, kqa, vqa, kqb, vqb);
    }
    for (; s + 1 < nsteps; s += 2) {
        ATT_STEP(true, s, false, false, pb0, pb1, p0, p1, kqb, vqb, kqa, vqa);
        ATT_STEP(false, s + 1, false, true, p0, p1, pb0, pb1, kqa, vqa, kqb, vqb);
    }
    ATT_STEP(true, nsteps - 1, false, false, pb0, pb1, p0, p1, kqb, vqb, kqa, vqa);
    { bf16x8 vfl[8]; ATT_LDVF(vfl, (vb_cur == 0 ? 4 : vb_cur - 1));
      const bf16x8 w0 = pack8(pb0, 0), w1 = pack8(pb0, 8), w2 = pack8(pb1, 0), w3 = pack8(pb1, 8);
      o0 = __builtin_amdgcn_mfma_f32_32x32x16_bf16(vfl[0], w0, o0, 0, 0, 0); o1 = __builtin_amdgcn_mfma_f32_32x32x16_bf16(vfl[1], w0, o1, 0, 0, 0);
      o0 = __builtin_amdgcn_mfma_f32_32x32x16_bf16(vfl[2], w1, o0, 0, 0, 0); o1 = __builtin_amdgcn_mfma_f32_32x32x16_bf16(vfl[3], w1, o1, 0, 0, 0);
      o0 = __builtin_amdgcn_mfma_f32_32x32x16_bf16(vfl[4], w2, o0, 0, 0, 0); o1 = __builtin_amdgcn_mfma_f32_32x32x16_bf16(vfl[5], w2, o1, 0, 0, 0);
      o0 = __builtin_amdgcn_mfma_f32_32x32x16_bf16(vfl[6], w3, o0, 0, 0, 0); o1 = __builtin_amdgcn_mfma_f32_32x32x16_bf16(vfl[7], w3, o1, 0, 0, 0);
      lsum += ((sum4(pb0, 0) + sum4(pb0, 4)) + (sum4(pb0, 8) + sum4(pb0, 12))) + ((sum4(pb1, 0) + sum4(pb1, 4)) + (sum4(pb1, 8) + sum4(pb1, 12))); }
#undef ATT_MAXUPD
#undef ATT_VV
#undef ATT_MXOP
#undef ATT_SB
#undef ATT_LDVF
#undef ATT_LDKF
#undef ATT_PVF
#undef ATT_QKF
#undef ATT_EXPPACK
#undef ATT_PV
#undef ATT_STEP
#undef ATT_LDK
#undef ATT_LDV
#undef ATT_TILE
#undef ATT_QK
#undef ATT_MASK
    float lt = xhalf_sum(lsum);
    if (MODE == 1) lt += __builtin_amdgcn_exp2f(A.sink[qhead] * LOG2E - m);
    const float inv = 1.0f / lt;
#pragma unroll
    for (int r = 0; r < 16; ++r) { o0[r] *= inv; o1[r] *= inv; }
    const int qq = q0 + rq + r32;
    const size_t yrow = qq < CTXL ? (size_t)(NLAT + b * CTXL + qq) : (size_t)b * SEQ + (qq - CTXL);
    if (MODE == 0) {
        LAS float* xb = (LAS float*)(lds + XB0) + (wid & 3) * 2048;
        if (sub == 1) {
#pragma unroll
            for (int r = 0; r < 16; ++r) { xb[r * 64 + lane] = o0[r]; xb[(16 + r) * 64 + lane] = o1[r]; } }
        __syncthreads();
        if (sub == 0) { float ss = 0.f;
#pragma unroll
            for (int r = 0; r < 16; ++r) { o0[r] -= A.lam * xb[r * 64 + lane]; o1[r] -= A.lam * xb[(16 + r) * 64 + lane]; ss += o0[r] * o0[r] + o1[r] * o1[r]; }
            ss = xhalf_sum(ss); const float rs = A.oml / sqrtf(ss * (1.0f / 64.0f) + 1e-6f);
            bf16_t* yp = A.Y + yrow * DM + head * 64;
#pragma unroll
            for (int rg = 0; rg < 4; ++rg) { const int dv = 8 * rg + 4 * hi; const f32x4 w0 = *(const f32x4*)(A.subw + dv), w1 = *(const f32x4*)(A.subw + 32 + dv);
                u32x2 a, c2; a.x = cvtpk(o0[4 * rg] * rs * w0[0], o0[4 * rg + 1] * rs * w0[1]); a.y = cvtpk(o0[4 * rg + 2] * rs * w0[2], o0[4 * rg + 3] * rs * w0[3]);
                c2.x = cvtpk(o1[4 * rg] * rs * w1[0], o1[4 * rg + 1] * rs * w1[1]); c2.y = cvtpk(o1[4 * rg + 2] * rs * w1[2], o1[4 * rg + 3] * rs * w1[3]);
                *(u32x2*)(yp + dv) = a; *(u32x2*)(yp + 32 + dv) = c2; } }
    } else {
        bf16_t* yp = A.Y + yrow * DM + (MODE == 1 ? 512 : 768) + qhead * 64;
#pragma unroll
        for (int rg = 0; rg < 4; ++rg) { const int dv = 8 * rg + 4 * hi;
            u32x2 a, c2; a.x = cvtpk(o0[4 * rg], o0[4 * rg + 1]); a.y = cvtpk(o0[4 * rg + 2], o0[4 * rg + 3]);
            c2.x = cvtpk(o1[4 * rg], o1[4 * rg + 1]); c2.y = cvtpk(o1[4 * rg + 2], o1[4 * rg + 3]);
            *(u32x2*)(yp + dv) = a; *(u32x2*)(yp + 32 + dv) = c2; }
    }
}
__device__ __forceinline__ unsigned xcc_id() { return (unsigned)__builtin_amdgcn_s_getreg((3 << 11) | 20) & 0xFu; }
__device__ __forceinline__ void attn_phase(const Params& P, LAS unsigned char* lds, int l) {
    GAS unsigned char* wsg_ = (GAS unsigned char*)P.ws; asm volatile("" : "+s"(wsg_)); unsigned char* ws = (unsigned char*)wsg_;
    unsigned char* qkv = ws + WS_QKV; bf16_t* Y = (bf16_t*)(ws + WS_Y);
    const float lam = ((const float*)(ws + WS_LAM))[l]; const float oml = 1.0f - (l == 0 ? 0.2f : 0.35550906759097f);
    const float* subw = P.in[17] + l * 64; const float* sink = P.in[18] + l * 4;
    const unsigned* xcnt = (const unsigned*)(ws + WS_XCNT);
    const int myx = (int)xcc_id(); const int rank = __builtin_amdgcn_readfirstlane(*(const LAS int*)(lds + LDS_RANK_OFF));
    int nx = 0, vx = 0, nloc = 1;
    for (int j = 0; j < 16; ++j) { const int cj = (int)xcnt[j]; if (cj > 0) { if (j < myx) ++vx; ++nx; } if (j == myx) nloc = cj; }
    if (nx < 1) nx = 1; if (nloc < 1) nloc = 1;
    const int nlist = (l == 0) ? 260 : 256;
    for (int g = vx; g < 8; g += nx) {
        for (int i = rank; i < nlist; i += nloc) {
            int mode, b, head, qt;
            if (i < 128) { mode = 0; b = g >> 2; head = g & 3; qt = 2 + i; }
            else if (i < 192) { mode = 2; b = (g & 3) >> 1; head = g & 1; qt = 2 + 64 * (g >> 2) + (i - 128); }
            else if (i < 256) { mode = 1; b = (g & 3) >> 1; head = g & 1; qt = 2 + 64 * (g >> 2) + (i - 192); }
            else if (i < 258) { mode = 0; b = g >> 2; head = g & 3; qt = i - 256; }
            else if (i == 258) { mode = 2; b = (g & 3) >> 1; head = g & 1; qt = g >> 2; }
            else { mode = 1; b = (g & 3) >> 1; head = g & 1; qt = g >> 2; }
            if (mode == 0) { const AttnPtrs A{(const bf16_t*)(qkv + O_QA), (const bf16_t*)(qkv + O_KA), (const bf16_t*)(qkv + O_VAT), Y, subw, sink, lam, oml}; attn_unit<0>(lds, A, b, head, qt); }
            else if (mode == 1) { const AttnPtrs A{(const bf16_t*)(qkv + O_QC), (const bf16_t*)(qkv + O_KC), (const bf16_t*)(qkv + O_VCT), Y, subw, sink, lam, oml}; attn_unit<1>(lds, A, b, head, qt); }
            else { const AttnPtrs A{(const bf16_t*)(qkv + O_QD), (const bf16_t*)(qkv + O_KD), (const bf16_t*)(qkv + O_VDT), Y, subw, sink, lam, oml}; attn_unit<2>(lds, A, b, head, qt); }
        }
    }
}

#define XB_TMO      128
#define XB_XCNT(j)  (256  + 64 * (j))
#define XB_XSUB(j)  (1280 + 64 * (j))
#define XB_XGEN(j)  (2304 + 64 * (j))
#define XB_TOP      3328
#define XB_TOPGEN   3392
#define XCD_BAR_WORDS 3456
#define XB_SPIN_CAP (1u << 23)

__device__ __forceinline__ unsigned xb_ld(unsigned* p)              { return __hip_atomic_load(p, __ATOMIC_RELAXED, __HIP_MEMORY_SCOPE_AGENT); }
__device__ __forceinline__ unsigned xb_add(unsigned* p, unsigned v) { return __hip_atomic_fetch_add(p, v, __ATOMIC_RELAXED, __HIP_MEMORY_SCOPE_AGENT); }
__device__ __forceinline__ unsigned xb_xcc_id() { return (unsigned)__builtin_amdgcn_s_getreg((3 << 11) | 20) & 0xFu; }
#define XB_SPIN(cond, bar) do { unsigned _sp = 0; while (cond) { __builtin_amdgcn_s_sleep(1); \
    if ((++_sp & 255u) == 0u) { if (xb_ld(&(bar)[XB_TMO])) break; if (_sp > XB_SPIN_CAP) { atomicAdd(&(bar)[XB_TMO], 1u); break; } } } } while (0)

struct XcdBarrier {
    unsigned* bar; unsigned x;
    volatile LAS unsigned* st;
};

__device__ __forceinline__ XcdBarrier xcd_barrier_post(unsigned* bar, volatile LAS unsigned* st) {
    XcdBarrier b; b.bar = bar; b.x = xb_xcc_id(); b.st = st;
    if (threadIdx.x == 0) (void)xb_add(&bar[XB_XCNT(b.x)], 1u);
    return b;
}
__device__ __forceinline__ void xcd_barrier_complete(unsigned* bar, unsigned x, unsigned& nloc, unsigned& nx) {
    const unsigned G = gridDim.x * gridDim.y * gridDim.z;
    unsigned sum, cnt, mine, sp = 0u;
    for (;;) {
        sum = 0u; cnt = 0u; mine = 0u;
#pragma unroll
        for (unsigned j = 0; j < 16; ++j) { const unsigned c = xb_ld(&bar[XB_XCNT(j)]); sum += c; cnt += (c > 0u) ? 1u : 0u; mine = (j == x) ? c : mine; }
        if (sum == G) break;
        __builtin_amdgcn_s_sleep(1);
        if ((++sp & 255u) == 0u) { if (xb_ld(&bar[XB_TMO])) break; if (sp > XB_SPIN_CAP) { atomicAdd(&bar[XB_TMO], 1u); break; } }
    }
    nloc = mine > 0u ? mine : 1u; nx = cnt > 0u ? cnt : 1u;
}

__device__ __forceinline__ void xcd_barrier(const XcdBarrier& b) {
    asm volatile("s_waitcnt vmcnt(0)" ::: "memory");
    __syncthreads();
    if (threadIdx.x == 0) {
        unsigned* bar = b.bar;
        __builtin_amdgcn_s_waitcnt(0);
        unsigned nloc = b.st[0], nx = b.st[1];
        if (nloc == 0u) { xcd_barrier_complete(bar, b.x, nloc, nx); b.st[0] = nloc; b.st[1] = nx; }
        const unsigned old = xb_add(&bar[XB_XSUB(b.x)], 1u);
        const unsigned gen = old / nloc;
        if (old + 1u == (gen + 1u) * nloc) {
            __builtin_amdgcn_fence(__ATOMIC_RELEASE, "agent");
            asm volatile("s_waitcnt vmcnt(0)" ::: "memory");
            const unsigned og = xb_add(&bar[XB_TOP], 1u);
            const unsigned tg = og / nx;
            if (og + 1u == (tg + 1u) * nx) xb_add(&bar[XB_TOPGEN], 1u);
            else XB_SPIN(xb_ld(&bar[XB_TOPGEN]) == tg, bar);
            __builtin_amdgcn_fence(__ATOMIC_ACQUIRE, "agent");
            xb_add(&bar[XB_XGEN(b.x)], 1u);
            asm volatile("s_waitcnt vmcnt(0)" ::: "memory");
        } else {
            XB_SPIN(xb_ld(&bar[XB_XGEN(b.x)]) == gen, bar);
            __builtin_amdgcn_fence(__ATOMIC_ACQUIRE, "agent");
            asm volatile("s_waitcnt vmcnt(0)" ::: "memory");
        }
    }
    __syncthreads();
}

__global__ void __launch_bounds__(512, 2) mega_fwd(Params P) {
    extern __shared__ __attribute__((aligned(16))) unsigned char lds_raw[];
    LAS unsigned char* lds = (LAS unsigned char*)lds_raw;
    cg::grid_group grid = cg::this_grid();
    unsigned char* ws = P.ws;
    const float* mod = (const float*)(ws + WS_MOD);
    const int G = gridDim.x, bx = blockIdx.x;

    if (threadIdx.x == 0) { const unsigned r_ = atomicAdd((unsigned*)(ws + WS_XCNT) + xcc_id(), 1u); *(LAS unsigned*)(lds + LDS_RANK_OFF) = r_; }
    if (threadIdx.x == 0) { *(volatile LAS unsigned*)(lds + LDS_XB_OFF) = 0u; *(volatile LAS unsigned*)(lds + LDS_XB_OFF + 4) = 0u; }
    __syncthreads();
    (void)xcd_barrier_post((unsigned*)(ws + WS_XBAR), (volatile LAS unsigned*)(lds + LDS_XB_OFF));
#define GBAR() do { XcdBarrier xb_; xb_.bar = (unsigned*)(P.ws + WS_XBAR); xb_.x = xb_xcc_id(); xb_.st = (volatile LAS unsigned*)(lds + LDS_XB_OFF); xcd_barrier(xb_); } while (0)
    prologue(P, lds);
    grid.sync();
    row_pass<false>(P, TROWS, nullptr, nullptr, mod + 0 * 1024, mod + 1 * 1024, true, false);
    GBAR();
#pragma unroll 1
    for (int l = 0; l < 2; ++l) {
        GAS unsigned char* wsg_ = (GAS unsigned char*)ws; asm volatile("" : "+s"(wsg_)); unsigned char* wsl = (unsigned char*)wsg_;
        const float* modl = (const float*)(wsl + WS_MOD) + (size_t)l * 3 * NMODW;
        const unsigned char* wl = wsl + WS_W + (size_t)l * W_LAYER;
        float* xctx = (float*)(wsl + WS_XCTX); bf16_t* H = (bf16_t*)(wsl + WS_H); bf16_t* ACT = (bf16_t*)(wsl + WS_ACT); bf16_t* Z = (bf16_t*)(wsl + WS_Z); bf16_t* Y = (bf16_t*)(wsl + WS_Y);
        const int Mtail = (l == 1) ? NLAT : TROWS;
        const float* lng = P.in[6] + l * 3 * DM; const float* lnb = P.in[7] + l * 3 * DM;
#pragma unroll 1
        for (int f = 0; f < 2; ++f) {
            const int Mf = f == 0 ? TROWS : Mtail;
            { pg8::Gemm g{H, (const bf16_t*)(wl + (f == 0 ? W_GU1 : W_GU2)), Mf, 2 * DFF, DM}; pg8::StaticOrder S; S.init(Mf, 2 * DFF, G, bx);
              pg8::EpiSwiglu E{ACT, DFF};
              pg8::gemm_phase<pg8::EpiSwiglu, pg8::StaticOrder, true, true>(lds, g, S, E); }
            GBAR();
            { pg8::Gemm g{ACT, (const bf16_t*)(wl + (f == 0 ? W_DN1 : W_DN2)), Mf, DM, DFF}; pg8::StaticOrder S; S.init(Mf, DM, G, bx);
              const int pli = (f == 0) ? (l == 0 ? 0 : 2) : 1;
              const float* plg = (f == 0) ? P.in[6] + (l == 0 ? 0 : (l - 1) * 3 * DM) + pli * DM : lng + DM; const float* plb = (f == 0) ? P.in[7] + (l == 0 ? 0 : (l - 1) * 3 * DM) + pli * DM : lnb + DM;
              const bool first_ = (f == 0 && l == 0);
              pg8::EpiResid E{P.out, xctx, modl + (f == 0 ? 2 : 8) * 1024, 0.5f, first_ ? P.in[0] : (const float*)P.out, first_ ? P.in[2] : (const float*)xctx, (const float*)(wsl + WS_STATS), plg, plb, first_ ? 1 : 0};
              pg8::gemm_phase<pg8::EpiResid, pg8::StaticOrder, true, true>(lds, g, S, E); }
            GBAR();
            if (f == 0) {
                row_pass<true>(P, TROWS, lng, lnb, modl + 3 * 1024, modl + 4 * 1024, true, false);
                GBAR();
                { pg8::Gemm g{H, (const bf16_t*)(wl + W_IN), TROWS, INW, DM}; pg8::StaticOrder S; S.init(TROWS, INW, G, bx);
                  pg8::EpiBf16<0> E{Z, INW, nullptr, 0, 0, 1.f};
                  pg8::gemm_phase<pg8::EpiBf16<0>, pg8::StaticOrder, true, true>(lds, g, S, E); }
                GBAR();
                zpost_phase(P, lds, l);
                GBAR();
                attn_phase(P, lds, l);
                GBAR();
                { pg8::Gemm g{Y, (const bf16_t*)(wl + W_OUT), Mtail, DM, DM}; pg8::StaticOrder S; S.init(Mtail, DM, G, bx);
                  pg8::EpiResid E{P.out, xctx, modl + 5 * 1024, 1.0f, (const float*)P.out, (const float*)xctx, (const float*)(wsl + WS_STATS), lng, lnb, 0};
                  pg8::gemm_phase<pg8::EpiResid, pg8::StaticOrder, true, true>(lds, g, S, E); }
                GBAR();
                row_pass<true>(P, Mtail, lng + DM, lnb + DM, modl + 6 * 1024, modl + 7 * 1024, true, false);
                GBAR();
            } else {
                const bool last = (l == 1);
                row_pass<true>(P, Mtail, lng + 2 * DM, lnb + 2 * DM, modl + 3 * NMODW + 0 * 1024, modl + 3 * NMODW + 1 * 1024, !last, last);
                if (!last) GBAR();
            }
        }
    }
}

extern "C" void kernel_launch(void* const* d_in, const int* in_sizes, int n_in, void* d_out, int out_size, void* d_ws, size_t ws_size, hipStream_t stream) {
    static int grid = 0;
    if (grid == 0) {
        if (n_in != 23 || out_size != NLAT * DM || ws_size < WS_END) { fprintf(stderr, "kernel_launch: unexpected shapes (n_in %d out %d ws %zu, need %zu)\n", n_in, out_size, ws_size, (size_t)WS_END); grid = -1; return; }
        int dev = 0, cus = 0, per_cu = 0;
        if (hipGetDevice(&dev) != hipSuccess || hipDeviceGetAttribute(&cus, hipDeviceAttributeMultiprocessorCount, dev) != hipSuccess) { grid = -1; return; }
        if (hipFuncSetAttribute((const void*)mega_fwd, hipFuncAttributeMaxDynamicSharedMemorySize, LDS_BYTES) != hipSuccess) { fprintf(stderr, "kernel_launch: hipFuncSetAttribute failed\n"); grid = -1; return; }
        if (hipOccupancyMaxActiveBlocksPerMultiprocessor(&per_cu, (const void*)mega_fwd, 512, LDS_BYTES) != hipSuccess || per_cu < 1) { fprintf(stderr, "kernel_launch: occupancy query says %d\n", per_cu); per_cu = 1; }
        (void)hipGetLastError();
        grid = cus * per_cu;
    }
    if (grid < 0) return;
    Params p{};
    for (int i = 0; i < 23; ++i) p.in[i] = (const float*)d_in[i];
    p.out = (float*)d_out; p.ws = (unsigned char*)d_ws;
    (void)hipMemsetAsync((unsigned char*)d_ws + WS_XCNT, 0, 64 * 1024, stream);
    void* args[] = {&p};
    hipError_t e = hipLaunchCooperativeKernel((const void*)mega_fwd, dim3(grid), dim3(512), args, LDS_BYTES, stream);
    if (e != hipSuccess) fprintf(stderr, "kernel_launch: cooperative launch failed: %s (grid %d)\n", hipGetErrorString(e), grid);
}
```

```cpp
#include <hip/hip_runtime.h>
#include <hip/hip_cooperative_groups.h>
#include <cstdio>
#include <cstdint>
namespace cg = cooperative_groups;
namespace pg8 {
#define PG8_LAS __attribute__((address_space(3)))
typedef unsigned short bf16_t;
typedef short bf16x8 __attribute__((ext_vector_type(8)));
typedef float f32x4 __attribute__((ext_vector_type(4)));
typedef unsigned u32x4 __attribute__((ext_vector_type(4)));
constexpr int BM = 256, BK = 64, HALF = 128, HTB = HALF * BK * 2  , STAGE_BYTES = 8 * HTB, NXCD = 8, WGM = 8;

__host__ __device__ __forceinline__ int lds_byte(int r, int c) { const int st = (r >> 4) * 2 + (c >> 5), rr = r & 15, cc = c & 31, ob = rr * 64 + cc * 2; return st * 1024 + (ob ^ (((ob >> 9) & 1) << 5)); }
__host__ __device__ __forceinline__ void stage_rc(int b, int& R, int& C) { const int st = b / 1024, sb = b % 1024, swz = sb ^ (((sb >> 9) & 1) << 5); R = (st >> 1) * 16 + swz / 64; C = (st & 1) * 32 + (swz % 64) / 2; }
__host__ __device__ __forceinline__ int perm32(int rho) { const int n = rho >> 4, i = rho & 15; return 8 * (i >> 2) + 4 * n + (i & 3); }

struct Unit { int pm, pn; };
struct Gemm { const bf16_t* A; const bf16_t* Bt; int M, N, K; };

struct StaticOrder {
    int nM, nN, nwg, G, c;
    __host__ __device__ void init(int M, int N, int G_, int c_) { nM = M / BM; nN = N / BM; nwg = nM * nN; G = G_; c = c_; }
    __host__ __device__ bool next(int i, Unit& u) const {
        const long L = (long)i * G + c; if (L >= nwg) return false;
        int wgid = (int)L; { const int q = nwg / NXCD, r = nwg % NXCD, xcd = wgid % NXCD, off = wgid / NXCD; wgid = (xcd < r ? xcd * (q + 1) : r * (q + 1) + (xcd - r) * q) + off; }
        const int nig = WGM * nN, gid = wgid / nig, fm = gid * WGM, gsz = (nM - fm) < WGM ? (nM - fm) : WGM;
        u.pm = fm + ((wgid % nig) % gsz); u.pn = (wgid % nig) / gsz; return true;
    }
    __device__ __forceinline__ void a_ready(const Unit&) const {}
    __device__ __forceinline__ void done(const Unit&) const {}
};

__device__ __forceinline__ unsigned cvt_pk_bf16(float lo, float hi) { unsigned r; asm volatile("v_cvt_pk_bf16_f32 %0, %1, %2" : "=v"(r) : "v"(lo), "v"(hi)); return r; }
typedef float f32x2 __attribute__((ext_vector_type(2)));
__device__ __forceinline__ f32x2 gelu_pk(f32x2 v) {
    const f32x2 av = __builtin_elementwise_abs(v), d = av * 0.2316418882f + 1.0f;
    f32x2 t; t.x = __builtin_amdgcn_rcpf(d.x); t.y = __builtin_amdgcn_rcpf(d.y);
    f32x2 q = t * 0.5307027145f + (-0.7265760135f); q = q * t + 0.7107068705f; q = q * t + (-0.142248368f); q = q * t + 0.127414796f; q = q * t;
    const f32x2 s = (v * v) * (-0.72134752044f);
    f32x2 e; e.x = __builtin_amdgcn_exp2f(s.x); e.y = __builtin_amdgcn_exp2f(s.y);
    const f32x2 m = v * (q * e), r = v - m;
    f32x2 o; o.x = v.x < 0.f ? m.x : r.x; o.y = v.y < 0.f ? m.y : r.y; return o;
}

template <int ACT  > struct EpiBf16 {
    static constexpr bool PERM = true, AFTER_DRAIN = false; static_assert(ACT == 0 || ACT == 1, "EpiBf16: ACT is 0 (none) or 1 (gelu_pk)");
    bf16_t* O; int ldc; const float* bias; int split_cols; size_t split_stride; float scale0;
    __device__ __forceinline__ void operator()(const f32x4 (&acc)[2][2][4][2], const Unit& u, int wr, int wc, int fr, int fq) const {
        const int row0 = u.pm * BM + wr * 64 + fr; int colt = u.pn * BM; bf16_t* base = O;
        float sc = 1.f; if (split_cols) { const int t = colt / split_cols; base += (size_t)t * split_stride; colt -= t * split_cols; if (t == 0) sc = scale0; }
        const int col0 = colt + wc * 32 + 8 * fq, bcol0 = u.pn * BM + wc * 32 + 8 * fq;
        f32x4 bv[2][2];
#pragma unroll
        for (int bj = 0; bj < 2; ++bj)
#pragma unroll
            for (int n = 0; n < 2; ++n) bv[bj][n] = bias ? *(const f32x4*)(bias + bcol0 + bj * HALF + 4 * n) : (f32x4){0.f, 0.f, 0.f, 0.f};
#pragma unroll
        for (int ai = 0; ai < 2; ++ai)
#pragma unroll
            for (int m = 0; m < 4; ++m) { bf16_t* rowp = base + (size_t)(row0 + ai * HALF + m * 16) * ldc + col0;
#pragma unroll
                for (int bj = 0; bj < 2; ++bj) { f32x4 v0 = acc[ai][bj][m][0] + bv[bj][0], v1 = acc[ai][bj][m][1] + bv[bj][1];
                    if (ACT == 1) { f32x2 a = gelu_pk((f32x2){v0[0], v0[1]}), b = gelu_pk((f32x2){v0[2], v0[3]}), c = gelu_pk((f32x2){v1[0], v1[1]}), d = gelu_pk((f32x2){v1[2], v1[3]});
                        v0 = (f32x4){a.x, a.y, b.x, b.y}; v1 = (f32x4){c.x, c.y, d.x, d.y}; }
                    v0 = v0 * sc; v1 = v1 * sc; u32x4 w; w.x = cvt_pk_bf16(v0[0], v0[1]); w.y = cvt_pk_bf16(v0[2], v0[3]); w.z = cvt_pk_bf16(v1[0], v1[1]); w.w = cvt_pk_bf16(v1[2], v1[3]);
                    *(u32x4*)(rowp + bj * HALF) = w; } }
    }
};
struct EpiSwiglu {
    static constexpr bool PERM = true, AFTER_DRAIN = false;
    bf16_t* O; int ldc;
    __device__ __forceinline__ void operator()(const f32x4 (&acc)[2][2][4][2], const Unit& u, int wr, int wc, int fr, int fq) const {
        const int row0 = u.pm * BM + wr * 64 + fr; const int col0 = u.pn * HALF + wc * 32 + 8 * fq;
#pragma unroll
        for (int ai = 0; ai < 2; ++ai)
#pragma unroll
            for (int m = 0; m < 4; ++m) { bf16_t* rowp = O + (size_t)(row0 + ai * HALF + m * 16) * ldc + col0;
                float r[8];
#pragma unroll
                for (int n = 0; n < 2; ++n)
#pragma unroll
                    for (int e = 0; e < 4; ++e) { const float g = acc[ai][0][m][n][e], uu = acc[ai][1][m][n][e];
                        const float sg = __builtin_amdgcn_rcpf(1.0f + __builtin_amdgcn_exp2f(-1.4426950408889634f * g)); r[n * 4 + e] = g * sg * uu; }
                u32x4 w; w.x = cvt_pk_bf16(r[0], r[1]); w.y = cvt_pk_bf16(r[2], r[3]); w.z = cvt_pk_bf16(r[4], r[5]); w.w = cvt_pk_bf16(r[6], r[7]);
                *(u32x4*)rowp = w; }
    }
};
struct EpiResid {
    static constexpr bool PERM = true, AFTER_DRAIN = false;
    float* Xlat; float* Xctx; const float* gate; float coef;
    const float* Slat; const float* Sctx;
    const float* stats; const float* lg; const float* lb; int ident;
    __device__ __forceinline__ void operator()(const f32x4 (&acc)[2][2][4][2], const Unit& u, int wr, int wc, int fr, int fq) const {
        const int rowt = u.pm * BM; float* base; int set;
        const float* sbase;
        if (rowt < 32768) { base = Xlat + (size_t)rowt * 1024; sbase = Slat + (size_t)rowt * 1024; set = rowt >> 14; } else { base = Xctx + (size_t)(rowt - 32768) * 1024; sbase = Sctx + (size_t)(rowt - 32768) * 1024; set = 2; }
        const int col0 = u.pn * BM + wc * 32 + 8 * fq; const float* gp = gate + set * 9216 + col0;
        float mean[2][4], rstd[2][4];
#pragma unroll
        for (int ai = 0; ai < 2; ++ai)
#pragma unroll
            for (int m = 0; m < 4; ++m) { mean[ai][m] = 0.f; rstd[ai][m] = 1.f;
                if (!ident) { const f32x2 st = *(const f32x2*)(stats + 2 * (size_t)(rowt + wr * 64 + fr + ai * HALF + m * 16)); mean[ai][m] = st[0]; rstd[ai][m] = st[1]; } }
#pragma unroll
        for (int bj = 0; bj < 2; ++bj)
#pragma unroll
            for (int n = 0; n < 2; ++n) { const f32x4 gvv = *(const f32x4*)(gp + bj * HALF + 4 * n) * coef; f32x4 g4v, b4v;
                if (ident) { g4v = (f32x4){1.41421356237f, 1.41421356237f, 1.41421356237f, 1.41421356237f}; b4v = (f32x4){0.f, 0.f, 0.f, 0.f}; }
                else { g4v = *(const f32x4*)(lg + col0 + bj * HALF + 4 * n) * 1.41421356237f; b4v = *(const f32x4*)(lb + col0 + bj * HALF + 4 * n) * 1.41421356237f; }
#pragma unroll
                for (int ai = 0; ai < 2; ++ai)
#pragma unroll
                    for (int m = 0; m < 4; ++m) { const size_t eo_ = (size_t)(wr * 64 + fr + ai * HALF + m * 16) * 1024 + col0 + bj * HALF + 4 * n; f32x4* p = (f32x4*)(base + eo_); const f32x4 x = *(const f32x4*)(sbase + eo_);
                        *p = ((x - mean[ai][m]) * rstd[ai][m]) * g4v + b4v + gvv * acc[ai][bj][m][n]; } }
    }
};
template <class Epi, class Sched, bool ALIGN_EPI = false, bool SP2 = false>
__device__ __forceinline__ void gemm_phase(PG8_LAS unsigned char* lds, const Gemm g, const Sched& S, const Epi& E) {
    int tid_ = threadIdx.x; asm volatile("" : "+v"(tid_)); const int tid = tid_, wid = __builtin_amdgcn_readfirstlane(tid >> 6), lane = tid & 63, wr = wid >> 2, wc = wid & 3, fr = lane & 15, fq = lane >> 4;
    const int K = g.K, nt = K / BK;
    unsigned voffA[2], voffB[2];
#pragma unroll
    for (int i = 0; i < 2; ++i) { int R, C; stage_rc(tid * 16 + i * 8192, R, C); const int Rb = Epi::PERM ? ((R & ~31) + perm32(R & 31)) : R;
        voffA[i] = (unsigned)(R * K + C) * 2u; voffB[i] = (unsigned)(Rb * K + C) * 2u; }
    const size_t kstep = (size_t)(BK * 2);
    const size_t hstep = (size_t)HALF * K * 2;
    const size_t tstep = 2 * hstep;
    const unsigned ldsw = (unsigned)wid * 1024u;
    const int aoff = lds_byte(wr * 64 + fr, fq * 8), boff = lds_byte(wc * 32 + fr, fq * 8);
#define PG8_SA(b, h) (((b) * 2 + (h)) * HTB)
#define PG8_SB(b, h) ((4 + (b) * 2 + (h)) * HTB)
#define PG8_STAGE(bufoff, gbase, voff) do { _Pragma("unroll") for (int _i = 0; _i < 2; ++_i) \
        __builtin_amdgcn_global_load_lds((const unsigned*)((const char*)(gbase) + (voff)[_i]), (PG8_LAS unsigned*)(lds + (bufoff) + ldsw + _i * 8192), 16, 0, 0); } while (0)
#define PG8_LDA(dst, b, h) do { _Pragma("unroll") for (int m = 0; m < 4; ++m) _Pragma("unroll") for (int k = 0; k < 2; ++k) dst[m][k] = *(const PG8_LAS bf16x8*)(lds + PG8_SA(b, h) + aoff + m * 2048 + k * 1024); } while (0)
#define PG8_LDB(dst, b, h) do { _Pragma("unroll") for (int n = 0; n < 2; ++n) _Pragma("unroll") for (int k = 0; k < 2; ++k) dst[n][k] = *(const PG8_LAS bf16x8*)(lds + PG8_SB(b, h) + boff + n * 2048 + k * 1024); } while (0)
#define PG8_MMA(ai, bj, At, Bt) do { __builtin_amdgcn_s_setprio(1); _Pragma("unroll") for (int m = 0; m < 4; ++m) _Pragma("unroll") for (int n = 0; n < 2; ++n) _Pragma("unroll") for (int k = 0; k < 2; ++k) \
        acc[ai][bj][m][n] = __builtin_amdgcn_mfma_f32_16x16x32_bf16(Bt[n][k], At[m][k], acc[ai][bj][m][n], 0, 0, 0); __builtin_amdgcn_s_setprio(0); } while (0)
#define PG8_WAIT_V(n) asm volatile("s_waitcnt vmcnt(" #n ")" ::: "memory")
#define PG8_WAIT_L(n) asm volatile("s_waitcnt lgkmcnt(" #n ")" ::: "memory")
#define PG8_BAR __builtin_amdgcn_s_barrier()
#define PG8_SCHED __builtin_amdgcn_sched_barrier(0)
    Unit cur, nxt; int ui = 0;
    if (!S.next(0, cur)) return;
    f32x4 acc[2][2][4][2];
#pragma unroll
    for (int a = 0; a < 2; ++a)
#pragma unroll
        for (int b = 0; b < 2; ++b)
#pragma unroll
            for (int m = 0; m < 4; ++m)
#pragma unroll
                for (int n = 0; n < 2; ++n) acc[a][b][m][n] = (f32x4){0.f, 0.f, 0.f, 0.f};
    bf16x8 At[4][2], B0[2][2], B1[2][2];
    const char* cA = (const char*)g.A + (size_t)cur.pm * tstep; const char* cB = (const char*)g.Bt + (size_t)cur.pn * tstep;
    S.a_ready(cur);
    if constexpr (SP2) {
        PG8_STAGE(PG8_SB(0, 0), cB, voffB); PG8_STAGE(PG8_SB(0, 1), cB + hstep, voffB); PG8_STAGE(PG8_SA(0, 0), cA, voffA); PG8_STAGE(PG8_SA(0, 1), cA + hstep, voffA);
        if (wr == 1) PG8_BAR;
        PG8_WAIT_V(2); PG8_BAR;
        PG8_STAGE(PG8_SB(1, 0), cB + kstep, voffB); PG8_STAGE(PG8_SA(1, 0), cA + kstep, voffA); PG8_STAGE(PG8_SB(1, 1), cB + hstep + kstep, voffB);
        PG8_WAIT_V(6); PG8_BAR;
    } else {
        PG8_STAGE(PG8_SB(0, 0), cB, voffB); PG8_STAGE(PG8_SA(0, 0), cA, voffA); PG8_STAGE(PG8_SB(0, 1), cB + hstep, voffB); PG8_STAGE(PG8_SA(0, 1), cA + hstep, voffA);
        if (wr == 1) PG8_BAR;
        PG8_WAIT_V(4); PG8_BAR;
        PG8_STAGE(PG8_SB(1, 0), cB + kstep, voffB); PG8_STAGE(PG8_SA(1, 0), cA + kstep, voffA); PG8_STAGE(PG8_SB(1, 1), cB + hstep + kstep, voffB);
        PG8_WAIT_V(6); PG8_BAR;
    }
    for (;;) {
        const bool has_next = S.next(ui + 1, nxt);
        const char* nA = has_next ? (const char*)g.A + (size_t)nxt.pm * tstep : cA; const char* nB = has_next ? (const char*)g.Bt + (size_t)nxt.pn * tstep : cB;
        for (int t = 0; t < nt; t += 2) {
            const bool last = (t == nt - 2);
            const char* a1 = cA + (size_t)(t + 1) * kstep;
            const char* a2 = last ? nA : cA + (size_t)(t + 2) * kstep; const char* b2 = last ? nB : cB + (size_t)(t + 2) * kstep;
            const char* a3 = a2 + kstep; const char* b3 = b2 + kstep;
            if (last && has_next) S.a_ready(nxt);
            if constexpr (SP2) {
            PG8_LDB(B0, 0, 0); PG8_LDB(B1, 0, 1); PG8_SCHED; PG8_LDA(At, 0, 0); PG8_STAGE(PG8_SA(1, 1), a1 + hstep, voffA);
            PG8_WAIT_V(8); PG8_WAIT_L(0); PG8_BAR; PG8_MMA(0, 0, At, B0); PG8_MMA(0, 1, At, B1); PG8_BAR; PG8_SCHED;
            PG8_LDA(At, 0, 1); PG8_STAGE(PG8_SB(0, 0), b2, voffB); PG8_STAGE(PG8_SB(0, 1), b2 + hstep, voffB); PG8_STAGE(PG8_SA(0, 0), a2, voffA);
            PG8_WAIT_V(8); PG8_WAIT_L(0); PG8_BAR; PG8_MMA(1, 0, At, B0); PG8_MMA(1, 1, At, B1); PG8_BAR; PG8_SCHED;
            PG8_LDB(B0, 1, 0); PG8_LDB(B1, 1, 1); PG8_SCHED; PG8_LDA(At, 1, 0); PG8_STAGE(PG8_SA(0, 1), a2 + hstep, voffA);
            PG8_WAIT_V(8); PG8_WAIT_L(0); PG8_BAR; PG8_MMA(0, 0, At, B0); PG8_MMA(0, 1, At, B1); PG8_BAR; PG8_SCHED;
            PG8_LDA(At, 1, 1); PG8_STAGE(PG8_SB(1, 0), b3, voffB); PG8_STAGE(PG8_SB(1, 1), b3 + hstep, voffB); PG8_STAGE(PG8_SA(1, 0), a3, voffA);
            PG8_WAIT_V(8); PG8_WAIT_L(0); PG8_BAR; PG8_MMA(1, 0, At, B0); PG8_MMA(1, 1, At, B1); PG8_BAR; PG8_SCHED;
            } else {
            PG8_LDB(B0, 0, 0); PG8_SCHED; PG8_LDA(At, 0, 0); PG8_STAGE(PG8_SA(1, 1), a1 + hstep, voffA);
            PG8_WAIT_L(8); PG8_BAR; PG8_WAIT_L(0); PG8_MMA(0, 0, At, B0); PG8_BAR; PG8_SCHED;
            PG8_LDB(B1, 0, 1); PG8_STAGE(PG8_SB(0, 0), b2, voffB);
            PG8_BAR; PG8_WAIT_L(0); PG8_MMA(0, 1, At, B1); PG8_BAR;
            PG8_LDA(At, 0, 1); PG8_STAGE(PG8_SA(0, 0), a2, voffA);
            PG8_BAR; PG8_WAIT_L(0); PG8_MMA(1, 0, At, B0); PG8_BAR; PG8_SCHED;
            PG8_STAGE(PG8_SB(0, 1), b2 + hstep, voffB);
            PG8_WAIT_V(6); PG8_BAR; PG8_MMA(1, 1, At, B1); PG8_BAR;
            PG8_LDB(B0, 1, 0); PG8_SCHED; PG8_LDA(At, 1, 0); PG8_STAGE(PG8_SA(0, 1), a2 + hstep, voffA);
            PG8_WAIT_L(8); PG8_BAR; PG8_WAIT_L(0); PG8_MMA(0, 0, At, B0); PG8_BAR; PG8_SCHED;
            PG8_LDB(B1, 1, 1); PG8_STAGE(PG8_SB(1, 0), b3, voffB);
            PG8_BAR; PG8_WAIT_L(0); PG8_MMA(0, 1, At, B1); PG8_BAR;
            PG8_LDA(At, 1, 1); PG8_STAGE(PG8_SA(1, 0), a3, voffA);
            PG8_BAR; PG8_WAIT_L(0); PG8_MMA(1, 0, At, B0); PG8_BAR; PG8_SCHED;
            PG8_STAGE(PG8_SB(1, 1), b3 + hstep, voffB);
            PG8_WAIT_V(6); PG8_BAR; PG8_MMA(1, 1, At, B1); PG8_BAR;
            }
        }
        if constexpr (ALIGN_EPI) { if (wr == 0) PG8_BAR; }
        if constexpr (!Epi::AFTER_DRAIN) { E(acc, cur, wr, wc, fr, fq); S.done(cur); }
        if (!has_next) break;
#pragma unroll
        for (int a = 0; a < 2; ++a)
#pragma unroll
            for (int b = 0; b < 2; ++b)
#pragma unroll
                for (int m = 0; m < 4; ++m)
#pragma unroll
                    for (int n = 0; n < 2; ++n) acc[a][b][m][n] = (f32x4){0.f, 0.f, 0.f, 0.f};
        cur = nxt; cA = nA; cB = nB; ++ui;
        if constexpr (ALIGN_EPI) { if (wr == 1) PG8_BAR; }
    }
    PG8_WAIT_V(0);
    if constexpr (!ALIGN_EPI) { if (wr == 0) PG8_BAR; }
    PG8_BAR;
    if constexpr (Epi::AFTER_DRAIN) { E.fused(acc, cur, wr, wc, fr, fq, lds, wid, lane); S.done(cur); }
#undef PG8_SA
#undef PG8_SB
#undef PG8_STAGE
#undef PG8_LDA
#undef PG8_LDB
#undef PG8_MMA
#undef PG8_WAIT_V
#undef PG8_WAIT_L
#undef PG8_BAR
#undef PG8_SCHED
}
}

#define LAS __attribute__((address_space(3)))
#define GAS __attribute__((address_space(1)))
typedef unsigned short bf16_t;
typedef short bf16x8 __attribute__((ext_vector_type(8)));
typedef float f32x4 __attribute__((ext_vector_type(4)));
typedef float f32x16 __attribute__((ext_vector_type(16)));
typedef float f32x2 __attribute__((ext_vector_type(2)));
typedef unsigned u32x4 __attribute__((ext_vector_type(4)));
typedef unsigned u32x2 __attribute__((ext_vector_type(2)));
constexpr int DM = 1024, SEQ = 16384, CTXL = 256, NLAT = 32768, TROWS = 33280, NK = SEQ + CTXL, DFF = 2816, INW = 2560, NMODW = 9216;
constexpr size_t MiB = (size_t)1 << 20;
constexpr size_t WS_MOD = 0, WS_LAM = 512 * 1024, WS_STATS = 3 * 512 * 1024 + 1024 * 1024 * 0, WS_XCNT = 768 * 1024, WS_XBAR = 800 * 1024, WS_ROPE = 1 * MiB, WS_XCTX = 2 * MiB, WS_W = 4 * MiB, WS_H = 84 * MiB, WS_BIG = 149 * MiB;
constexpr size_t W_GU1 = 0, W_DN1 = 11534336, W_IN = 17301504, W_OUT = 22544384, W_GU2 = 24641536, W_DN2 = 36175872, W_LAYER = 41943040;
constexpr size_t QU = 8519680;
constexpr size_t WS_ACT = WS_BIG, WS_Z = WS_BIG, WS_Y = WS_BIG + 163 * MiB, WS_QKV = WS_BIG + 228 * MiB;
constexpr size_t O_QA = 0, O_KA = 2 * QU, O_VAT = 4 * QU, O_QC = 6 * QU, O_KC = 8 * QU, O_VCT = 9 * QU, O_QD = 10 * QU, O_KD = 12 * QU, O_VDT = 13 * QU;
constexpr size_t WS_END = WS_QKV + 14 * QU;
constexpr int LDS_BYTES = 147456, LDS_RANK_OFF = 147440, LDS_XB_OFF = 147444;
constexpr float LOG2E = 1.4426950408889634f;
constexpr float QSCALE_A = 0.17677669529663687f * LOG2E;
constexpr float QSCALE_H = 0.125f * LOG2E;

struct Params { const float* in[23]; float* out; unsigned char* ws; };

__device__ __forceinline__ float bf2f(unsigned v) { return __uint_as_float(v << 16); }
typedef float f32x2_t __attribute__((ext_vector_type(2))); typedef __bf16 bf16x2_t __attribute__((ext_vector_type(2)));
__device__ __forceinline__ unsigned cvtpk(float lo, float hi) { f32x2_t v = {lo, hi}; bf16x2_t b = __builtin_convertvector(v, bf16x2_t); return __builtin_bit_cast(unsigned, b); }
__device__ __forceinline__ float wave_sum(float v) {
#pragma unroll
    for (int o = 1; o < 64; o <<= 1) v += __shfl_xor(v, o);
    return v;
}
__device__ __forceinline__ float xhalf_max(float v) { auto rr = __builtin_amdgcn_permlane32_swap(__float_as_uint(v), __float_as_uint(v), false, false); return fmaxf(__uint_as_float(rr[0]), __uint_as_float(rr[1])); }
__device__ __forceinline__ float xhalf_sum(float v) { auto rr = __builtin_amdgcn_permlane32_swap(__float_as_uint(v), __float_as_uint(v), false, false); return __uint_as_float(rr[0]) + __uint_as_float(rr[1]); }
__device__ __forceinline__ int crow(int r, int hi) { return (r & 3) + 8 * (r >> 2) + 4 * hi; }

__device__ __forceinline__ void transpose_item(const float* W, int K, int N, bf16_t* WT, bool gu, LAS float* scr, int item, int lane) {
    const int nblk = N / 32, kb = item / nblk, nb = item % nblk, k0 = 64 * kb, n0 = 32 * nb;
    int rbase = n0;
    if (gu) { const int half = n0 >= DFF ? 1 : 0, j0 = n0 - half * DFF; rbase = (j0 >> 7) * 256 + half * 128 + (j0 & 127); }
#pragma unroll 8
    for (int i = 0; i < 32; ++i) { const int kk = 2 * i + (lane >> 5); scr[kk * 33 + (lane & 31)] = W[(size_t)(k0 + kk) * N + n0 + (lane & 31)]; }
    asm volatile("s_waitcnt lgkmcnt(0)" ::: "memory");
    const int c = lane & 7;
#pragma unroll
    for (int j = 0; j < 4; ++j) { const int n = (lane >> 3) + 8 * j; const LAS float* s = scr + (8 * c) * 33 + n;
        u32x4 o; o.x = cvtpk(s[0 * 33], s[1 * 33]); o.y = cvtpk(s[2 * 33], s[3 * 33]); o.z = cvtpk(s[4 * 33], s[5 * 33]); o.w = cvtpk(s[6 * 33], s[7 * 33]);
        *(u32x4*)(WT + (size_t)(rbase + n) * K + k0 + 8 * c) = o; }
    asm volatile("s_waitcnt lgkmcnt(0)" ::: "memory");
}
__device__ __forceinline__ void dsincos(double a, float& c, float& s) {
    const double TWO_PI = 6.283185307179586476925286766559;
    const double k = __builtin_rint(a / TWO_PI); double r = a - k * TWO_PI;
    const double r2 = r * r; double tc = 1.0, ts = r, sc = 1.0, ss = r;
#pragma unroll 1
    for (int i = 1; i <= 16; ++i) { tc = -tc * r2 / (double)((2 * i - 1) * (2 * i)); ts = -ts * r2 / (double)((2 * i) * (2 * i + 1)); sc += tc; ss += ts; }
    c = (float)sc; s = (float)ss;
}
__device__ __forceinline__ void prologue(const Params& P, LAS unsigned char* lds) {
    int tid_ = threadIdx.x; asm volatile("" : "+v"(tid_)); const int tid = tid_, lane = tid & 63, wave = __builtin_amdgcn_readfirstlane(tid >> 6);
    GAS unsigned char* wsg_ = (GAS unsigned char*)P.ws; asm volatile("" : "+s"(wsg_)); unsigned char* ws = (unsigned char*)wsg_;
    LAS float* sv = (LAS float*)(lds + 69632); LAS float* red = sv + 3072;
    for (int k = tid; k < 3072; k += 512) { const int s = k >> 10, kk = k & 1023; const float c = s < 2 ? P.in[1][s * 1024 + kk] : P.in[3][kk]; sv[k] = c / (1.0f + __expf(-c)); }
    __syncthreads();
    float* mod = (float*)(ws + WS_MOD);
    for (int it = blockIdx.x; it < 288; it += gridDim.x) {
        const int l = it / 144, n0 = (it % 144) * 64;
        const float* w = P.in[4] + (size_t)l * 1024 * NMODW + (size_t)(wave * 128) * NMODW + n0 + lane;
        float a0 = 0.f, a1 = 0.f, a2 = 0.f;
#pragma unroll 8
        for (int k = 0; k < 128; ++k) { const float wv = w[(size_t)k * NMODW]; const int kk = wave * 128 + k; a0 += sv[kk] * wv; a1 += sv[1024 + kk] * wv; a2 += sv[2048 + kk] * wv; }
        red[(wave * 3 + 0) * 64 + lane] = a0; red[(wave * 3 + 1) * 64 + lane] = a1; red[(wave * 3 + 2) * 64 + lane] = a2;
        __syncthreads();
        if (tid < 192) { const int s = tid >> 6, ln = tid & 63; float t = 0.f;
#pragma unroll
            for (int w8 = 0; w8 < 8; ++w8) t += red[(w8 * 3 + s) * 64 + ln];
            mod[(size_t)(l * 3 + s) * NMODW + n0 + ln] = t + P.in[5][l * NMODW + n0 + ln]; }
        __syncthreads();
    }
    { const int gt = blockIdx.x * 512 + tid; float* rope = (float*)(ws + WS_ROPE);
      if (gt < 6144) { const int pos = gt / 24, f = gt % 24; double inv;
          if (f < 8) { inv = 1.0; for (int i = 0; i < (f >> 1); ++i) inv *= 0.1; if (f & 1) inv *= 0.31622776601683794; }
          else { const int i4 = f - 8; inv = 1.0; for (int i = 0; i < (i4 >> 2); ++i) inv *= 0.1; const int rm = i4 & 3; inv *= (rm == 0 ? 1.0 : rm == 1 ? 0.5623413251903491 : rm == 2 ? 0.31622776601683794 : 0.1778279410038923); }
          const float invf = (float)inv; const float ang = (float)pos * invf; float c, s; dsincos((double)ang, c, s);
          if (f < 8) { rope[pos * 8 + f] = c; rope[2048 + pos * 8 + f] = s; } else { rope[4096 + pos * 16 + (f - 8)] = c; rope[8192 + pos * 16 + (f - 8)] = s; } }
      if (gt == 6144 || gt == 6145) { const int l = gt - 6144; float s1 = 0.f, s2 = 0.f;
          for (int i = 0; i < 32; ++i) { s1 += P.in[13][l * 32 + i] * P.in[14][l * 32 + i]; s2 += P.in[15][l * 32 + i] * P.in[16][l * 32 + i]; }
          const float li = l == 0 ? 0.2f : 0.35550906759097f; ((float*)(ws + WS_LAM))[l] = expf(s1) - expf(s2) + li; } }
    { LAS float* scr = (LAS float*)(lds + wave * 8448);
      const int gw = blockIdx.x * 8 + wave, NGW = gridDim.x * 8;
      constexpr int I_GU = 16 * 176, I_DN = 44 * 32, I_IN = 16 * 80, I_OUT = 16 * 32, I_LAYER = 2 * I_GU + 2 * I_DN + I_IN + I_OUT;
      for (int it = gw; it < 2 * I_LAYER; it += NGW) {
          const int l = it / I_LAYER; int r = it % I_LAYER; unsigned char* wl = ws + WS_W + (size_t)l * W_LAYER;
          if (r < I_GU) { transpose_item(P.in[8] + (size_t)l * DM * 2 * DFF, DM, 2 * DFF, (bf16_t*)(wl + W_GU1), true, scr, r, lane); continue; } r -= I_GU;
          if (r < I_GU) { transpose_item(P.in[21] + (size_t)l * DM * 2 * DFF, DM, 2 * DFF, (bf16_t*)(wl + W_GU2), true, scr, r, lane); continue; } r -= I_GU;
          if (r < I_DN) { transpose_item(P.in[9] + (size_t)l * DFF * DM, DFF, DM, (bf16_t*)(wl + W_DN1), false, scr, r, lane); continue; } r -= I_DN;
          if (r < I_DN) { transpose_item(P.in[22] + (size_t)l * DFF * DM, DFF, DM, (bf16_t*)(wl + W_DN2), false, scr, r, lane); continue; } r -= I_DN;
          if (r < I_IN) { transpose_item(P.in[10] + (size_t)l * DM * INW, DM, INW, (bf16_t*)(wl + W_IN), false, scr, r, lane); continue; } r -= I_IN;
          transpose_item(P.in[11] + (size_t)l * DM * DM, DM, DM, (bf16_t*)(wl + W_OUT), false, scr, r, lane);
      } }
}

template <bool LN>
__device__ __forceinline__ void row_pass(const Params& P, int nrows, const float* gam, const float* bet, const float* shift0, const float* scale0, bool write_h, bool write_x) {
    int tid_ = threadIdx.x; asm volatile("" : "+v"(tid_)); const int tid = tid_, lane = tid & 63, wave = __builtin_amdgcn_readfirstlane(tid >> 6);
    const int gw = blockIdx.x * 8 + wave, NGW = gridDim.x * 8;
    GAS unsigned char* wsg_ = (GAS unsigned char*)P.ws; asm volatile("" : "+s"(wsg_)); unsigned char* ws = (unsigned char*)wsg_;
    float* xctx = (float*)(ws + WS_XCTX); bf16_t* H = (bf16_t*)(ws + WS_H); float* stats = (float*)(ws + WS_STATS);
    f32x4 sh[4], sc[4], g4[4], b4[4]; int curset = -1;
#pragma unroll
    for (int j = 0; j < 4; ++j) { sh[j] = (f32x4){0.f, 0.f, 0.f, 0.f}; sc[j] = sh[j]; g4[j] = sh[j]; b4[j] = sh[j]; }
    if (LN) {
#pragma unroll
        for (int j = 0; j < 4; ++j) { g4[j] = *(const f32x4*)(gam + 4 * lane + 256 * j); b4[j] = *(const f32x4*)(bet + 4 * lane + 256 * j); } }
    for (int r = gw; r < nrows; r += NGW) {
        const int set = r < SEQ ? 0 : (r < NLAT ? 1 : 2);
        if (write_h && set != curset) { curset = set;
#pragma unroll
            for (int j = 0; j < 4; ++j) { sh[j] = *(const f32x4*)(shift0 + set * NMODW + 4 * lane + 256 * j); sc[j] = *(const f32x4*)(scale0 + set * NMODW + 4 * lane + 256 * j); } }
        float* dst = r < NLAT ? P.out + (size_t)r * DM : xctx + (size_t)(r - NLAT) * DM;
        const float* src = LN ? dst : (r < NLAT ? P.in[0] + (size_t)r * DM : P.in[2] + (size_t)(r - NLAT) * DM);
        f32x4 v[4];
#pragma unroll
        for (int j = 0; j < 4; ++j) v[j] = *(const f32x4*)(src + 4 * lane + 256 * j);
        if (LN) {
            float s = 0.f;
#pragma unroll
            for (int j = 0; j < 4; ++j) s += (v[j][0] + v[j][1]) + (v[j][2] + v[j][3]);
            const float mean = wave_sum(s) * (1.0f / DM); float s2 = 0.f;
#pragma unroll
            for (int j = 0; j < 4; ++j) { v[j] = v[j] - mean; s2 += (v[j][0] * v[j][0] + v[j][1] * v[j][1]) + (v[j][2] * v[j][2] + v[j][3] * v[j][3]); }
            const float rstd = 1.0f / sqrtf(wave_sum(s2) * (1.0f / DM) + 1e-6f);
            if (!write_x && lane == 0) *(f32x2*)(stats + 2 * (size_t)r) = (f32x2){mean, rstd};
#pragma unroll
            for (int j = 0; j < 4; ++j) v[j] = v[j] * rstd * g4[j] + b4[j];
        }
        if (write_x) {
#pragma unroll
            for (int j = 0; j < 4; ++j) *(f32x4*)(dst + 4 * lane + 256 * j) = v[j]; }
        if (write_h) {
#pragma unroll
            for (int j = 0; j < 4; ++j) { const f32x4 h = v[j] * (sc[j] + 1.0f) + sh[j]; u32x2 o; o.x = cvtpk(h[0], h[1]); o.y = cvtpk(h[2], h[3]);
                *(u32x2*)(H + (size_t)r * DM + 4 * lane + 256 * j) = o; } }
    }
}

__device__ __forceinline__ void rope4(float (&v)[4], const float* ctab, const float* stab, bool odd, int xmask) {
    const f32x4 c = *(const f32x4*)ctab, s = *(const f32x4*)stab;
#pragma unroll
    for (int e = 0; e < 4; ++e) { const float p = __shfl_xor(v[e], xmask); v[e] = v[e] * c[e] + (odd ? p : -p) * s[e]; }
}
__device__ __forceinline__ void up4(const u32x2 raw, float (&v)[4]) { v[0] = bf2f(raw.x & 0xffffu); v[1] = bf2f(raw.x >> 16); v[2] = bf2f(raw.y & 0xffffu); v[3] = bf2f(raw.y >> 16); }
__device__ __forceinline__ void ld4(const bf16_t* p, float (&v)[4]) { const u32x2 raw = *(const u32x2*)p; v[0] = bf2f(raw.x & 0xffffu); v[1] = bf2f(raw.x >> 16); v[2] = bf2f(raw.y & 0xffffu); v[3] = bf2f(raw.y >> 16); }
__device__ __forceinline__ void st4(bf16_t* p, const float (&v)[4], float sc) { u32x2 o; o.x = cvtpk(v[0] * sc, v[1] * sc); o.y = cvtpk(v[2] * sc, v[3] * sc); *(u32x2*)p = o; }
__device__ __forceinline__ void st4lds(LAS bf16_t* p, const float (&v)[4]) { u32x2 o; o.x = cvtpk(v[0], v[1]); o.y = cvtpk(v[2], v[3]); *(LAS u32x2*)p = o; }

__device__ __forceinline__ void zpost_phase(const Params& P, LAS unsigned char* lds, int l) {
    int tid_ = threadIdx.x; asm volatile("" : "+v"(tid_)); const int tid = tid_, lane = tid & 63, wave = __builtin_amdgcn_readfirstlane(tid >> 6);
    GAS unsigned char* wsg_ = (GAS unsigned char*)P.ws; asm volatile("" : "+s"(wsg_)); unsigned char* ws = (unsigned char*)wsg_;
    const bf16_t* Z = (const bf16_t*)(ws + WS_Z); bf16_t* Y = (bf16_t*)(ws + WS_Y); unsigned char* qkv = ws + WS_QKV;
    bf16_t *QA = (bf16_t*)(qkv + O_QA), *KA = (bf16_t*)(qkv + O_KA), *VAT = (bf16_t*)(qkv + O_VAT), *QC = (bf16_t*)(qkv + O_QC), *KC = (bf16_t*)(qkv + O_KC), *VCT = (bf16_t*)(qkv + O_VCT),
           *QD = (bf16_t*)(qkv + O_QD), *KD = (bf16_t*)(qkv + O_KD), *VDT = (bf16_t*)(qkv + O_VDT);
    const float* rope = (const float*)(ws + WS_ROPE);
    const float* convw = P.in[12] + l * 768; const float* qnw = P.in[19] + l * 64; const float* knw = P.in[20] + l * 64;
    LAS bf16_t* vt = (LAS bf16_t*)lds;
    for (int u = blockIdx.x; u < 1040; u += gridDim.x) {
        const int b = u / 520, kt = u % 520, kk0 = kt * 32; const bool isctx = kt < 8;
        __syncthreads();
        for (int ii = 0; ii < 4; ++ii) {
            const int i = wave * 4 + ii, kk = kk0 + i;
            const int r = isctx ? NLAT + b * CTXL + kk : b * SEQ + kk - CTXL;
            const int t = kk - CTXL, prow = (t >> 6) & 255, pcol = t & 63;
            const bf16_t* z = Z + (size_t)r * INW;
            float v[4];
            const int lkk = lane & 31;
            const bool hasp_ = isctx ? (kk > 0) : (t > 0), hasn_ = isctx ? (kk < CTXL - 1) : (t < SEQ - 1);
            u32x2 zr[16];
            zr[0] = *(const u32x2*)(z + 4 * lane); zr[1] = *(const u32x2*)(z + 256 + 4 * lane); zr[2] = *(const u32x2*)(z + 512 + 4 * lane);
            zr[3] = *(const u32x2*)(z + 768 + 4 * lane); zr[4] = *(const u32x2*)(z + 1024 + 4 * lane); zr[5] = *(const u32x2*)(z + 1280 + 4 * lane);
            zr[6] = (u32x2){0u, 0u}; zr[7] = zr[6]; zr[8] = zr[6]; zr[9] = zr[6];
            if (hasp_) { zr[6] = *(const u32x2*)(z - INW + 1024 + 4 * lane); zr[7] = *(const u32x2*)(z - INW + 1280 + 4 * lane); }
            if (hasn_) { zr[8] = *(const u32x2*)(z + INW + 1024 + 4 * lane); zr[9] = *(const u32x2*)(z + INW + 1280 + 4 * lane); }
            zr[10] = *(const u32x2*)(z + 1536 + 4 * lane); zr[11] = *(const u32x2*)(z + 1792 + 4 * lkk); zr[12] = *(const u32x2*)(z + 1920 + 4 * lkk);
            zr[13] = *(const u32x2*)(z + 2048 + 4 * lane); zr[14] = *(const u32x2*)(z + 2304 + 4 * lkk); zr[15] = *(const u32x2*)(z + 2432 + 4 * lkk);
            { const int h = lane >> 4, c = (4 * lane) & 63, quarter = (lane & 7) >> 1, e0 = (lane & 1) * 4; const int pos = quarter < 2 ? prow : pcol;
              const float* ct = rope + pos * 8 + e0; const float* st = rope + 2048 + pos * 8 + e0;
              up4(zr[0], v); if (!isctx) rope4(v, ct, st, quarter & 1, 2);
              st4(QA + ((size_t)(b * 4 + h) * NK + kk) * 64 + c, v, QSCALE_A);
              up4(zr[1], v); if (!isctx) rope4(v, ct, st, quarter & 1, 2);
              st4(KA + ((size_t)(b * 4 + h) * NK + kk) * 64 + c, v, 1.0f);
              up4(zr[2], v); st4lds(vt + i * 520 + 4 * lane, v); }
            { const bool hasp = isctx ? (kk > 0) : (t > 0), hasn = isctx ? (kk < CTXL - 1) : (t < SEQ - 1);
              float gb[4], gc[4], uu[4], hm[4], hp[4]; up4(zr[3], gb); up4(zr[4], gc); up4(zr[5], uu);
#pragma unroll
              for (int e = 0; e < 4; ++e) { hm[e] = 0.f; hp[e] = 0.f; }
              if (hasp) { float a[4], c2[4]; up4(zr[6], a); up4(zr[7], c2);
#pragma unroll
                  for (int e = 0; e < 4; ++e) hm[e] = a[e] * c2[e]; }
              if (hasn) { float a[4], c2[4]; up4(zr[8], a); up4(zr[9], c2);
#pragma unroll
                  for (int e = 0; e < 4; ++e) hp[e] = a[e] * c2[e]; }
              const f32x4 w0 = *(const f32x4*)(convw + 4 * lane), w1 = *(const f32x4*)(convw + 256 + 4 * lane), w2 = *(const f32x4*)(convw + 512 + 4 * lane);
#pragma unroll
              for (int e = 0; e < 4; ++e) v[e] = gb[e] * (w0[e] * hm[e] + w1[e] * (gc[e] * uu[e]) + w2[e] * hp[e]);
              st4(Y + (size_t)r * DM + 256 + 4 * lane, v, 1.0f); }
            { const int hq = lane >> 4, c = (4 * lane) & 63, quarter = (lane & 15) >> 2, e0 = (lane & 3) * 4; const int pos = quarter < 2 ? prow : pcol;
              const float* ct = rope + 4096 + pos * 16 + e0; const float* st = rope + 8192 + pos * 16 + e0;
              const int lk = lane & 31, hk = lk >> 4;
              up4(zr[10], v); if (!isctx) rope4(v, ct, st, quarter & 1, 4);
              st4(QC + ((size_t)(b * 4 + hq) * NK + kk) * 64 + c, v, QSCALE_H);
              up4(zr[11], v); if (!isctx) rope4(v, ct, st, quarter & 1, 4);
              if (lane < 32) st4(KC + ((size_t)(b * 2 + hk) * NK + kk) * 64 + c, v, 1.0f);
              up4(zr[12], v); if (lane < 32) st4lds(vt + i * 520 + 256 + 4 * lk, v);
              up4(zr[13], v);
              { float ss = v[0] * v[0] + v[1] * v[1] + v[2] * v[2] + v[3] * v[3]; ss += __shfl_xor(ss, 1); ss += __shfl_xor(ss, 2); ss += __shfl_xor(ss, 4); ss += __shfl_xor(ss, 8);
                const float rs = 1.0f / sqrtf(ss * (1.0f / 64.0f) + 1e-6f); const f32x4 w = *(const f32x4*)(qnw + c);
#pragma unroll
                for (int e = 0; e < 4; ++e) v[e] = v[e] * rs * w[e]; }
              if (!isctx) rope4(v, ct, st, quarter & 1, 4);
              st4(QD + ((size_t)(b * 4 + hq) * NK + kk) * 64 + c, v, QSCALE_H);
              up4(zr[14], v);
              { float ss = v[0] * v[0] + v[1] * v[1] + v[2] * v[2] + v[3] * v[3]; ss += __shfl_xor(ss, 1); ss += __shfl_xor(ss, 2); ss += __shfl_xor(ss, 4); ss += __shfl_xor(ss, 8);
                const float rs = 1.0f / sqrtf(ss * (1.0f / 64.0f) + 1e-6f); const f32x4 w = *(const f32x4*)(knw + c);
#pragma unroll
                for (int e = 0; e < 4; ++e) v[e] = v[e] * rs * w[e]; }
              if (!isctx) rope4(v, ct, st, quarter & 1, 4);
              if (lane < 32) st4(KD + ((size_t)(b * 2 + hk) * NK + kk) * 64 + c, v, 1.0f);
              up4(zr[15], v); if (lane < 32) st4lds(vt + i * 520 + 384 + 4 * lk, v); }
        }
        __syncthreads();
#pragma unroll 2
        for (int it = 0; it < 4; ++it) { const int vc = it * 128 + (tid >> 2), g = tid & 3; bf16_t* dst;
          if (vc < 256) dst = VAT + ((size_t)(b * 4 + (vc >> 6)) * 64 + (vc & 63)) * NK;
          else if (vc < 384) dst = VCT + ((size_t)(b * 2 + ((vc - 256) >> 6)) * 64 + (vc & 63)) * NK;
          else dst = VDT + ((size_t)(b * 2 + ((vc - 384) >> 6)) * 64 + (vc & 63)) * NK;
          unsigned w[4];
#pragma unroll
          for (int i2 = 0; i2 < 4; ++i2) { const int ia = 2 * i2, ib = 2 * i2 + 1;
              const int ta = 16 * (g >> 1) + 8 * (ia >> 2) + 4 * (g & 1) + (ia & 3), tb = 16 * (g >> 1) + 8 * (ib >> 2) + 4 * (g & 1) + (ib & 3);
              w[i2] = (unsigned)vt[ta * 520 + vc] | ((unsigned)vt[tb * 520 + vc] << 16); }
          *(u32x4*)(dst + kk0 + 8 * g) = (u32x4){w[0], w[1], w[2], w[3]}; }
    }
}

__device__ __forceinline__ float fmax3(float a, float b, float c) { float r; asm("v_max3_f32 %0, %1, %2, %3" : "=v"(r) : "v"(a), "v"(b), "v"(c)); return r; }
__device__ __forceinline__ void g2_first(f32x16& acc, bf16x8 a, bf16x8 b, const f32x16& c, float& e0, float& e1, float& e2, float& e3, float p0, float p1, float p2, float p3) {
    asm volatile("s_nop 1\n\tv_mfma_f32_32x32x16_bf16 %0, %5, %6, %7\n\tv_exp_f32_e32 %1, %8\n\tv_exp_f32_e32 %2, %9\n\tv_exp_f32_e32 %3, %10\n\tv_exp_f32_e32 %4, %11\n\ts_nop 0"
                 : "=&v"(acc), "=&v"(e0), "=&v"(e1), "=&v"(e2), "=&v"(e3) : "v"(a), "v"(b), "v"(c), "v"(p0), "v"(p1), "v"(p2), "v"(p3)); }
__device__ __forceinline__ void g2_acc(f32x16& acc, bf16x8 a, bf16x8 b, float& e0, float& e1, float& e2, float& e3, float p0, float p1, float p2, float p3) {
    asm volatile("v_mfma_f32_32x32x16_bf16 %0, %5, %6, %0\n\tv_exp_f32_e32 %1, %7\n\tv_exp_f32_e32 %2, %8\n\tv_exp_f32_e32 %3, %9\n\tv_exp_f32_e32 %4, %10\n\ts_nop 0"
                 : "+v"(acc), "=&v"(e0), "=&v"(e1), "=&v"(e2), "=&v"(e3) : "v"(a), "v"(b), "v"(p0), "v"(p1), "v"(p2), "v"(p3)); }
__device__ __forceinline__ void g2_none(float& e0, float& e1, float& e2, float& e3, float p0, float p1, float p2, float p3) {
    asm volatile("v_exp_f32_e32 %0, %4\n\tv_exp_f32_e32 %1, %5\n\tv_exp_f32_e32 %2, %6\n\tv_exp_f32_e32 %3, %7\n\ts_nop 0"
                 : "=&v"(e0), "=&v"(e1), "=&v"(e2), "=&v"(e3) : "v"(p0), "v"(p1), "v"(p2), "v"(p3)); }
__device__ __forceinline__ bf16x8 pack8(const f32x16& e, int b) { const u32x4 t = (u32x4){cvtpk(e[b], e[b + 1]), cvtpk(e[b + 2], e[b + 3]), cvtpk(e[b + 4], e[b + 5]), cvtpk(e[b + 6], e[b + 7])}; return __builtin_bit_cast(bf16x8, t); }
__device__ __forceinline__ float sum4(const f32x16& e, int b) { return (e[b] + e[b + 1]) + (e[b + 2] + e[b + 3]); }
__device__ __forceinline__ void g1_a0(f32x16& o, bf16x8 vf, bf16x8 pw, float& ps, float a0, float a1, float a2, float a3) {
    asm volatile("s_nop 1\n\tv_mfma_f32_32x32x16_bf16 %0, %2, %3, %0\n\tv_add_f32_e32 %1, %1, %4\n\tv_add_f32_e32 %1, %1, %5\n\tv_add_f32_e32 %1, %1, %6\n\tv_add_f32_e32 %1, %1, %7"
                 : "+v"(o), "+v"(ps) : "v"(vf), "v"(pw), "v"(a0), "v"(a1), "v"(a2), "v"(a3)); }
__device__ __forceinline__ void g1_b0(f32x16& o, bf16x8 vf, bf16x8 pw, float& ps, float a0, float a1, float a2, float a3,
                                      unsigned& w0, unsigned& w1, unsigned& w2, unsigned& w3, float c0, float c1, float c2, float c3, float c4, float c5, float c6, float c7) {
    asm volatile("s_nop 1\n\tv_mfma_f32_32x32x16_bf16 %0, %6, %7, %0\n\tv_add_f32_e32 %1, %1, %8\n\tv_add_f32_e32 %1, %1, %9\n\tv_add_f32_e32 %1, %1, %10\n\tv_add_f32_e32 %1, %1, %11\n\t"
                 "v_cvt_pk_bf16_f32 %2, %12, %13\n\tv_cvt_pk_bf16_f32 %3, %14, %15\n\tv_cvt_pk_bf16_f32 %4, %16, %17\n\tv_cvt_pk_bf16_f32 %5, %18, %19"
                 : "+v"(o), "+v"(ps), "=&v"(w0), "=&v"(w1), "=&v"(w2), "=&v"(w3)
                 : "v"(vf), "v"(pw), "v"(a0), "v"(a1), "v"(a2), "v"(a3), "v"(c0), "v"(c1), "v"(c2), "v"(c3), "v"(c4), "v"(c5), "v"(c6), "v"(c7)); }
__device__ __forceinline__ void g1_a(f32x16& o, bf16x8 vf, bf16x8 pw, float& mx, float m0, float m1, float m2, float m3, float& ps, float a0, float a1, float a2, float a3) {
    asm volatile("s_nop 1\n\tv_mfma_f32_32x32x16_bf16 %0, %3, %4, %0\n\tv_max3_f32 %1, %1, %5, %6\n\tv_max3_f32 %1, %1, %7, %8\n\t"
                 "v_add_f32_e32 %2, %2, %9\n\tv_add_f32_e32 %2, %2, %10\n\tv_add_f32_e32 %2, %2, %11\n\tv_add_f32_e32 %2, %2, %12"
                 : "+v"(o), "+v"(mx), "+v"(ps) : "v"(vf), "v"(pw), "v"(m0), "v"(m1), "v"(m2), "v"(m3), "v"(a0), "v"(a1), "v"(a2), "v"(a3)); }
__device__ __forceinline__ void g1_b(f32x16& o, bf16x8 vf, bf16x8 pw, float& mx, float m0, float m1, float m2, float m3, float& ps, float a0, float a1, float a2, float a3,
                                     unsigned& w0, unsigned& w1, unsigned& w2, unsigned& w3, float c0, float c1, float c2, float c3, float c4, float c5, float c6, float c7) {
    asm volatile("s_nop 1\n\tv_mfma_f32_32x32x16_bf16 %0, %7, %8, %0\n\tv_max3_f32 %1, %1, %9, %10\n\tv_max3_f32 %1, %1, %11, %12\n\t"
                 "v_add_f32_e32 %2, %2, %13\n\tv_add_f32_e32 %2, %2, %14\n\tv_add_f32_e32 %2, %2, %15\n\tv_add_f32_e32 %2, %2, %16\n\t"
                 "v_cvt_pk_bf16_f32 %3, %17, %18\n\tv_cvt_pk_bf16_f32 %4, %19, %20\n\tv_cvt_pk_bf16_f32 %5, %21, %22\n\tv_cvt_pk_bf16_f32 %6, %23, %24"
                 : "+v"(o), "+v"(mx), "+v"(ps), "=&v"(w0), "=&v"(w1), "=&v"(w2), "=&v"(w3)
                 : "v"(vf), "v"(pw), "v"(m0), "v"(m1), "v"(m2), "v"(m3), "v"(a0), "v"(a1), "v"(a2), "v"(a3), "v"(c0), "v"(c1), "v"(c2), "v"(c3), "v"(c4), "v"(c5), "v"(c6), "v"(c7)); }
struct AttnPtrs { const bf16_t* Q; const bf16_t* K; const bf16_t* Vt; bf16_t* Y; const float* subw; const float* sink; float lam; float oml; };
template <int MODE>
__device__ __forceinline__ void attn_unit(LAS unsigned char* lds, const AttnPtrs& A, int b, int head, int qt) {
    int tid_ = threadIdx.x; asm volatile("" : "+v"(tid_)); const int tid = tid_, lane = tid & 63, r32 = lane & 31, hi = lane >> 5;
    const int wid = __builtin_amdgcn_readfirstlane(tid >> 6), sub = wid >> 2, rq = (wid & 3) * 32;
    constexpr int DQ = (MODE == 0) ? 32 : 64, NCH = DQ / 16, NKVH = (MODE == 0) ? 4 : 2;
    constexpr int KBUF = 9216, VBUF = 9216, VS0 = 4 * KBUF, XB0 = VS0 + 5 * VBUF;
    constexpr float THR = 8.0f;
    const int q0 = qt * 128;
    const int qhead = (MODE == 0) ? head : head * 2 + sub;
    const int doff = (MODE == 0) ? sub * 32 : 0;
    const bf16_t* Qrow = A.Q + ((size_t)(b * 4 + qhead) * NK + q0 + rq + r32) * 64 + doff;
    const bf16_t* Kb = A.K + (size_t)(b * NKVH + head) * NK * 64;
    const bf16_t* Vb = A.Vt + (size_t)(b * NKVH + head) * 64 * NK;
    bf16x8 qf[NCH];
#pragma unroll
    for (int j = 0; j < NCH; ++j) qf[j] = *(const bf16x8*)(Qrow + 16 * j + 8 * hi);
    int lo = 4, hit = 4;
    if (qt >= 2) { if (MODE == 1) { lo = (q0 - 128) >> 6; if (lo < 4) lo = 4; hit = (q0 + 256) >> 6; if (hit > 260) hit = 260; } else { hit = 260; } }
    const int nsteps = 4 + hit - lo;
#define ATT_TILE(s) ((s) < 4 ? (s) : lo + (s) - 4)
    const int srow = tid >> 3, sch = tid & 7;
    const bf16_t* kg = Kb + (size_t)srow * 64 + sch * 8;
    const bf16_t* vg = Vb + (size_t)srow * NK + sch * 8;
    const unsigned sofs = srow * 144 + sch * 16;
    LAS unsigned char* Ks = lds; LAS unsigned char* Vs = lds + VS0;
    const LAS unsigned char* kp0 = Ks + r32 * 144 + (doff + 8 * hi) * 2;
    const LAS unsigned char* vp0 = Vs + r32 * 144 + hi * 16;
    const int qrel = q0 + rq + r32;
    f32x16 negm, p0, p1, o0, o1;
#pragma unroll
    for (int r = 0; r < 16; ++r) { negm[r] = 0.f; o0[r] = 0.f; o1[r] = 0.f; }
    asm volatile("" : "+v"(negm));
#define ATT_QK(D0, D1, kbuf) do { const LAS unsigned char* kp_ = kp0 + (kbuf) * KBUF; \
        _Pragma("unroll") for (int j = 0; j < NCH; ++j) { const bf16x8 k0_ = *(const LAS bf16x8*)(kp_ + j * 32); const bf16x8 k1_ = *(const LAS bf16x8*)(kp_ + 32 * 144 + j * 32); \
            if (j == 0) { D0 = __builtin_amdgcn_mfma_f32_32x32x16_bf16(k0_, qf[0], negm, 0, 0, 0); D1 = __builtin_amdgcn_mfma_f32_32x32x16_bf16(k1_, qf[0], negm, 0, 0, 0); } \
            else { D0 = __builtin_amdgcn_mfma_f32_32x32x16_bf16(k0_, qf[j], D0, 0, 0, 0); D1 = __builtin_amdgcn_mfma_f32_32x32x16_bf16(k1_, qf[j], D1, 0, 0, 0); } } } while (0)
#define ATT_MASK(D0, D1, s) do { if (MODE == 1 && (s) >= 4) { asm volatile("s_nop 7\n\ts_nop 3" ::: "memory");     \
        const int db_ = (lo + (s) - 4) * 64 - qrel; \
        _Pragma("unroll") for (int r = 0; r < 16; ++r) { const int d0_ = db_ + crow(r, hi), d1_ = d0_ + 32; \
            if (d0_ > 128 || d0_ < -128) D0[r] = -1e30f; if (d1_ > 128 || d1_ < -128) D1[r] = -1e30f; } } } while (0)
#define ATT_LDK(s) (*(const u32x4*)(kg + (size_t)ATT_TILE(s) * 4096))
#define ATT_LDV(s) (*(const u32x4*)(vg + ATT_TILE(s) * 64))

    __syncthreads();
    u32x4 kqa = (u32x4){0u, 0u, 0u, 0u}, vqa = kqa, kqb = kqa, vqb = kqa;
    { const u32x4 k0r = ATT_LDK(0); const u32x4 v0r = ATT_LDV(0); const u32x4 k1r = ATT_LDK(1); const u32x4 k2r = ATT_LDK(2); const u32x4 v1r = ATT_LDV(1);
      kqb = ATT_LDK(3); vqb = ATT_LDV(2);
      *(LAS u32x4*)(Ks + sofs) = k0r; *(LAS u32x4*)(Vs + sofs) = v0r; *(LAS u32x4*)(Ks + KBUF + sofs) = k1r; *(LAS u32x4*)(Ks + 2 * KBUF + sofs) = k2r; *(LAS u32x4*)(Vs + VBUF + sofs) = v1r; }
    __syncthreads();
    f32x16 pb0, pb1;
    ATT_QK(p0, p1, 0);
    float m = 0.f, lsum = 0.f;
    int kb_cur = 0;
#define ATT_MAXUPD(S, P0, P1) do { \
        float mx = fmax3(fmax3(P0[0], P1[0], P0[1]), P1[1], P0[2]); \
        _Pragma("unroll") for (int r = 2; r < 14; r += 2) mx = fmax3(fmax3(mx, P1[r], P0[r + 1]), P1[r + 1], P0[r + 2]); \
        mx = fmax3(fmax3(mx, P1[14], P0[15]), P1[15], P1[15]); \
        mx = xhalf_max(mx); \
        if ((S) == 0 || __any(mx > THR)) { \
            const float dl = ((S) == 0) ? mx : fmaxf(mx, 0.f); \
            m += dl; \
            _Pragma("unroll") for (int r = 0; r < 16; ++r) { P0[r] -= dl; P1[r] -= dl; negm[r] = -m; } \
            asm volatile("" : "+v"(negm)); \
            if ((S) > 0) { const float f = __builtin_amdgcn_exp2f(-dl); lsum *= f; \
                _Pragma("unroll") for (int r = 0; r < 16; ++r) { o0[r] *= f; o1[r] *= f; } } \
        } } while (0)
#define ATT_EXPPACK(P0, P1, PW) do { \
        float ps = 0.f; \
        _Pragma("unroll") for (int r = 0; r < 16; ++r) { P0[r] = __builtin_amdgcn_exp2f(P0[r]); P1[r] = __builtin_amdgcn_exp2f(P1[r]); ps += P0[r] + P1[r]; } \
        lsum += ps; \
        { u32x4 t; \
          t.x = cvtpk(P0[0], P0[1]); t.y = cvtpk(P0[2], P0[3]); t.z = cvtpk(P0[4], P0[5]); t.w = cvtpk(P0[6], P0[7]); PW[0] = __builtin_bit_cast(bf16x8, t); \
          t.x = cvtpk(P0[8], P0[9]); t.y = cvtpk(P0[10], P0[11]); t.z = cvtpk(P0[12], P0[13]); t.w = cvtpk(P0[14], P0[15]); PW[1] = __builtin_bit_cast(bf16x8, t); \
          t.x = cvtpk(P1[0], P1[1]); t.y = cvtpk(P1[2], P1[3]); t.z = cvtpk(P1[4], P1[5]); t.w = cvtpk(P1[6], P1[7]); PW[2] = __builtin_bit_cast(bf16x8, t); \
          t.x = cvtpk(P1[8], P1[9]); t.y = cvtpk(P1[10], P1[11]); t.z = cvtpk(P1[12], P1[13]); t.w = cvtpk(P1[14], P1[15]); PW[3] = __builtin_bit_cast(bf16x8, t); } } while (0)
#define ATT_PV(PW, vslot) do { const LAS unsigned char* vp_ = vp0 + (vslot) * VBUF; \
        _Pragma("unroll") for (int c = 0; c < 4; ++c) { const bf16x8 v0_ = *(const LAS bf16x8*)(vp_ + c * 32); const bf16x8 v1_ = *(const LAS bf16x8*)(vp_ + 32 * 144 + c * 32); \
            o0 = __builtin_amdgcn_mfma_f32_32x32x16_bf16(v0_, PW[c], o0, 0, 0, 0); o1 = __builtin_amdgcn_mfma_f32_32x32x16_bf16(v1_, PW[c], o1, 0, 0, 0); } } while (0)
    bf16x8 pwk[4];
#pragma unroll
    for (int c = 0; c < 4; ++c) pwk[c] = (bf16x8){0, 0, 0, 0, 0, 0, 0, 0};
#define ATT_LDVF(VF, vslot) do { const LAS unsigned char* vp_ = vp0 + (vslot) * VBUF; \
        _Pragma("unroll") for (int c = 0; c < 4; ++c) { VF[2 * c] = *(const LAS bf16x8*)(vp_ + c * 32); VF[2 * c + 1] = *(const LAS bf16x8*)(vp_ + 32 * 144 + c * 32); } } while (0)
#define ATT_LDKF(KF, kslot) do { const LAS unsigned char* kp_ = kp0 + (kslot) * KBUF; \
        _Pragma("unroll") for (int j = 0; j < NCH; ++j) { KF[2 * j] = *(const LAS bf16x8*)(kp_ + j * 32); KF[2 * j + 1] = *(const LAS bf16x8*)(kp_ + 32 * 144 + j * 32); } } while (0)
#define ATT_PVF(VF, PW) do { \
        _Pragma("unroll") for (int c = 0; c < 4; ++c) { o0 = __builtin_amdgcn_mfma_f32_32x32x16_bf16(VF[2 * c], PW[c], o0, 0, 0, 0); o1 = __builtin_amdgcn_mfma_f32_32x32x16_bf16(VF[2 * c + 1], PW[c], o1, 0, 0, 0); } } while (0)
#define ATT_QKF(KF, D0, D1) do { \
        D0 = __builtin_amdgcn_mfma_f32_32x32x16_bf16(KF[0], qf[0], negm, 0, 0, 0); D1 = __builtin_amdgcn_mfma_f32_32x32x16_bf16(KF[1], qf[0], negm, 0, 0, 0); \
        _Pragma("unroll") for (int j = 1; j < NCH; ++j) { D0 = __builtin_amdgcn_mfma_f32_32x32x16_bf16(KF[2 * j], qf[j], D0, 0, 0, 0); D1 = __builtin_amdgcn_mfma_f32_32x32x16_bf16(KF[2 * j + 1], qf[j], D1, 0, 0, 0); } } while (0)
#define ATT_VV(P0, P1, i) ((i) < 16 ? P0[(i) & 15] : P1[(i) & 15])
#define ATT_MXOP(P0, P1, k) do { if ((k) == 0) mx_ = fmax3(P0[0], P0[1], P0[2]); else if ((k) == 15) mx_ = fmax3(mx_, P1[15], P1[15]); \
        else mx_ = fmax3(mx_, ATT_VV(P0, P1, 1 + 2 * (k)), ATT_VV(P0, P1, 2 + 2 * (k))); } while (0)
#define ATT_SB() __builtin_amdgcn_sched_barrier(0)
#define ATT_STEP(BAR, S, FIRST, CHK, P0, P1, N0, N1, KN, VN, KO, VO) do { \
        if (BAR) __syncthreads(); \
        const int kb_n1 = (kb_cur + 1) & 3; const int vb_prev = vb_cur == 0 ? 4 : vb_cur - 1; \
        { const int sk_ = (S) + 4 < nsteps ? (S) + 4 : nsteps - 1, sv_ = (S) + 3 < nsteps ? (S) + 3 : nsteps - 1;     \
          KN = ATT_LDK(sk_); VN = ATT_LDV(sv_); } \
        bf16x8 kf_[2 * NCH]; \
        float mx_; \
        if (!(FIRST)) { \
            if (BAR) { ATT_LDVF(vf_, vb_prev); }     \
            ATT_SB(); \
            __builtin_amdgcn_s_setprio(1); \
              \
            float ps_ = 0.f; mx_ = P0[0]; bf16x8 pwa_ = pack8(N0, 0), pwb_; unsigned w0_, w1_, w2_, w3_; \
            if (CHK) { \
            g1_a(o0, vf_[0], pwa_, mx_, P0[1], P0[2], P0[3], P0[4], ps_, N0[0], N0[1], N0[2], N0[3]); \
            g1_b(o1, vf_[1], pwa_, mx_, P0[5], P0[6], P0[7], P0[8], ps_, N0[4], N0[5], N0[6], N0[7], w0_, w1_, w2_, w3_, N0[8], N0[9], N0[10], N0[11], N0[12], N0[13], N0[14], N0[15]); \
            { const u32x4 t_ = (u32x4){w0_, w1_, w2_, w3_}; pwb_ = __builtin_bit_cast(bf16x8, t_); } \
            g1_a(o0, vf_[2], pwb_, mx_, P0[9], P0[10], P0[11], P0[12], ps_, N0[8], N0[9], N0[10], N0[11]); \
            g1_b(o1, vf_[3], pwb_, mx_, P0[13], P0[14], P0[15], P1[0], ps_, N0[12], N0[13], N0[14], N0[15], w0_, w1_, w2_, w3_, N1[0], N1[1], N1[2], N1[3], N1[4], N1[5], N1[6], N1[7]); \
            { const u32x4 t_ = (u32x4){w0_, w1_, w2_, w3_}; pwa_ = __builtin_bit_cast(bf16x8, t_); } \
            g1_a(o0, vf_[4], pwa_, mx_, P1[1], P1[2], P1[3], P1[4], ps_, N1[0], N1[1], N1[2], N1[3]); \
            g1_b(o1, vf_[5], pwa_, mx_, P1[5], P1[6], P1[7], P1[8], ps_, N1[4], N1[5], N1[6], N1[7], w0_, w1_, w2_, w3_, N1[8], N1[9], N1[10], N1[11], N1[12], N1[13], N1[14], N1[15]); \
            { const u32x4 t_ = (u32x4){w0_, w1_, w2_, w3_}; pwb_ = __builtin_bit_cast(bf16x8, t_); } \
            g1_a(o0, vf_[6], pwb_, mx_, P1[9], P1[10], P1[11], P1[12], ps_, N1[8], N1[9], N1[10], N1[11]); \
            g1_a(o1, vf_[7], pwb_, mx_, P1[13], P1[14], P1[15], P1[15], ps_, N1[12], N1[13], N1[14], N1[15]); \
            } else { \
            g1_a0(o0, vf_[0], pwa_, ps_, N0[0], N0[1], N0[2], N0[3]); \
            g1_b0(o1, vf_[1], pwa_, ps_, N0[4], N0[5], N0[6], N0[7], w0_, w1_, w2_, w3_, N0[8], N0[9], N0[10], N0[11], N0[12], N0[13], N0[14], N0[15]); \
            { const u32x4 t_ = (u32x4){w0_, w1_, w2_, w3_}; pwb_ = __builtin_bit_cast(bf16x8, t_); } \
            g1_a0(o0, vf_[2], pwb_, ps_, N0[8], N0[9], N0[10], N0[11]); \
            g1_b0(o1, vf_[3], pwb_, ps_, N0[12], N0[13], N0[14], N0[15], w0_, w1_, w2_, w3_, N1[0], N1[1], N1[2], N1[3], N1[4], N1[5], N1[6], N1[7]); \
            { const u32x4 t_ = (u32x4){w0_, w1_, w2_, w3_}; pwa_ = __builtin_bit_cast(bf16x8, t_); } \
            g1_a0(o0, vf_[4], pwa_, ps_, N1[0], N1[1], N1[2], N1[3]); \
            g1_b0(o1, vf_[5], pwa_, ps_, N1[4], N1[5], N1[6], N1[7], w0_, w1_, w2_, w3_, N1[8], N1[9], N1[10], N1[11], N1[12], N1[13], N1[14], N1[15]); \
            { const u32x4 t_ = (u32x4){w0_, w1_, w2_, w3_}; pwb_ = __builtin_bit_cast(bf16x8, t_); } \
            g1_a0(o0, vf_[6], pwb_, ps_, N1[8], N1[9], N1[10], N1[11]); \
            g1_a0(o1, vf_[7], pwb_, ps_, N1[12], N1[13], N1[14], N1[15]); \
            } \
            lsum += ps_; \
        } else { \
            _Pragma("unroll") for (int k = 0; k < 16; ++k) ATT_MXOP(P0, P1, k); \
        } \
        __builtin_amdgcn_s_setprio(0); \
        ATT_LDKF(kf_, kb_n1); \
        ATT_SB(); \
        if (CHK) { const float mx = xhalf_max(mx_); \
          if ((FIRST) || __any(mx > THR)) { \
            const float dl = (FIRST) ? mx : fmaxf(mx, 0.f); \
            m += dl; \
            _Pragma("unroll") for (int r = 0; r < 16; ++r) { P0[r] -= dl; P1[r] -= dl; negm[r] = -m; } \
            asm volatile("" : "+v"(negm)); \
            if (!(FIRST)) { asm volatile("s_nop 11" ::: "memory"); const float f = __builtin_amdgcn_exp2f(-dl); lsum *= f; \
                _Pragma("unroll") for (int r = 0; r < 16; ++r) { o0[r] *= f; o1[r] *= f; } } \
          } } \
        ATT_SB(); \
        { \
          _Pragma("unroll") for (int g = 0; g < 8; ++g) { \
            constexpr int GSTEP = 8 / (2 * NCH); \
            const float q0_ = g < 4 ? P0[(4 * g) & 15] : P1[(4 * g) & 15], q1_ = g < 4 ? P0[(4 * g + 1) & 15] : P1[(4 * g + 1) & 15], q2_ = g < 4 ? P0[(4 * g + 2) & 15] : P1[(4 * g + 2) & 15], q3_ = g < 4 ? P0[(4 * g + 3) & 15] : P1[(4 * g + 3) & 15]; \
            float e0, e1, e2, e3; \
            if ((g % GSTEP) == 0) { const int mi = g / GSTEP, j = mi >> 1; \
                if ((mi & 1) == 0) { if (j == 0) g2_first(N0, kf_[0], qf[0], negm, e0, e1, e2, e3, q0_, q1_, q2_, q3_); else g2_acc(N0, kf_[2 * j], qf[j], e0, e1, e2, e3, q0_, q1_, q2_, q3_); } \
                else { if (j == 0) g2_first(N1, kf_[1], qf[0], negm, e0, e1, e2, e3, q0_, q1_, q2_, q3_); else g2_acc(N1, kf_[2 * j + 1], qf[j], e0, e1, e2, e3, q0_, q1_, q2_, q3_); } } \
            else g2_none(e0, e1, e2, e3, q0_, q1_, q2_, q3_); \
            if (g < 4) { P0[(4 * g) & 15] = e0; P0[(4 * g + 1) & 15] = e1; P0[(4 * g + 2) & 15] = e2; P0[(4 * g + 3) & 15] = e3; } \
            else { P1[(4 * g) & 15] = e0; P1[(4 * g + 1) & 15] = e1; P1[(4 * g + 2) & 15] = e2; P1[(4 * g + 3) & 15] = e3; } \
            ATT_SB(); } } \
        ATT_MASK(N0, N1, (S) + 1); \
        *(LAS u32x4*)(Ks + ((kb_cur + 3) & 3) * KBUF + sofs) = KO; \
        *(LAS u32x4*)(Vs + (vb_cur >= 3 ? vb_cur - 3 : vb_cur + 2) * VBUF + sofs) = VO; \
        if (BAR) { ATT_LDVF(vf_, vb_cur); }     \
        kb_cur = kb_n1; vb_cur = vb_cur == 4 ? 0 : vb_cur + 1; } while (0)
    int vb_cur = 0;
    bf16x8 vf_[8];
    ATT_STEP(false, 0, true, true, p0, p1, pb0, pb1, kqa, vqa, kqb, vqb);
    int s = 1;
    for (; s + 7 < nsteps; s += 8) {
        ATT_STEP(true, s, false, false, pb0, pb1, p0, p1, kqb, vqb, kqa, vqa);
        ATT_STEP(false, s + 1, false, false, p0, p1, pb0, pb1, kqa, vqa, kqb, vqb);
        ATT_STEP(true, s + 2, false, false, pb0, pb1, p0, p1, kqb, vqb, kqa, vqa);
        ATT_STEP(false, s + 3, false, false, p0, p1, pb0, pb1, kqa, vqa, kqb, vqb);
        ATT_STEP(true, s + 4, false, false, pb0, pb1, p0, p1, kqb, vqb, kqa, vqa);
        ATT_STEP(false, s + 5, false, false, p0, p1, pb0, pb1, kqa, vqa, kqb, vqb);
        ATT_STEP(true, s + 6, false, false, pb0, pb1, p0, p1, kqb, vqb, kqa, vqa);
        ATT_STEP(false, s + 7, false, true, p0, p1, pb0, pb1, kqa, vqa, kqb, vqb);
    }
    for (; s + 1 < nsteps; s += 2) {
        ATT_STEP(true, s, false, false, pb0, pb1, p0, p1, kqb, vqb, kqa, vqa);
        ATT_STEP(false, s + 1, false, true, p0, p1, pb0, pb1, kqa, vqa, kqb, vqb);
    }
    ATT_STEP(true, nsteps - 1, false, false, pb0, pb1, p0, p1, kqb, vqb, kqa, vqa);
    { bf16x8 vfl[8]; ATT_LDVF(vfl, (vb_cur == 0 ? 4 : vb_cur - 1));
      const bf16x8 w0 = pack8(pb0, 0), w1 = pack8(pb0, 8), w2 = pack8(pb1, 0), w3 = pack8(pb1, 8);
      o0 = __builtin_amdgcn_mfma_f32_32x32x16_bf16(vfl[0], w0, o0, 0, 0, 0); o1 = __builtin_amdgcn_mfma_f32_32x32x16_bf16(vfl[1], w0, o1, 0, 0, 0);
      o0 = __builtin_amdgcn_mfma_f32_32x32x16_bf16(vfl[2], w1, o0, 0, 0, 0); o1 = __builtin_amdgcn_mfma_f32_32x32x16_bf16(vfl[3], w1, o1, 0, 0, 0);
      o0 = __builtin_amdgcn_mfma_f32_32x32x16_bf16(vfl[4], w2, o0, 0, 0, 0); o1 = __builtin_amdgcn_mfma_f32_32x32x16_bf16(vfl[5], w2, o1, 0, 0, 0);
      o0 = __builtin_amdgcn_mfma_f32_32x32x16_bf16(vfl[6], w3, o0, 0, 0, 0); o1 = __builtin_amdgcn_mfma_f32_32x32x16_bf16(vfl[7], w3, o1, 0, 0, 0);
      lsum += ((sum4(pb0, 0) + sum4(pb0, 4)) + (sum4(pb0, 8) + sum4(pb0, 12))) + ((sum4(pb1, 0) + sum4(pb1, 4)) + (sum4(pb1, 8) + sum4(pb1, 12))); }
#undef ATT_MAXUPD
#undef ATT_VV
#undef ATT_MXOP
#undef ATT_SB
#undef ATT_LDVF
#undef ATT_LDKF
#undef ATT_PVF
#undef ATT_QKF
#undef ATT_EXPPACK
#undef ATT_PV
#undef ATT_STEP
#undef ATT_LDK
#undef ATT_LDV
#undef ATT_TILE
#undef ATT_QK
#undef ATT_MASK
    float lt = xhalf_sum(lsum);
    if (MODE == 1) lt += __builtin_amdgcn_exp2f(A.sink[qhead] * LOG2E - m);
    const float inv = 1.0f / lt;
#pragma unroll
    for (int r = 0; r < 16; ++r) { o0[r] *= inv; o1[r] *= inv; }
    const int qq = q0 + rq + r32;
    const size_t yrow = qq < CTXL ? (size_t)(NLAT + b * CTXL + qq) : (size_t)b * SEQ + (qq - CTXL);
    if (MODE == 0) {
        LAS float* xb = (LAS float*)(lds + XB0) + (wid & 3) * 2048;
        if (sub == 1) {
#pragma unroll
            for (int r = 0; r < 16; ++r) { xb[r * 64 + lane] = o0[r]; xb[(16 + r) * 64 + lane] = o1[r]; } }
        __syncthreads();
        if (sub == 0) { float ss = 0.f;
#pragma unroll
            for (int r = 0; r < 16; ++r) { o0[r] -= A.lam * xb[r * 64 + lane]; o1[r] -= A.lam * xb[(16 + r) * 64 + lane]; ss += o0[r] * o0[r] + o1[r] * o1[r]; }
            ss = xhalf_sum(ss); const float rs = A.oml / sqrtf(ss * (1.0f / 64.0f) + 1e-6f);
            bf16_t* yp = A.Y + yrow * DM + head * 64;
#pragma unroll
            for (int rg = 0; rg < 4; ++rg) { const int dv = 8 * rg + 4 * hi; const f32x4 w0 = *(const f32x4*)(A.subw + dv), w1 = *(const f32x4*)(A.subw + 32 + dv);
                u32x2 a, c2; a.x = cvtpk(o0[4 * rg] * rs * w0[0], o0[4 * rg + 1] * rs * w0[1]); a.y = cvtpk(o0[4 * rg + 2] * rs * w0[2], o0[4 * rg + 3] * rs * w0[3]);
                c2.x = cvtpk(o1[4 * rg] * rs * w1[0], o1[4 * rg + 1] * rs * w1[1]); c2.y = cvtpk(o1[4 * rg + 2] * rs * w1[2], o1[4 * rg + 3] * rs * w1[3]);
                *(u32x2*)(yp + dv) = a; *(u32x2*)(yp + 32 + dv) = c2; } }
    } else {
        bf16_t* yp = A.Y + yrow * DM + (MODE == 1 ? 512 : 768) + qhead * 64;
#pragma unroll
        for (int rg = 0; rg < 4; ++rg) { const int dv = 8 * rg + 4 * hi;
            u32x2 a, c2; a.x = cvtpk(o0[4 * rg], o0[4 * rg + 1]); a.y = cvtpk(o0[4 * rg + 2], o0[4 * rg + 3]);
            c2.x = cvtpk(o1[4 * rg], o1[4 * rg + 1]); c2.y = cvtpk(o1[4 * rg + 2], o1[4 * rg + 3]);
            *(u32x2*)(yp + dv) = a; *(u32x2*)(yp + 32 + dv) = c2; }
    }
}
__device__ __forceinline__ unsigned xcc_id() { return (unsigned)__builtin_amdgcn_s_getreg((3 << 11) | 20) & 0xFu; }
__device__ __forceinline__ void attn_phase(const Params& P, LAS unsigned char* lds, int l) {
    GAS unsigned char* wsg_ = (GAS unsigned char*)P.ws; asm volatile("" : "+s"(wsg_)); unsigned char* ws = (unsigned char*)wsg_;
    unsigned char* qkv = ws + WS_QKV; bf16_t* Y = (bf16_t*)(ws + WS_Y);
    const float lam = ((const float*)(ws + WS_LAM))[l]; const float oml = 1.0f - (l == 0 ? 0.2f : 0.35550906759097f);
    const float* subw = P.in[17] + l * 64; const float* sink = P.in[18] + l * 4;
    const unsigned* xcnt = (const unsigned*)(ws + WS_XCNT);
    const int myx = (int)xcc_id(); const int rank = __builtin_amdgcn_readfirstlane(*(const LAS int*)(lds + LDS_RANK_OFF));
    int nx = 0, vx = 0, nloc = 1;
    for (int j = 0; j < 16; ++j) { const int cj = (int)xcnt[j]; if (cj > 0) { if (j < myx) ++vx; ++nx; } if (j == myx) nloc = cj; }
    if (nx < 1) nx = 1; if (nloc < 1) nloc = 1;
    const int nlist = (l == 0) ? 260 : 256;
    for (int g = vx; g < 8; g += nx) {
        for (int i = rank; i < nlist; i += nloc) {
            int mode, b, head, qt;
            if (i < 128) { mode = 0; b = g >> 2; head = g & 3; qt = 2 + i; }
            else if (i < 192) { mode = 2; b = (g & 3) >> 1; head = g & 1; qt = 2 + 64 * (g >> 2) + (i - 128); }
            else if (i < 256) { mode = 1; b = (g & 3) >> 1; head = g & 1; qt = 2 + 64 * (g >> 2) + (i - 192); }
            else if (i < 258) { mode = 0; b = g >> 2; head = g & 3; qt = i - 256; }
            else if (i == 258) { mode = 2; b = (g & 3) >> 1; head = g & 1; qt = g >> 2; }
            else { mode = 1; b = (g & 3) >> 1; head = g & 1; qt = g >> 2; }
            if (mode == 0) { const AttnPtrs A{(const bf16_t*)(qkv + O_QA), (const bf16_t*)(qkv + O_KA), (const bf16_t*)(qkv + O_VAT), Y, subw, sink, lam, oml}; attn_unit<0>(lds, A, b, head, qt); }
            else if (mode == 1) { const AttnPtrs A{(const bf16_t*)(qkv + O_QC), (const bf16_t*)(qkv + O_KC), (const bf16_t*)(qkv + O_VCT), Y, subw, sink, lam, oml}; attn_unit<1>(lds, A, b, head, qt); }
            else { const AttnPtrs A{(const bf16_t*)(qkv + O_QD), (const bf16_t*)(qkv + O_KD), (const bf16_t*)(qkv + O_VDT), Y, subw, sink, lam, oml}; attn_unit<2>(lds, A, b, head, qt); }
        }
    }
}

#define XB_TMO      128
#define XB_XCNT(j)  (256  + 64 * (j))
#define XB_XSUB(j)  (1280 + 64 * (j))
#define XB_XGEN(j)  (2304 + 64 * (j))
#define XB_TOP      3328
#define XB_TOPGEN   3392
#define XCD_BAR_WORDS 3456
#define XB_SPIN_CAP (1u << 23)

__device__ __forceinline__ unsigned xb_ld(unsigned* p)              { return __hip_atomic_load(p, __ATOMIC_RELAXED, __HIP_MEMORY_SCOPE_AGENT); }
__device__ __forceinline__ unsigned xb_add(unsigned* p, unsigned v) { return __hip_atomic_fetch_add(p, v, __ATOMIC_RELAXED, __HIP_MEMORY_SCOPE_AGENT); }
__device__ __forceinline__ unsigned xb_xcc_id() { return (unsigned)__builtin_amdgcn_s_getreg((3 << 11) | 20) & 0xFu; }
#define XB_SPIN(cond, bar) do { unsigned _sp = 0; while (cond) { __builtin_amdgcn_s_sleep(1); \
    if ((++_sp & 255u) == 0u) { if (xb_ld(&(bar)[XB_TMO])) break; if (_sp > XB_SPIN_CAP) { atomicAdd(&(bar)[XB_TMO], 1u); break; } } } } while (0)

struct XcdBarrier {
    unsigned* bar; unsigned x;
    volatile LAS unsigned* st;
};

__device__ __forceinline__ XcdBarrier xcd_barrier_post(unsigned* bar, volatile LAS unsigned* st) {
    XcdBarrier b; b.bar = bar; b.x = xb_xcc_id(); b.st = st;
    if (threadIdx.x == 0) (void)xb_add(&bar[XB_XCNT(b.x)], 1u);
    return b;
}
__device__ __forceinline__ void xcd_barrier_complete(unsigned* bar, unsigned x, unsigned& nloc, unsigned& nx) {
    const unsigned G = gridDim.x * gridDim.y * gridDim.z;
    unsigned sum, cnt, mine, sp = 0u;
    for (;;) {
        sum = 0u; cnt = 0u; mine = 0u;
#pragma unroll
        for (unsigned j = 0; j < 16; ++j) { const unsigned c = xb_ld(&bar[XB_XCNT(j)]); sum += c; cnt += (c > 0u) ? 1u : 0u; mine = (j == x) ? c : mine; }
        if (sum == G) break;
        __builtin_amdgcn_s_sleep(1);
        if ((++sp & 255u) == 0u) { if (xb_ld(&bar[XB_TMO])) break; if (sp > XB_SPIN_CAP) { atomicAdd(&bar[XB_TMO], 1u); break; } }
    }
    nloc = mine > 0u ? mine : 1u; nx = cnt > 0u ? cnt : 1u;
}

__device__ __forceinline__ void xcd_barrier(const XcdBarrier& b) {
    asm volatile("s_waitcnt vmcnt(0)" ::: "memory");
    __syncthreads();
    if (threadIdx.x == 0) {
        unsigned* bar = b.bar;
        __builtin_amdgcn_s_waitcnt(0);
        unsigned nloc = b.st[0], nx = b.st[1];
        if (nloc == 0u) { xcd_barrier_complete(bar, b.x, nloc, nx); b.st[0] = nloc; b.st[1] = nx; }
        const unsigned old = xb_add(&bar[XB_XSUB(b.x)], 1u);
        const unsigned gen = old / nloc;
        if (old + 1u == (gen + 1u) * nloc) {
            __builtin_amdgcn_fence(__ATOMIC_RELEASE, "agent");
            asm volatile("s_waitcnt vmcnt(0)" ::: "memory");
            const unsigned og = xb_add(&bar[XB_TOP], 1u);
            const unsigned tg = og / nx;
            if (og + 1u == (tg + 1u) * nx) xb_add(&bar[XB_TOPGEN], 1u);
            else XB_SPIN(xb_ld(&bar[XB_TOPGEN]) == tg, bar);
            __builtin_amdgcn_fence(__ATOMIC_ACQUIRE, "agent");
            xb_add(&bar[XB_XGEN(b.x)], 1u);
            asm volatile("s_waitcnt vmcnt(0)" ::: "memory");
        } else {
            XB_SPIN(xb_ld(&bar[XB_XGEN(b.x)]) == gen, bar);
            __builtin_amdgcn_fence(__ATOMIC_ACQUIRE, "agent");
            asm volatile("s_waitcnt vmcnt(0)" ::: "memory");
        }
    }
    __syncthreads();
}

__global__ void __launch_bounds__(512, 2) mega_fwd(Params P) {
    extern __shared__ __attribute__((aligned(16))) unsigned char lds_raw[];
    LAS unsigned char* lds = (LAS unsigned char*)lds_raw;
    cg::grid_group grid = cg::this_grid();
    unsigned char* ws = P.ws;
    const float* mod = (const float*)(ws + WS_MOD);
    const int G = gridDim.x, bx = blockIdx.x;

    if (threadIdx.x == 0) { const unsigned r_ = atomicAdd((unsigned*)(ws + WS_XCNT) + xcc_id(), 1u); *(LAS unsigned*)(lds + LDS_RANK_OFF) = r_; }
    if (threadIdx.x == 0) { *(volatile LAS unsigned*)(lds + LDS_XB_OFF) = 0u; *(volatile LAS unsigned*)(lds + LDS_XB_OFF + 4) = 0u; }
    __syncthreads();
    (void)xcd_barrier_post((unsigned*)(ws + WS_XBAR), (volatile LAS unsigned*)(lds + LDS_XB_OFF));
#define GBAR() do { XcdBarrier xb_; xb_.bar = (unsigned*)(P.ws + WS_XBAR); xb_.x = xb_xcc_id(); xb_.st = (volatile LAS unsigned*)(lds + LDS_XB_OFF); xcd_barrier(xb_); } while (0)
    prologue(P, lds);
    grid.sync();
    row_pass<false>(P, TROWS, nullptr, nullptr, mod + 0 * 1024, mod + 1 * 1024, true, false);
    GBAR();
#pragma unroll 1
    for (int l = 0; l < 2; ++l) {
        GAS unsigned char* wsg_ = (GAS unsigned char*)ws; asm volatile("" : "+s"(wsg_)); unsigned char* wsl = (unsigned char*)wsg_;
        const float* modl = (const float*)(wsl + WS_MOD) + (size_t)l * 3 * NMODW;
        const unsigned char* wl = wsl + WS_W + (size_t)l * W_LAYER;
        float* xctx = (float*)(wsl + WS_XCTX); bf16_t* H = (bf16_t*)(wsl + WS_H); bf16_t* ACT = (bf16_t*)(wsl + WS_ACT); bf16_t* Z = (bf16_t*)(wsl + WS_Z); bf16_t* Y = (bf16_t*)(wsl + WS_Y);
        const int Mtail = (l == 1) ? NLAT : TROWS;
        const float* lng = P.in[6] + l * 3 * DM; const float* lnb = P.in[7] + l * 3 * DM;
#pragma unroll 1
        for (int f = 0; f < 2; ++f) {
            const int Mf = f == 0 ? TROWS : Mtail;
            { pg8::Gemm g{H, (const bf16_t*)(wl + (f == 0 ? W_GU1 : W_GU2)), Mf, 2 * DFF, DM}; pg8::StaticOrder S; S.init(Mf, 2 * DFF, G, bx);
              pg8::EpiSwiglu E{ACT, DFF};
              pg8::gemm_phase<pg8::EpiSwiglu, pg8::StaticOrder, true, true>(lds, g, S, E); }
            GBAR();
            { pg8::Gemm g{ACT, (const bf16_t*)(wl + (f == 0 ? W_DN1 : W_DN2)), Mf, DM, DFF}; pg8::StaticOrder S; S.init(Mf, DM, G, bx);
              const int pli = (f == 0) ? (l == 0 ? 0 : 2) : 1;
              const float* plg = (f == 0) ? P.in[6] + (l == 0 ? 0 : (l - 1) * 3 * DM) + pli * DM : lng + DM; const float* plb = (f == 0) ? P.in[7] + (l == 0 ? 0 : (l - 1) * 3 * DM) + pli * DM : lnb + DM;
              const bool first_ = (f == 0 && l == 0);
              pg8::EpiResid E{P.out, xctx, modl + (f == 0 ? 2 : 8) * 1024, 0.5f, first_ ? P.in[0] : (const float*)P.out, first_ ? P.in[2] : (const float*)xctx, (const float*)(wsl + WS_STATS), plg, plb, first_ ? 1 : 0};
              pg8::gemm_phase<pg8::EpiResid, pg8::StaticOrder, true, true>(lds, g, S, E); }
            GBAR();
            if (f == 0) {
                row_pass<true>(P, TROWS, lng, lnb, modl + 3 * 1024, modl + 4 * 1024, true, false);
                GBAR();
                { pg8::Gemm g{H, (const bf16_t*)(wl + W_IN), TROWS, INW, DM}; pg8::StaticOrder S; S.init(TROWS, INW, G, bx);
                  pg8::EpiBf16<0> E{Z, INW, nullptr, 0, 0, 1.f};
                  pg8::gemm_phase<pg8::EpiBf16<0>, pg8::StaticOrder, true, true>(lds, g, S, E); }
                GBAR();
                zpost_phase(P, lds, l);
                GBAR();
                attn_phase(P, lds, l);
                GBAR();
                { pg8::Gemm g{Y, (const bf16_t*)(wl + W_OUT), Mtail, DM, DM}; pg8::StaticOrder S; S.init(Mtail, DM, G, bx);
                  pg8::EpiResid E{P.out, xctx, modl + 5 * 1024, 1.0f, (const float*)P.out, (const float*)xctx, (const float*)(wsl + WS_STATS), lng, lnb, 0};
                  pg8::gemm_phase<pg8::EpiResid, pg8::StaticOrder, true, true>(lds, g, S, E); }
                GBAR();
                row_pass<true>(P, Mtail, lng + DM, lnb + DM, modl + 6 * 1024, modl + 7 * 1024, true, false);
                GBAR();
            } else {
                const bool last = (l == 1);
                row_pass<true>(P, Mtail, lng + 2 * DM, lnb + 2 * DM, modl + 3 * NMODW + 0 * 1024, modl + 3 * NMODW + 1 * 1024, !last, last);
                if (!last) GBAR();
            }
        }
    }
}

extern "C" void kernel_launch(void* const* d_in, const int* in_sizes, int n_in, void* d_out, int out_size, void* d_ws, size_t ws_size, hipStream_t stream) {
    static int grid = 0;
    if (grid == 0) {
        if (n_in != 23 || out_size != NLAT * DM || ws_size < WS_END) { fprintf(stderr, "kernel_launch: unexpected shapes (n_in %d out %d ws %zu, need %zu)\n", n_in, out_size, ws_size, (size_t)WS_END); grid = -1; return; }
        int dev = 0, cus = 0, per_cu = 0;
        if (hipGetDevice(&dev) != hipSuccess || hipDeviceGetAttribute(&cus, hipDeviceAttributeMultiprocessorCount, dev) != hipSuccess) { grid = -1; return; }
        if (hipFuncSetAttribute((const void*)mega_fwd, hipFuncAttributeMaxDynamicSharedMemorySize, LDS_BYTES) != hipSuccess) { fprintf(stderr, "kernel_launch: hipFuncSetAttribute failed\n"); grid = -1; return; }
        if (hipOccupancyMaxActiveBlocksPerMultiprocessor(&per_cu, (const void*)mega_fwd, 512, LDS_BYTES) != hipSuccess || per_cu < 1) { fprintf(stderr, "kernel_launch: occupancy query says %d\n", per_cu); per_cu = 1; }
        (void)hipGetLastError();
        grid = cus * per_cu;
    }
    if (grid < 0) return;
    Params p{};
    for (int i = 0; i < 23; ++i) p.in[i] = (const float*)d_in[i];
    p.out = (float*)d_out; p.ws = (unsigned char*)d_ws;
    (void)hipMemsetAsync((unsigned char*)d_ws + WS_XCNT, 0, 64 * 1024, stream);
    void* args[] = {&p};
    hipError_t e = hipLaunchCooperativeKernel((const void*)mega_fwd, dim3(grid), dim3(512), args, LDS_BYTES, stream);
    if (e != hipSuccess) fprintf(stderr, "kernel_launch: cooperative launch failed: %s (grid %d)\n", hipGetErrorString(e), grid);
}
```
